# Optimizing an MI355X kernel written in HIP

```python
import numpy as np
import jax, jax.numpy as jnp
from jax import lax

D_MODEL = 1024
BATCH = 32
SEQ = 2048
DEPTH = 1

POOL_WINDOWS = (2, 4, 8, 16)
N_POOL_GROUPS = len(POOL_WINDOWS)
POOL_GROUP = D_MODEL // 8
POOL_WIDTH = POOL_GROUP * N_POOL_GROUPS
HEAD_DIM = 64
N_HEADS = D_MODEL // HEAD_DIM
N_KV_GROUPS = 2
HEADS_PER_GROUP = N_HEADS // N_KV_GROUPS
ATTN_WIDTH = N_HEADS * HEAD_DIM
N_NSA_BRANCHES = 3
KV_WIDTH = N_NSA_BRANCHES * 2 * N_KV_GROUPS * HEAD_DIM
CMP_BLOCK = 32
CMP_STRIDE = 16
CMP_HIDDEN = 128
SLC_BLOCK = 64
SLC_TOP_N = 8
WINDOW = 512
Q_BLOCK = 32
ROPE_THETA = 10000.0
SCALE = HEAD_DIM ** -0.5
FORCE_BONUS = 1000.0
NEG_INF = -1e30
N_MERGE = 2
OFF_Q = POOL_WIDTH
OFF_KV = OFF_Q + ATTN_WIDTH
OFF_NSA_G = OFF_KV + KV_WIDTH
OFF_MERGE_G = OFF_NSA_G + N_NSA_BRANCHES * N_HEADS
IN_WIDTH = OFF_MERGE_G + N_MERGE * D_MODEL
D_FF = 2752
CONV_WIDTH = 3
EPS = 1e-6

kernel_name = "hybrid_pool_nsa_convffn"


def rms_norm(x, w):
    xf = x.astype(jnp.float32)
    y = xf * lax.rsqrt(jnp.mean(xf * xf, axis=-1, keepdims=True) + EPS)
    return (y * w.astype(jnp.float32)).astype(x.dtype)


def rope(x, pos):
    half = HEAD_DIM // 2
    freqs = ROPE_THETA ** (-jnp.arange(half, dtype=jnp.float32) / half)
    ang = pos.astype(jnp.float32)[:, None] * freqs[None, :]
    shp = (1, pos.shape[0]) + (1,) * (x.ndim - 3) + (half,)
    cos = jnp.cos(ang).reshape(shp)
    sin = jnp.sin(ang).reshape(shp)
    xf = x.astype(jnp.float32)
    x1, x2 = xf[..., :half], xf[..., half:]
    return jnp.concatenate([x1 * cos - x2 * sin, x2 * cos + x1 * sin], axis=-1).astype(x.dtype)


def masked_softmax(s, mask):
    s = jnp.where(mask, s.astype(jnp.float32), NEG_INF)
    p = jax.nn.softmax(s, axis=-1)
    return jnp.where(mask, p, 0.0)


def pool_mixer(u, pool_w, pool_scale):
    B, S, _ = u.shape
    ug = u.reshape(B, S, N_POOL_GROUPS, POOL_GROUP).astype(jnp.float32)
    c = jnp.pad(jnp.cumsum(ug, axis=1), ((0, 0), (1, 0), (0, 0), (0, 0)))
    t = jnp.arange(S)
    outs = []
    for gi, w in enumerate(POOL_WINDOWS):
        lo = jnp.maximum(t + 1 - w, 0)
        cnt = jnp.minimum(t + 1, w).astype(jnp.float32)
        outs.append((c[:, 1:, gi] - c[:, lo, gi]) / cnt[None, :, None])
    pooled = jnp.stack(outs, axis=2) - ug
    y = jnp.einsum('bsgc,gcd->bsgd', pooled.astype(u.dtype), pool_w)
    return y.reshape(B, S, POOL_WIDTH) * pool_scale


def compress(k, pos_emb, w1, b1, w2):
    B, S = k.shape[0], k.shape[1]
    n_cmp = (S - CMP_BLOCK) // CMP_STRIDE + 1
    idx = np.arange(n_cmp)[:, None] * CMP_STRIDE + np.arange(CMP_BLOCK)[None, :]
    blk = k[:, idx] + pos_emb[None, None, :, None, :]
    flat = jnp.moveaxis(blk, 3, 2).reshape(B, n_cmp, N_KV_GROUPS, CMP_BLOCK * HEAD_DIM)
    hid = jax.nn.gelu(flat @ w1 + b1)
    return hid @ w2


def nsa_attention(q, k, v, nsa_g, cmp_pos, cmp_w1, cmp_b1, cmp_w2):
    B, S = q.shape[0], q.shape[1]
    k_c, k_s, k_w = k[:, :, 0], k[:, :, 1], k[:, :, 2]
    v_c, v_s, v_w = v[:, :, 0], v[:, :, 1], v[:, :, 2]
    k_cmp = compress(k_c, cmp_pos[0], cmp_w1[0], cmp_b1[0], cmp_w2[0])
    v_cmp = compress(v_c, cmp_pos[1], cmp_w1[1], cmp_b1[1], cmp_w2[1])
    n_cmp = k_cmp.shape[1]
    cmp_end = jnp.asarray(np.arange(n_cmp) * CMP_STRIDE + CMP_BLOCK - 1, dtype=jnp.int32)
    n_slc = S // SLC_BLOCK
    n_sel = min(SLC_TOP_N, n_slc)
    ci = np.arange(n_cmp)[:, None]
    sj = np.arange(n_slc)[None, :]
    overlap = jnp.asarray(((ci * CMP_STRIDE < (sj + 1) * SLC_BLOCK) &
                           (ci * CMP_STRIDE + CMP_BLOCK > sj * SLC_BLOCK)).astype(np.float32))
    ks_blk = k_s.reshape(B, n_slc, SLC_BLOCK, N_KV_GROUPS, HEAD_DIM).transpose(0, 3, 1, 2, 4)
    vs_blk = v_s.reshape(B, n_slc, SLC_BLOCK, N_KV_GROUPS, HEAD_DIM).transpose(0, 3, 1, 2, 4)
    pad = ((0, 0), (WINDOW, 0), (0, 0), (0, 0))
    kw_pad = jnp.pad(k_w, pad)
    vw_pad = jnp.pad(v_w, pad)
    b_ix = jnp.arange(B)[:, None, None, None]
    g_ix = jnp.arange(N_KV_GROUPS)[None, :, None, None]
    blk_ids = jnp.arange(n_slc)

    def chunk(args):
        qc, gc, start = args
        tq = start + jnp.arange(Q_BLOCK)
        qg = qc.reshape(B, Q_BLOCK, N_KV_GROUPS, HEADS_PER_GROUP, HEAD_DIM)
        s_c = jnp.einsum('bqghd,bngd->bghqn', qg, k_cmp)
        p_c = masked_softmax(s_c, cmp_end[None, :] <= tq[:, None])
        o_c = jnp.einsum('bghqn,bngd->bqghd', p_c.astype(v_cmp.dtype), v_cmp)
        imp = jnp.einsum('bghqn,nj->bgqj', p_c, overlap)
        cur = tq // SLC_BLOCK
        forced = ((blk_ids[None] == 0) | (blk_ids[None] == cur[:, None]) |
                  (blk_ids[None] == cur[:, None] - 1)).astype(jnp.float32)
        valid_b = blk_ids[None] * SLC_BLOCK <= tq[:, None]
        score = jnp.where(valid_b, imp + FORCE_BONUS * forced, NEG_INF)
        _, idx = lax.top_k(score, n_sel)
        kg = ks_blk[b_ix, g_ix, idx]
        vg = vs_blk[b_ix, g_ix, idx]
        m_tok = n_sel * SLC_BLOCK
        kpos = idx[..., None] * SLC_BLOCK + jnp.arange(SLC_BLOCK)
        mask_s = (kpos <= tq[None, None, :, None, None]).reshape(B, N_KV_GROUPS, 1, Q_BLOCK, m_tok)
        s_s = jnp.einsum('bqghd,bgqnld->bghqnl', qg, kg).reshape(B, N_KV_GROUPS, HEADS_PER_GROUP, Q_BLOCK, m_tok)
        p_s = masked_softmax(s_s, mask_s)
        o_s = jnp.einsum('bghqm,bgqmd->bqghd', p_s.astype(vg.dtype),
                         vg.reshape(B, N_KV_GROUPS, Q_BLOCK, m_tok, HEAD_DIM))
        kw = lax.dynamic_slice_in_dim(kw_pad, start, Q_BLOCK + WINDOW, axis=1)
        vw = lax.dynamic_slice_in_dim(vw_pad, start, Q_BLOCK + WINDOW, axis=1)
        kp = start - WINDOW + jnp.arange(Q_BLOCK + WINDOW)
        dist = tq[:, None] - kp[None, :]
        mask_w = (dist >= 0) & (dist < WINDOW) & (kp[None, :] >= 0)
        s_w = jnp.einsum('bqghd,bkgd->bghqk', qg, kw)
        p_w = masked_softmax(s_w, mask_w)
        o_w = jnp.einsum('bghqk,bkgd->bqghd', p_w.astype(vw.dtype), vw)
        gc = gc.reshape(B, Q_BLOCK, N_KV_GROUPS, HEADS_PER_GROUP, N_NSA_BRANCHES)
        o = gc[..., 0:1] * o_c + gc[..., 1:2] * o_s + gc[..., 2:3] * o_w
        return o.reshape(B, Q_BLOCK, ATTN_WIDTH)

    n_q = S // Q_BLOCK
    q_chunks = q.reshape(B, n_q, Q_BLOCK, N_HEADS, HEAD_DIM).transpose(1, 0, 2, 3, 4)
    g_chunks = nsa_g.reshape(B, n_q, Q_BLOCK, N_HEADS, N_NSA_BRANCHES).transpose(1, 0, 2, 3, 4)
    starts = jnp.arange(n_q, dtype=jnp.int32) * Q_BLOCK
    out = lax.map(chunk, (q_chunks, g_chunks, starts))
    return out.transpose(1, 0, 2, 3).reshape(B, S, ATTN_WIDTH)


def token_mixer(h, w_in, pool_w, pool_scale, q_norm_w, k_norm_w, cmp_pos, cmp_w1, cmp_b1,
                cmp_w2, w_pool_br, w_attn_br, w_o):
    B, S, _ = h.shape
    z = h @ w_in
    u_pool = z[..., :OFF_Q]
    q = z[..., OFF_Q:OFF_KV].reshape(B, S, N_HEADS, HEAD_DIM)
    kv = z[..., OFF_KV:OFF_NSA_G].reshape(B, S, N_NSA_BRANCHES, 2, N_KV_GROUPS, HEAD_DIM)
    nsa_g = jax.nn.sigmoid(z[..., OFF_NSA_G:OFF_MERGE_G].astype(jnp.float32)).astype(h.dtype)
    nsa_g = nsa_g.reshape(B, S, N_HEADS, N_NSA_BRANCHES)
    merge_g = jax.nn.sigmoid(z[..., OFF_MERGE_G:].astype(jnp.float32)).astype(h.dtype)
    merge_g = merge_g.reshape(B, S, N_MERGE, D_MODEL)
    pos = jnp.arange(S)
    q = rope(rms_norm(q, q_norm_w), pos) * SCALE
    k = rope(rms_norm(kv[:, :, :, 0], k_norm_w[:, None, :]), pos)
    v = kv[:, :, :, 1]
    y_pool = pool_mixer(u_pool, pool_w, pool_scale) @ w_pool_br
    y_attn = nsa_attention(q, k, v, nsa_g, cmp_pos, cmp_w1, cmp_b1, cmp_w2) @ w_attn_br
    merged = merge_g[:, :, 0] * y_pool + merge_g[:, :, 1] * y_attn
    return merged @ w_o


def conv_ffn(h, w_up, conv_w, conv_b, w_down):
    S = h.shape[1]
    u = h @ w_up
    up = jnp.pad(u, ((0, 0), (CONV_WIDTH - 1, 0), (0, 0)))
    c = conv_b + conv_w[0] * up[:, 0:S]
    for tap in range(1, CONV_WIDTH):
        c = c + conv_w[tap] * up[:, tap:tap + S]
    gate, val = jnp.split(c, 2, axis=-1)
    return (jax.nn.silu(gate) * val) @ w_down


def setup_inputs(seed: int = 0) -> dict:
    key = jax.random.key(seed)
    ks = jax.random.split(key, 20)
    f32 = jnp.float32
    nrm = lambda k, shape, s: jax.random.normal(k, shape, f32) * s
    L = DEPTH
    return {
        "x": jax.random.normal(ks[0], (BATCH, SEQ, D_MODEL), f32),
        "attn_norm_w": 1.0 + nrm(ks[1], (L, D_MODEL), 0.05),
        "w_in": nrm(ks[2], (L, D_MODEL, IN_WIDTH), D_MODEL ** -0.5),
        "pool_w": nrm(ks[3], (L, N_POOL_GROUPS, POOL_GROUP, POOL_GROUP), POOL_GROUP ** -0.5),
        "pool_scale": 1.0 + nrm(ks[4], (L, POOL_WIDTH), 0.1),
        "q_norm_w": 1.0 + nrm(ks[5], (L, HEAD_DIM), 0.05),
        "k_norm_w": 1.0 + nrm(ks[6], (L, N_NSA_BRANCHES, HEAD_DIM), 0.05),
        "cmp_pos": nrm(ks[7], (L, 2, CMP_BLOCK, HEAD_DIM), 0.5),
        "cmp_w1": nrm(ks[8], (L, 2, CMP_BLOCK * HEAD_DIM, CMP_HIDDEN), (CMP_BLOCK * HEAD_DIM) ** -0.5),
        "cmp_b1": nrm(ks[9], (L, 2, CMP_HIDDEN), 0.02),
        "cmp_w2": nrm(ks[10], (L, 2, CMP_HIDDEN, HEAD_DIM), CMP_HIDDEN ** -0.5),
        "w_pool_br": nrm(ks[11], (L, POOL_WIDTH, D_MODEL), POOL_WIDTH ** -0.5),
        "w_attn_br": nrm(ks[12], (L, ATTN_WIDTH, D_MODEL), ATTN_WIDTH ** -0.5),
        "w_o": nrm(ks[13], (L, D_MODEL, D_MODEL), D_MODEL ** -0.5),
        "ffn_norm_w": 1.0 + nrm(ks[14], (L, D_MODEL), 0.05),
        "w_up": nrm(ks[15], (L, D_MODEL, 2 * D_FF), D_MODEL ** -0.5),
        "conv_w": nrm(ks[16], (L, CONV_WIDTH, 2 * D_FF), CONV_WIDTH ** -0.5),
        "conv_b": nrm(ks[17], (L, 2 * D_FF), 0.02),
        "w_down": nrm(ks[18], (L, D_FF, D_MODEL), D_FF ** -0.5),
    }


def reference(x, attn_norm_w, w_in, pool_w, pool_scale, q_norm_w, k_norm_w, cmp_pos, cmp_w1,
              cmp_b1, cmp_w2, w_pool_br, w_attn_br, w_o, ffn_norm_w, w_up, conv_w, conv_b, w_down):
    for l in range(DEPTH):
        h = rms_norm(x, attn_norm_w[l])
        x = x + token_mixer(h, w_in[l], pool_w[l], pool_scale[l], q_norm_w[l], k_norm_w[l],
                            cmp_pos[l], cmp_w1[l], cmp_b1[l], cmp_w2[l], w_pool_br[l],
                            w_attn_br[l], w_o[l])
        h = rms_norm(x, ffn_norm_w[l])
        x = x + conv_ffn(h, w_up[l], conv_w[l], conv_b[l], w_down[l])
    return x
```

```cpp
#include <hip/hip_runtime.h>
#include <hip/hip_cooperative_groups.h>
#include <cstdio>
#include <cstdint>
namespace cg = cooperative_groups;
namespace pg8 {
#define PG8_LAS __attribute__((address_space(3)))
typedef unsigned short bf16_t;
typedef short bf16x8 __attribute__((ext_vector_type(8)));
typedef float f32x4 __attribute__((ext_vector_type(4)));
typedef unsigned u32x4 __attribute__((ext_vector_type(4)));
constexpr int BM = 256, BK = 64, HALF = 128, HTB = HALF * BK * 2  , STAGE_BYTES = 8 * HTB, NXCD = 8, WGM = 8;

__host__ __device__ __forceinline__ int lds_byte(int r, int c) { const int st = (r >> 4) * 2 + (c >> 5), rr = r & 15, cc = c & 31, ob = rr * 64 + cc * 2; return st * 1024 + (ob ^ (((ob >> 9) & 1) << 5)); }
__host__ __device__ __forceinline__ void stage_rc(int b, int& R, int& C) { const int st = b / 1024, sb = b % 1024, swz = sb ^ (((sb >> 9) & 1) << 5); R = (st >> 1) * 16 + swz / 64; C = (st & 1) * 32 + (swz % 64) / 2; }
__host__ __device__ __forceinline__ int perm32(int rho) { const int n = rho >> 4, i = rho & 15; return 8 * (i >> 2) + 4 * n + (i & 3); }

struct Unit { int pm, pn; };
struct Gemm { const bf16_t* A; const bf16_t* Bt; int M, N, K; };

struct StaticOrder {
    int nM, nN, nwg, G, c;
    __host__ __device__ void init(int M, int N, int G_, int c_) { nM = M / BM; nN = N / BM; nwg = nM * nN; G = G_; c = c_; }
    __host__ __device__ bool next(int i, Unit& u) const {
        const long L = (long)i * G + c; if (L >= nwg) return false;
        int wgid = (int)L; { const int q = nwg / NXCD, r = nwg % NXCD, xcd = wgid % NXCD, off = wgid / NXCD; wgid = (xcd < r ? xcd * (q + 1) : r * (q + 1) + (xcd - r) * q) + off; }
        const int nig = WGM * nN, gid = wgid / nig, fm = gid * WGM, gsz = (nM - fm) < WGM ? (nM - fm) : WGM;
        u.pm = fm + ((wgid % nig) % gsz); u.pn = (wgid % nig) / gsz; return true;
    }
    __device__ __forceinline__ void a_ready(const Unit&) const {}
    __device__ __forceinline__ void done(const Unit&) const {}
};

__device__ __forceinline__ unsigned cvt_pk_bf16(float lo, float hi) { unsigned r; asm volatile("v_cvt_pk_bf16_f32 %0, %1, %2" : "=v"(r) : "v"(lo), "v"(hi)); return r; }
typedef float f32x2 __attribute__((ext_vector_type(2)));
template <class Epi, class Sched, bool ALIGN_EPI = false, bool SP2 = false>
__device__ __forceinline__ void gemm_phase(PG8_LAS unsigned char* lds, const Gemm g, const Sched& S, const Epi& E) {
    const int tid = threadIdx.x, wid = __builtin_amdgcn_readfirstlane(tid >> 6), lane = tid & 63, wr = wid >> 2, wc = wid & 3, fr = lane & 15, fq = lane >> 4;
    const int K = g.K, nt = K / BK;
    unsigned voffA[2], voffB[2];
#pragma unroll
    for (int i = 0; i < 2; ++i) { int R, C; stage_rc(tid * 16 + i * 8192, R, C); const int Rb = Epi::PERM ? ((R & ~31) + perm32(R & 31)) : R;
        voffA[i] = (unsigned)(R * K + C) * 2u; voffB[i] = (unsigned)(Rb * K + C) * 2u; }
    const size_t kstep = (size_t)(BK * 2);
    const size_t hstep = (size_t)HALF * K * 2;
    const size_t tstep = 2 * hstep;
    const unsigned ldsw = (unsigned)wid * 1024u;
    const int aoff = lds_byte(wr * 64 + fr, fq * 8), boff = lds_byte(wc * 32 + fr, fq * 8);
#define PG8_SA(b, h) (((b) * 2 + (h)) * HTB)
#define PG8_SB(b, h) ((4 + (b) * 2 + (h)) * HTB)
#define PG8_STAGE(bufoff, gbase, voff) do { _Pragma("unroll") for (int _i = 0; _i < 2; ++_i) \
        __builtin_amdgcn_global_load_lds((const unsigned*)((const char*)(gbase) + (voff)[_i]), (PG8_LAS unsigned*)(lds + (bufoff) + ldsw + _i * 8192), 16, 0, 0); } while (0)
#define PG8_LDA(dst, b, h) do { _Pragma("unroll") for (int m = 0; m < 4; ++m) _Pragma("unroll") for (int k = 0; k < 2; ++k) dst[m][k] = *(const PG8_LAS bf16x8*)(lds + PG8_SA(b, h) + aoff + m * 2048 + k * 1024); } while (0)
#define PG8_LDB(dst, b, h) do { _Pragma("unroll") for (int n = 0; n < 2; ++n) _Pragma("unroll") for (int k = 0; k < 2; ++k) dst[n][k] = *(const PG8_LAS bf16x8*)(lds + PG8_SB(b, h) + boff + n * 2048 + k * 1024); } while (0)
#define PG8_MMA(ai, bj, At, Bt) do { __builtin_amdgcn_s_setprio(1); _Pragma("unroll") for (int m = 0; m < 4; ++m) _Pragma("unroll") for (int n = 0; n < 2; ++n) _Pragma("unroll") for (int k = 0; k < 2; ++k) \
        acc[ai][bj][m][n] = __builtin_amdgcn_mfma_f32_16x16x32_bf16(Bt[n][k], At[m][k], acc[ai][bj][m][n], 0, 0, 0); __builtin_amdgcn_s_setprio(0); } while (0)
#define PG8_WAIT_V(n) asm volatile("s_waitcnt vmcnt(" #n ")" ::: "memory")
#define PG8_WAIT_L(n) asm volatile("s_waitcnt lgkmcnt(" #n ")" ::: "memory")
#define PG8_BAR __builtin_amdgcn_s_barrier()
#define PG8_SCHED __builtin_amdgcn_sched_barrier(0)
    Unit cur, nxt; int ui = 0;
    if (!S.next(0, cur)) return;
    f32x4 acc[2][2][4][2];
#pragma unroll
    for (int a = 0; a < 2; ++a)
#pragma unroll
        for (int b = 0; b < 2; ++b)
#pragma unroll
            for (int m = 0; m < 4; ++m)
#pragma unroll
                for (int n = 0; n < 2; ++n) acc[a][b][m][n] = (f32x4){0.f, 0.f, 0.f, 0.f};
    bf16x8 At[4][2], B0[2][2], B1[2][2];
    const char* cA = (const char*)g.A + (size_t)cur.pm * tstep; const char* cB = (const char*)g.Bt + (size_t)cur.pn * tstep;
    S.a_ready(cur);
    if constexpr (SP2) {
        PG8_STAGE(PG8_SB(0, 0), cB, voffB); PG8_STAGE(PG8_SB(0, 1), cB + hstep, voffB); PG8_STAGE(PG8_SA(0, 0), cA, voffA); PG8_STAGE(PG8_SA(0, 1), cA + hstep, voffA);
        if (wr == 1) PG8_BAR;
        PG8_WAIT_V(2); PG8_BAR;
        PG8_STAGE(PG8_SB(1, 0), cB + kstep, voffB); PG8_STAGE(PG8_SA(1, 0), cA + kstep, voffA); PG8_STAGE(PG8_SB(1, 1), cB + hstep + kstep, voffB);
        PG8_WAIT_V(6); PG8_BAR;
    } else {
        PG8_STAGE(PG8_SB(0, 0), cB, voffB); PG8_STAGE(PG8_SA(0, 0), cA, voffA); PG8_STAGE(PG8_SB(0, 1), cB + hstep, voffB); PG8_STAGE(PG8_SA(0, 1), cA + hstep, voffA);
        if (wr == 1) PG8_BAR;
        PG8_WAIT_V(4); PG8_BAR;
        PG8_STAGE(PG8_SB(1, 0), cB + kstep, voffB); PG8_STAGE(PG8_SA(1, 0), cA + kstep, voffA); PG8_STAGE(PG8_SB(1, 1), cB + hstep + kstep, voffB);
        PG8_WAIT_V(6); PG8_BAR;
    }
    for (;;) {
        const bool has_next = S.next(ui + 1, nxt);
        const char* nA = has_next ? (const char*)g.A + (size_t)nxt.pm * tstep : cA; const char* nB = has_next ? (const char*)g.Bt + (size_t)nxt.pn * tstep : cB;
        for (int t = 0; t < nt; t += 2) {
            const bool last = (t == nt - 2);
            const char* a1 = cA + (size_t)(t + 1) * kstep;
            const char* a2 = last ? nA : cA + (size_t)(t + 2) * kstep; const char* b2 = last ? nB : cB + (size_t)(t + 2) * kstep;
            const char* a3 = a2 + kstep; const char* b3 = b2 + kstep;
            if (last && has_next) S.a_ready(nxt);
            if constexpr (SP2) {
            PG8_LDB(B0, 0, 0); PG8_LDB(B1, 0, 1); PG8_SCHED; PG8_LDA(At, 0, 0); PG8_STAGE(PG8_SA(1, 1), a1 + hstep, voffA);
            PG8_WAIT_V(8); PG8_WAIT_L(0); PG8_BAR; PG8_MMA(0, 0, At, B0); PG8_MMA(0, 1, At, B1); PG8_BAR; PG8_SCHED;
            PG8_LDA(At, 0, 1); PG8_STAGE(PG8_SB(0, 0), b2, voffB); PG8_STAGE(PG8_SB(0, 1), b2 + hstep, voffB); PG8_STAGE(PG8_SA(0, 0), a2, voffA);
            PG8_WAIT_V(8); PG8_WAIT_L(0); PG8_BAR; PG8_MMA(1, 0, At, B0); PG8_MMA(1, 1, At, B1); PG8_BAR; PG8_SCHED;
            PG8_LDB(B0, 1, 0); PG8_LDB(B1, 1, 1); PG8_SCHED; PG8_LDA(At, 1, 0); PG8_STAGE(PG8_SA(0, 1), a2 + hstep, voffA);
            PG8_WAIT_V(8); PG8_WAIT_L(0); PG8_BAR; PG8_MMA(0, 0, At, B0); PG8_MMA(0, 1, At, B1); PG8_BAR; PG8_SCHED;
            PG8_LDA(At, 1, 1); PG8_STAGE(PG8_SB(1, 0), b3, voffB); PG8_STAGE(PG8_SB(1, 1), b3 + hstep, voffB); PG8_STAGE(PG8_SA(1, 0), a3, voffA);
            PG8_WAIT_V(8); PG8_WAIT_L(0); PG8_BAR; PG8_MMA(1, 0, At, B0); PG8_MMA(1, 1, At, B1); PG8_BAR; PG8_SCHED;
            } else {
            PG8_LDB(B0, 0, 0); PG8_SCHED; PG8_LDA(At, 0, 0); PG8_STAGE(PG8_SA(1, 1), a1 + hstep, voffA);
            PG8_WAIT_L(8); PG8_BAR; PG8_WAIT_L(0); PG8_MMA(0, 0, At, B0); PG8_BAR; PG8_SCHED;
            PG8_LDB(B1, 0, 1); PG8_STAGE(PG8_SB(0, 0), b2, voffB);
            PG8_BAR; PG8_WAIT_L(0); PG8_MMA(0, 1, At, B1); PG8_BAR;
            PG8_LDA(At, 0, 1); PG8_STAGE(PG8_SA(0, 0), a2, voffA);
            PG8_BAR; PG8_WAIT_L(0); PG8_MMA(1, 0, At, B0); PG8_BAR; PG8_SCHED;
            PG8_STAGE(PG8_SB(0, 1), b2 + hstep, voffB);
            PG8_WAIT_V(6); PG8_BAR; PG8_MMA(1, 1, At, B1); PG8_BAR;
            PG8_LDB(B0, 1, 0); PG8_SCHED; PG8_LDA(At, 1, 0); PG8_STAGE(PG8_SA(0, 1), a2 + hstep, voffA);
            PG8_WAIT_L(8); PG8_BAR; PG8_WAIT_L(0); PG8_MMA(0, 0, At, B0); PG8_BAR; PG8_SCHED;
            PG8_LDB(B1, 1, 1); PG8_STAGE(PG8_SB(1, 0), b3, voffB);
            PG8_BAR; PG8_WAIT_L(0); PG8_MMA(0, 1, At, B1); PG8_BAR;
            PG8_LDA(At, 1, 1); PG8_STAGE(PG8_SA(1, 0), a3, voffA);
            PG8_BAR; PG8_WAIT_L(0); PG8_MMA(1, 0, At, B0); PG8_BAR; PG8_SCHED;
            PG8_STAGE(PG8_SB(1, 1), b3 + hstep, voffB);
            PG8_WAIT_V(6); PG8_BAR; PG8_MMA(1, 1, At, B1); PG8_BAR;
            }
        }
        if constexpr (ALIGN_EPI) { if (wr == 0) PG8_BAR; }
        if constexpr (!Epi::AFTER_DRAIN) { E(acc, cur, wr, wc, fr, fq); S.done(cur); }
        if (!has_next) break;
#pragma unroll
        for (int a = 0; a < 2; ++a)
#pragma unroll
            for (int b = 0; b < 2; ++b)
#pragma unroll
                for (int m = 0; m < 4; ++m)
#pragma unroll
                    for (int n = 0; n < 2; ++n) acc[a][b][m][n] = (f32x4){0.f, 0.f, 0.f, 0.f};
        cur = nxt; cA = nA; cB = nB; ++ui;
        if constexpr (ALIGN_EPI) { if (wr == 1) PG8_BAR; }
    }
    PG8_WAIT_V(0);
    if constexpr (!ALIGN_EPI) { if (wr == 0) PG8_BAR; }
    PG8_BAR;
    if constexpr (Epi::AFTER_DRAIN) { E.fused(acc, cur, wr, wc, fr, fq, lds, wid, lane); S.done(cur); }
#undef PG8_SA
#undef PG8_SB
#undef PG8_STAGE
#undef PG8_LDA
#undef PG8_LDB
#undef PG8_MMA
#undef PG8_WAIT_V
#undef PG8_WAIT_L
#undef PG8_BAR
#undef PG8_SCHED
}
}
constexpr int BATCH = 32, SEQ = 2048, DM = 1024, MTOK = BATCH * SEQ;
constexpr int IN_W = 4400, N_IN = 4608, DFF = 2752, N_UP = 5632, K_DN = 2816, UPW = 5504;
constexpr float EPS = 1e-6f, QSCALE = 0.125f * 1.4426950408889634f, NEGBIG = -1e30f;
constexpr size_t MiB = 1u << 20;
constexpr size_t WS_CTL = 0, CTL_ZERO_BYTES = 1 * MiB;
constexpr size_t WS_WIN = 2 * MiB, WS_WPB = 11 * MiB, WS_WAB = 12 * MiB, WS_WO = 14 * MiB, WS_WUP = 16 * MiB, WS_WDN = 27 * MiB, WS_W1T = 33 * MiB;
constexpr size_t WS_W2T = 34 * MiB, WS_B1 = 34 * MiB + 65536, WS_ROPE = 35 * MiB, WS_R1 = 36 * MiB, WS_SSQ = 37 * MiB, WS_CMP = 41 * MiB, WS_NG = 44 * MiB, WS_RAW = 56 * MiB;
constexpr size_t WS_XB = 144 * MiB, WS_UPOOL = 272 * MiB, WS_Q = 336 * MiB, WS_KV = 464 * MiB, WS_MG = 560 * MiB, WS_POOLED = 816 * MiB, WS_ATT = 880 * MiB, WS_END = 1008 * MiB;
constexpr size_t WS_PY = WS_Q, WS_MERGED = WS_XB, WS_X1B = WS_Q, WS_A = WS_KV;
constexpr int LDS_BYTES = 147456, NWAVES = 8;

#define GAS __attribute__((address_space(1)))
#define LAS __attribute__((address_space(3)))
typedef unsigned short bf16;
typedef unsigned v4u __attribute__((ext_vector_type(4)));
typedef unsigned v2u __attribute__((ext_vector_type(2)));
typedef float f32x4 __attribute__((ext_vector_type(4)));
typedef float f32x16 __attribute__((ext_vector_type(16)));
typedef short bf16x8 __attribute__((ext_vector_type(8)));
typedef short s16x4 __attribute__((ext_vector_type(4)));
#define LDS_WAIT() asm volatile("s_waitcnt lgkmcnt(0)" ::: "memory")
#define VM_WAIT() asm volatile("s_waitcnt vmcnt(0)" ::: "memory")
__device__ __forceinline__ unsigned pk2(float lo, float hi) { return pg8::cvt_pk_bf16(lo, hi); }
__device__ __forceinline__ float bflo(unsigned w) { return __uint_as_float(w << 16); }
__device__ __forceinline__ float bfhi(unsigned w) { return __uint_as_float(w & 0xffff0000u); }
__device__ __forceinline__ float sigmoidf_(float z) { return 1.0f / (1.0f + __expf(-z)); }
__device__ __forceinline__ float wave_sum(float v) {
#pragma unroll
    for (int o = 1; o < 64; o <<= 1) v += __shfl_xor(v, o);
    return v;
}

struct Args {
    const float* in[19];
    float* out; unsigned char* ws;
    int ph_lo, ph_hi;
};
enum { I_X = 0, I_ANW, I_WIN, I_POOLW, I_POOLS, I_QNW, I_KNW, I_CPOS, I_CW1, I_CB1, I_CW2, I_WPB, I_WAB, I_WO, I_FNW, I_WUP, I_CONVW, I_CONVB, I_WDN };

struct MapId { __device__ __forceinline__ int operator()(int s) const { return s; } };
struct MapIn { __device__ __forceinline__ int operator()(int s) const {
    if (s < 512) return s;
    if (s < 1536) { const int t = s - 512, hq = t >> 6, d = t & 63; return 256 * (2 + (hq >> 2)) + 128 * (d >> 5) + 32 * (hq & 3) + (d & 31); }
    if (s < 2304) { const int t = s - 1536, u = t >> 6, d = t & 63; return 256 * (6 + (u >> 2)) + 128 * (d >> 5) + 32 * (u & 3) + (d & 31); }
    if (s < 2352) return 256 * 17 + (s - 2304);
    return 256 * 9 + (s - 2352); } };
struct MapUp { __device__ __forceinline__ int operator()(int s) const { const int ch = s < DFF ? s : s - DFF; const int base = 256 * (ch >> 7) + (ch & 127); return s < DFF ? base : base + 128; } };

template <class RowMap>
__device__ __forceinline__ void transpose_item(const float* W, int N, bf16* WT, int ldk, const float* kscale, LAS float* scr, int item, int lane, RowMap rm) {
    const int nblk = (N + 31) / 32, kb = item / nblk, nb = item % nblk, k0 = 64 * kb, n0 = 32 * nb;
    const int nsrc = n0 + (lane & 31); const bool nok = nsrc < N;
#pragma unroll 8
    for (int i = 0; i < 32; ++i) { const int kk = 2 * i + (lane >> 5); float v = nok ? W[(size_t)(k0 + kk) * N + nsrc] : 0.f; if (kscale) v *= kscale[k0 + kk]; scr[kk * 33 + (lane & 31)] = v; }
    LDS_WAIT(); asm volatile("" ::: "memory");
    const int c = lane & 7;
#pragma unroll
    for (int j = 0; j < 4; ++j) { const int n = (lane >> 3) + 8 * j; const LAS float* s = scr + (8 * c) * 33 + n;
        v4u o; o.x = pk2(s[0 * 33], s[1 * 33]); o.y = pk2(s[2 * 33], s[3 * 33]); o.z = pk2(s[4 * 33], s[5 * 33]); o.w = pk2(s[6 * 33], s[7 * 33]);
        if (n0 + n < N) *(GAS v4u*)(WT + (size_t)rm(n0 + n) * ldk + k0 + 8 * c) = o; }
    LDS_WAIT(); asm volatile("" ::: "memory");
}

__device__ __forceinline__ void p0_prologue(const Args& a, LAS unsigned char* lds, int vcu, int G) {
    const int tid = threadIdx.x, lane = tid & 63, wave = __builtin_amdgcn_readfirstlane(tid >> 6);
    unsigned char* ws = a.ws;
    LAS float* scr = (LAS float*)(lds + wave * 16384);
    const int gw = vcu * NWAVES + wave, NGW = G * NWAVES;
    const long gt = (long)gw * 64 + lane, NGT = (long)NGW * 64;
    bf16* WIN = (bf16*)(ws + WS_WIN); bf16* WUP = (bf16*)(ws + WS_WUP); bf16* WDN = (bf16*)(ws + WS_WDN);
    constexpr int I_IN = 16 * 138, I_AB = 16 * 32, I_O = 16 * 32, I_UP = 16 * 172, I_DN = 43 * 32, I_C1 = 32 * 4;
    constexpr int NITEMS = I_IN + I_AB + I_O + I_UP + I_DN + 2 * I_C1;
    for (int it = gw; it < NITEMS; it += NGW) {
        int r = it;
        if (r < I_IN) { transpose_item(a.in[I_WIN], IN_W, WIN, DM, a.in[I_ANW], scr, r, lane, MapIn()); continue; } r -= I_IN;
        if (r < I_AB) { transpose_item(a.in[I_WAB], DM, (bf16*)(ws + WS_WAB), DM, nullptr, scr, r, lane, MapId()); continue; } r -= I_AB;
        if (r < I_O) { transpose_item(a.in[I_WO], DM, (bf16*)(ws + WS_WO), DM, nullptr, scr, r, lane, MapId()); continue; } r -= I_O;
        if (r < I_UP) { transpose_item(a.in[I_WUP], UPW, WUP, DM, a.in[I_FNW], scr, r, lane, MapUp()); continue; } r -= I_UP;
        if (r < I_DN) { transpose_item(a.in[I_WDN], DM, WDN, K_DN, nullptr, scr, r, lane, MapId()); continue; } r -= I_DN;
        if (r < I_C1) { transpose_item(a.in[I_CW1], 128, (bf16*)(ws + WS_W1T), 2048, nullptr, scr, r, lane, MapId()); continue; } r -= I_C1;
        transpose_item(a.in[I_CW1] + 2048 * 128, 128, (bf16*)(ws + WS_W1T) + 128 * 2048, 2048, nullptr, scr, r, lane, MapId());
    }
    for (long i = gt; i < 208L * DM / 8; i += NGT) *(GAS v4u*)(WIN + (size_t)(256 * 17 + 48) * DM + i * 8) = (v4u){0u, 0u, 0u, 0u};
    for (long i = gt; i < 128L * DM / 8; i += NGT) { const long e = i * 8; const int rr = (int)(e / DM), cc = (int)(e % DM); const int row = 256 * 21 + (rr < 64 ? 64 + rr : 192 + (rr - 64));
        *(GAS v4u*)(WUP + (size_t)row * DM + cc) = (v4u){0u, 0u, 0u, 0u}; }
    for (long i = gt; i < 1024L * 8; i += NGT) { const int row = (int)(i >> 3), c8 = (int)(i & 7); *(GAS v4u*)(WDN + (size_t)row * K_DN + DFF + c8 * 8) = (v4u){0u, 0u, 0u, 0u}; }
    for (long i = gt; i < 128L * 8; i += NGT) { const int t = (int)(i >> 3), c8 = (int)(i & 7); *(GAS v4u*)((bf16*)(ws + WS_CMP) + ((size_t)t * 128 + 127) * 64 + c8 * 8) = (v4u){0u, 0u, 0u, 0u}; }
    { const float* pw = a.in[I_POOLW]; const float* ps = a.in[I_POOLS]; const float* wb = a.in[I_WPB]; bf16* WPB = (bf16*)(ws + WS_WPB);
      for (long i = gt; i < 512L * 1024; i += NGT) { const int n = (int)(i & 1023), k = (int)(i >> 10), g = k >> 7, c = k & 127; float s = 0.f;
          for (int d = 0; d < 128; ++d) s += pw[(g * 128 + c) * 128 + d] * ps[g * 128 + d] * wb[(size_t)(g * 128 + d) * 1024 + n];
          WPB[(size_t)n * 512 + k] = (bf16)(pk2(s, 0.f) & 0xffffu); } }
    for (long i = gt; i < 256; i += NGT) { const int kv = (int)(i >> 7), hc = (int)(i & 127); const float* w1 = a.in[I_CW1] + (size_t)kv * 2048 * 128; const float* pos = a.in[I_CPOS] + kv * 2048;
        float s = a.in[I_CB1][kv * 128 + hc]; for (int k = 0; k < 2048; ++k) s += pos[k] * w1[(size_t)k * 128 + hc]; ((float*)(ws + WS_B1))[i] = s; }
    for (long i = gt; i < 2 * 64 * 128; i += NGT) { const int kv = (int)(i >> 13), d = (int)((i >> 7) & 63), h = (int)(i & 127);
        ((bf16*)(ws + WS_W2T))[i] = (bf16)(pk2(a.in[I_CW2][(size_t)kv * 128 * 64 + h * 64 + d], 0.f) & 0xffffu); }
    for (long i = gt; i < 2048L * 32; i += NGT) { const int p = (int)(i >> 5), j = (int)(i & 31); const float fr = (float)pow(10000.0, -(double)j / 32.0); const float ang = (float)p * fr;
        ((float*)(ws + WS_ROPE))[i] = (float)cos((double)ang); ((float*)(ws + WS_ROPE))[65536 + i] = (float)sin((double)ang); }
    { const float* x = a.in[I_X]; bf16* XB = (bf16*)(ws + WS_XB); float* R1 = (float*)(ws + WS_R1);
      for (int m = gw; m < MTOK; m += NGW) { const GAS f32x4* xr = (const GAS f32x4*)(x + (size_t)m * DM) + lane; f32x4 v[4]; float s = 0.f;
#pragma unroll
          for (int j = 0; j < 4; ++j) { v[j] = xr[64 * j]; s += (v[j].x * v[j].x + v[j].y * v[j].y) + (v[j].z * v[j].z + v[j].w * v[j].w); }
          s = wave_sum(s); if (lane == 0) R1[m] = 1.0f / sqrtf(s * (1.0f / DM) + EPS);
          GAS v2u* o8 = (GAS v2u*)(XB + (size_t)m * DM) + lane;
#pragma unroll
          for (int j = 0; j < 4; ++j) o8[64 * j] = (v2u){pk2(v[j].x, v[j].y), pk2(v[j].z, v[j].w)}; } }
}

using pg8::Unit;
__device__ __forceinline__ v4u pack8(const f32x4& a, const f32x4& b) { v4u w; w.x = pk2(a[0], a[1]); w.y = pk2(a[2], a[3]); w.z = pk2(b[0], b[1]); w.w = pk2(b[2], b[3]); return w; }
__device__ __forceinline__ void unpack8(const v4u& w, f32x4& a, f32x4& b) { a = (f32x4){bflo(w.x), bfhi(w.x), bflo(w.y), bfhi(w.y)}; b = (f32x4){bflo(w.z), bfhi(w.z), bflo(w.w), bfhi(w.w)}; }

struct EpiIn {
    static constexpr bool PERM = true, AFTER_DRAIN = false;
    const float* r1; bf16* UPOOL; bf16* Q; bf16* KV; bf16* MG; float* NG; const float* qnw; const float* knw; const float* rope;
    __device__ __forceinline__ void operator()(const f32x4 (&acc)[2][2][4][2], const Unit& u, int wr, int wc, int fr, int fq) const {
        const int row0 = u.pm * 256 + wr * 64 + fr, pn = u.pn;
        if (pn < 2 || (pn >= 9 && pn < 17)) {
            const bool gate = pn >= 9; bf16* base = gate ? MG : UPOOL; const int ld = gate ? 2048 : 512; const int col0 = (gate ? 256 * (pn - 9) : 256 * pn) + 32 * wc + 8 * fq;
#pragma unroll
            for (int ai = 0; ai < 2; ++ai)
#pragma unroll
                for (int m = 0; m < 4; ++m) { const int row = row0 + ai * 128 + m * 16; const float rs = r1[row];
#pragma unroll
                    for (int bj = 0; bj < 2; ++bj) { f32x4 v0 = acc[ai][bj][m][0] * rs, v1 = acc[ai][bj][m][1] * rs;
                        if (gate) {
#pragma unroll
                            for (int i = 0; i < 4; ++i) { v0[i] = sigmoidf_(v0[i]); v1[i] = sigmoidf_(v1[i]); } }
                        *(v4u*)(base + (size_t)row * ld + col0 + 128 * bj) = pack8(v0, v1); } }
        } else if (pn < 9) {
            const bool isq = pn < 6; const int br = pn - 6, kvsel = wc >> 1, g = wc & 1; const bool donorm = isq || kvsel == 0;
            const float* nw = isq ? qnw : knw + br * 64;
            f32x4 w[2][2];
#pragma unroll
            for (int bj = 0; bj < 2; ++bj)
#pragma unroll
                for (int n = 0; n < 2; ++n) w[bj][n] = *(const f32x4*)(nw + 32 * bj + 8 * fq + 4 * n);
            const float osc = isq ? QSCALE : 1.0f;
            bf16* base = isq ? Q + (4 * (pn - 2) + wc) * 64 : KV + (size_t)(br * 2 + kvsel) * MTOK * 128 + g * 64; const int ld = isq ? 1024 : 128;
#pragma unroll
            for (int ai = 0; ai < 2; ++ai)
#pragma unroll
                for (int m = 0; m < 4; ++m) { const int row = row0 + ai * 128 + m * 16; const float rs = r1[row]; const int pos = row & (SEQ - 1);
                    f32x4 z[2][2]; float ss = 0.f;
#pragma unroll
                    for (int bj = 0; bj < 2; ++bj)
#pragma unroll
                        for (int n = 0; n < 2; ++n) { z[bj][n] = acc[ai][bj][m][n] * rs; const f32x4 t = z[bj][n]; ss += (t[0] * t[0] + t[1] * t[1]) + (t[2] * t[2] + t[3] * t[3]); }
                    if (donorm) {
                        ss += __shfl_xor(ss, 16); ss += __shfl_xor(ss, 32);
                        const float rn = 1.0f / sqrtf(ss * (1.0f / 64.0f) + EPS);
#pragma unroll
                        for (int n = 0; n < 2; ++n) { const f32x4 cs = *(const f32x4*)(rope + pos * 32 + 8 * fq + 4 * n), sn = *(const f32x4*)(rope + 65536 + pos * 32 + 8 * fq + 4 * n);
                            const f32x4 y0 = z[0][n] * rn * w[0][n], y1 = z[1][n] * rn * w[1][n];
                            z[0][n] = (y0 * cs - y1 * sn) * osc; z[1][n] = (y1 * cs + y0 * sn) * osc; }
                    }
#pragma unroll
                    for (int bj = 0; bj < 2; ++bj) *(v4u*)(base + (size_t)row * ld + 32 * bj + 8 * fq) = pack8(z[bj][0], z[bj][1]); }
        } else {
            if (wc < 2) {
#pragma unroll
                for (int ai = 0; ai < 2; ++ai)
#pragma unroll
                    for (int m = 0; m < 4; ++m) { const int row = row0 + ai * 128 + m * 16; const float rs = r1[row];
#pragma unroll
                        for (int n = 0; n < 2; ++n) { const int col = 32 * wc + 8 * fq + 4 * n; if (col < 48) { f32x4 v = acc[ai][0][m][n] * rs;
#pragma unroll
                                for (int i = 0; i < 4; ++i) v[i] = sigmoidf_(v[i]);
                                *(f32x4*)(NG + (size_t)row * 48 + col) = v; } } }
            }
        }
    }
};

struct EpiGate {
    static constexpr bool PERM = true, AFTER_DRAIN = false;
    const bf16* MG; bf16* PY; bf16* OUT; int first;
    __device__ __forceinline__ void operator()(const f32x4 (&acc)[2][2][4][2], const Unit& u, int wr, int wc, int fr, int fq) const {
        const int row0 = u.pm * 256 + wr * 64 + fr, col0 = 256 * u.pn + 32 * wc + 8 * fq;
#pragma unroll
        for (int ai = 0; ai < 2; ++ai)
#pragma unroll
            for (int m = 0; m < 4; ++m) { const int row = row0 + ai * 128 + m * 16;
#pragma unroll
                for (int bj = 0; bj < 2; ++bj) { const int col = col0 + 128 * bj; f32x4 g0, g1; unpack8(*(const v4u*)(MG + (size_t)row * 2048 + (first ? 0 : 1024) + col), g0, g1);
                    f32x4 v0 = acc[ai][bj][m][0] * g0, v1 = acc[ai][bj][m][1] * g1;
                    if (!first) { f32x4 p0, p1; unpack8(*(const v4u*)(PY + (size_t)row * 1024 + col), p0, p1); v0 += p0; v1 += p1; }
                    *(v4u*)((first ? PY : OUT) + (size_t)row * 1024 + col) = pack8(v0, v1); } }
    }
};

struct EpiWo {
    static constexpr bool PERM = true, AFTER_DRAIN = false;
    const float* x; float* out; bf16* X1B; float* ssq;
    __device__ __forceinline__ void operator()(const f32x4 (&acc)[2][2][4][2], const Unit& u, int wr, int wc, int fr, int fq) const {
        const int row0 = u.pm * 256 + wr * 64 + fr, col0 = 256 * u.pn + 32 * wc + 8 * fq;
#pragma unroll
        for (int ai = 0; ai < 2; ++ai)
#pragma unroll
            for (int m = 0; m < 4; ++m) { const int row = row0 + ai * 128 + m * 16; float ss = 0.f;
#pragma unroll
                for (int bj = 0; bj < 2; ++bj) { const size_t off = (size_t)row * 1024 + col0 + 128 * bj;
                    const f32x4 v0 = *(const f32x4*)(x + off) + acc[ai][bj][m][0], v1 = *(const f32x4*)(x + off + 4) + acc[ai][bj][m][1];
                    *(f32x4*)(out + off) = v0; *(f32x4*)(out + off + 4) = v1; *(v4u*)(X1B + off) = pack8(v0, v1);
                    ss += (v0[0] * v0[0] + v0[1] * v0[1]) + (v0[2] * v0[2] + v0[3] * v0[3]) + (v1[0] * v1[0] + v1[1] * v1[1]) + (v1[2] * v1[2] + v1[3] * v1[3]); }
                ss += __shfl_xor(ss, 16); ss += __shfl_xor(ss, 32);
                if (fq == 0) ssq[(size_t)row * 16 + u.pn * 4 + wc] = ss; }
    }
};

struct EpiUp {
    static constexpr bool PERM = true, AFTER_DRAIN = false;
    const float* r2; const float* cw; const float* cb; bf16* A; float* RAW;
    __device__ __forceinline__ void operator()(const f32x4 (&acc)[2][2][4][2], const Unit& u, int wr, int wc, int fr, int fq) const {
        const int lane = fr + 16 * fq, row0 = u.pm * 256 + wr * 64 + fr;
        const int chb = 128 * u.pn + 32 * wc + 8 * fq; const bool chok = chb < DFF;
        float rs[2][4];
#pragma unroll
        for (int ai = 0; ai < 2; ++ai)
#pragma unroll
            for (int m = 0; m < 4; ++m) rs[ai][m] = r2[row0 + ai * 128 + m * 16];
        const int l1 = (lane - 1) & 63, l2 = (lane - 2) & 63, l15 = (lane + 15) & 63, l14 = (lane + 14) & 63;
#pragma unroll
        for (int ai = 0; ai < 2; ++ai) {
            if (fr >= 14) { const int row = row0 + ai * 128 + 48;
#pragma unroll
                for (int bj = 0; bj < 2; ++bj)
#pragma unroll
                    for (int n = 0; n < 2; ++n) *(f32x4*)(RAW + ((size_t)(row >> 6) * 4 + (fr - 14)) * N_UP + 256 * u.pn + 128 * bj + 32 * wc + 8 * fq + 4 * n) = acc[ai][bj][3][n] * rs[ai][3]; }
            if (fr < 2) { const int row = row0 + ai * 128;
#pragma unroll
                for (int bj = 0; bj < 2; ++bj)
#pragma unroll
                    for (int n = 0; n < 2; ++n) *(f32x4*)(RAW + ((size_t)(row >> 6) * 4 + 2 + fr) * N_UP + 256 * u.pn + 128 * bj + 32 * wc + 8 * fq + 4 * n) = acc[ai][bj][0][n] * rs[ai][0]; }
        }
#pragma unroll
        for (int n = 0; n < 2; ++n)
#pragma unroll
            for (int hp = 0; hp < 2; ++hp) {
                asm volatile("" ::: "memory");
                const int ch = chb + 4 * n + 2 * hp; const int cg_ = chok ? ch : 0;
                float wgt[2][3][2], bia[2][2];
#pragma unroll
                for (int bj = 0; bj < 2; ++bj) { const float2 bb = *(const float2*)(cb + bj * DFF + cg_); bia[bj][0] = bb.x; bia[bj][1] = bb.y;
#pragma unroll
                    for (int t = 0; t < 3; ++t) { const float2 ww = *(const float2*)(cw + t * UPW + bj * DFF + cg_); wgt[bj][t][0] = ww.x; wgt[bj][t][1] = ww.y; } }
#pragma unroll
                for (int ai = 0; ai < 2; ++ai) {
                    float pvv[2][2] = {{0.f, 0.f}, {0.f, 0.f}};
#pragma unroll
                    for (int m = 0; m < 4; ++m) { const int row = row0 + ai * 128 + m * 16; float c_[2][2];
#pragma unroll
                        for (int bj = 0; bj < 2; ++bj)
#pragma unroll
                            for (int e = 0; e < 2; ++e) { const float cur = acc[ai][bj][m][n][2 * hp + e] * rs[ai][m];
                                const float a1 = __shfl(cur, l1), b1 = __shfl(pvv[bj][e], l15), a2 = __shfl(cur, l2), b2 = __shfl(pvv[bj][e], l14);
                                const float p1 = fr >= 1 ? a1 : b1, p2 = fr >= 2 ? a2 : b2;
                                c_[bj][e] = bia[bj][e] + wgt[bj][0][e] * p2 + wgt[bj][1][e] * p1 + wgt[bj][2][e] * cur; pvv[bj][e] = cur; }
                        const float o0 = c_[0][0] * sigmoidf_(c_[0][0]) * c_[1][0], o1 = c_[0][1] * sigmoidf_(c_[0][1]) * c_[1][1];
                        if (!chok) *(unsigned*)(A + (size_t)row * K_DN + ch) = 0u;
                        else if (!(m == 0 && fr < 2)) *(unsigned*)(A + (size_t)row * K_DN + ch) = pk2(o0, o1); }
                }
            }
    }
};

struct EpiDown {
    static constexpr bool PERM = true, AFTER_DRAIN = false;
    float* out;
    __device__ __forceinline__ void operator()(const f32x4 (&acc)[2][2][4][2], const Unit& u, int wr, int wc, int fr, int fq) const {
        const int row0 = u.pm * 256 + wr * 64 + fr, col0 = 256 * u.pn + 32 * wc + 8 * fq;
#pragma unroll
        for (int ai = 0; ai < 2; ++ai)
#pragma unroll
            for (int m = 0; m < 4; ++m) { const int row = row0 + ai * 128 + m * 16;
#pragma unroll
                for (int bj = 0; bj < 2; ++bj) { const size_t off = (size_t)row * 1024 + col0 + 128 * bj;
                    *(f32x4*)(out + off) = *(const f32x4*)(out + off) + acc[ai][bj][m][0]; *(f32x4*)(out + off + 4) = *(const f32x4*)(out + off + 4) + acc[ai][bj][m][1]; } }
    }
};

__device__ __forceinline__ float gelu_tanh(float x) { const float y = 0.7978845608028654f * (x + 0.044715f * x * x * x); const float e = __expf(2.0f * y); return 0.5f * x * (2.0f - 2.0f / (e + 1.0f)); }

__device__ __forceinline__ void p2_pool_compress(const Args& a, LAS unsigned char* lds, int vcu, int G) {
    const int tid = threadIdx.x, lane = tid & 63, wave = __builtin_amdgcn_readfirstlane(tid >> 6);
    unsigned char* ws = a.ws;
    const int gw = vcu * NWAVES + wave, NGW = G * NWAVES;
    {
        LAS unsigned char* wl = lds + wave * 4608;
        const bf16* W1T = (const bf16*)(ws + WS_W1T); const bf16* W2T = (const bf16*)(ws + WS_W2T); const float* B1 = (const float*)(ws + WS_B1);
        const int fr = lane & 15, fq = lane >> 4;
        for (int unit = gw; unit < 1024; unit += NGW) {
            const int kv = unit >> 9, rest = unit & 511, b = rest >> 4, g = (rest >> 3) & 1, n0 = 16 * (rest & 7);
            const int n = n0 + fr, nn = n < 126 ? n : 126;
            const bf16* arow = (const bf16*)(ws + WS_KV) + ((size_t)kv * MTOK + (size_t)b * SEQ + 16 * nn) * 128 + g * 64 + 8 * fq;
            const bf16* w1 = W1T + (size_t)kv * 128 * 2048 + (size_t)fr * 2048 + 8 * fq;
            f32x4 acc[8];
#pragma unroll
            for (int hb = 0; hb < 8; ++hb) acc[hb] = (f32x4){0.f, 0.f, 0.f, 0.f};
#pragma unroll 2
            for (int ks = 0; ks < 64; ++ks) {
                const bf16x8 bfrag = *(const bf16x8*)(arow + (ks >> 1) * 128 + (ks & 1) * 32);
#pragma unroll
                for (int hb = 0; hb < 8; ++hb) { const bf16x8 afrag = *(const bf16x8*)(w1 + (size_t)hb * 16 * 2048 + 32 * ks);
                    acc[hb] = __builtin_amdgcn_mfma_f32_16x16x32_bf16(afrag, bfrag, acc[hb], 0, 0, 0); }
            }
#pragma unroll
            for (int hb = 0; hb < 8; ++hb) { const f32x4 bv = *(const f32x4*)(B1 + kv * 128 + 16 * hb + 4 * fq); f32x4 h = acc[hb] + bv;
#pragma unroll
                for (int i = 0; i < 4; ++i) h[i] = gelu_tanh(h[i]);
                *(LAS v2u*)(wl + fr * 272 + (16 * hb + 4 * fq) * 2) = (v2u){pk2(h[0], h[1]), pk2(h[2], h[3])}; }
            LDS_WAIT(); asm volatile("" ::: "memory");
            f32x4 o[4];
#pragma unroll
            for (int db = 0; db < 4; ++db) o[db] = (f32x4){0.f, 0.f, 0.f, 0.f};
#pragma unroll
            for (int ks = 0; ks < 4; ++ks) { const bf16x8 bfrag = *(const LAS bf16x8*)(wl + fr * 272 + 64 * ks + 16 * fq);
#pragma unroll
                for (int db = 0; db < 4; ++db) { const bf16x8 afrag = *(const bf16x8*)(W2T + (size_t)kv * 64 * 128 + (16 * db + fr) * 128 + 32 * ks + 8 * fq);
                    o[db] = __builtin_amdgcn_mfma_f32_16x16x32_bf16(afrag, bfrag, o[db], 0, 0, 0); } }
            LDS_WAIT(); asm volatile("" ::: "memory");
            if (n < 127) { bf16* dst = (bf16*)(ws + WS_CMP) + (((size_t)kv * BATCH + b) * 2 + g) * 128 * 64 + (size_t)n * 64;
#pragma unroll
                for (int db = 0; db < 4; ++db) *(v2u*)(dst + 16 * db + 4 * fq) = (v2u){pk2(o[db][0], o[db][1]), pk2(o[db][2], o[db][3])}; }
        }
    }
    {
        const bf16* U = (const bf16*)(ws + WS_UPOOL); bf16* P = (bf16*)(ws + WS_POOLED);
        const long gt = (long)gw * 64 + lane, NGT = (long)NGW * 64;
        for (long it = gt; it < (long)MTOK * 64; it += NGT) { const int row = (int)(it >> 6), c8 = (int)(it & 63), t = row & (SEQ - 1), w = 2 << (c8 >> 4); const int cnt = (t + 1 < w) ? t + 1 : w;
            f32x4 s0 = (f32x4){0.f, 0.f, 0.f, 0.f}, s1 = s0, u0 = s0, u1 = s0;
            for (int p = 0; p < cnt; ++p) { f32x4 x0, x1; unpack8(*(const v4u*)(U + (size_t)(row - p) * 512 + c8 * 8), x0, x1); s0 += x0; s1 += x1; if (p == 0) { u0 = x0; u1 = x1; } }
            const float inv = 1.0f / (float)cnt;
            *(v4u*)(P + (size_t)row * 512 + c8 * 8) = pack8(s0 * inv - u0, s1 * inv - u1); }
    }
}

__device__ __forceinline__ void p5b_r2(const Args& a, int vcu, int G) {
    const long gt = ((long)vcu * NWAVES * 64) + threadIdx.x, NGT = (long)G * NWAVES * 64;
    const float* ssq = (const float*)(a.ws + WS_SSQ); float* R2 = (float*)(a.ws + WS_R1);
    for (long row = gt; row < MTOK; row += NGT) { const f32x4* p = (const f32x4*)(ssq + (size_t)row * 16); const f32x4 s = (p[0] + p[1]) + (p[2] + p[3]);
        R2[row] = 1.0f / sqrtf(((s[0] + s[1]) + (s[2] + s[3])) * (1.0f / DM) + EPS); }
}
__device__ __forceinline__ void p7_fixup(const Args& a, int vcu, int G) {
    const long gt = ((long)vcu * NWAVES * 64) + threadIdx.x, NGT = (long)G * NWAVES * 64;
    const float* RAW = (const float*)(a.ws + WS_RAW); bf16* A = (bf16*)(a.ws + WS_A); const float* cw = a.in[I_CONVW]; const float* cb = a.in[I_CONVB];
    for (long it = gt; it < 2048L * (DFF / 4); it += NGT) { const int c4 = (int)(it % (DFF / 4)), rk = (int)(it / (DFF / 4)), s = rk >> 1, k = rk & 1, ch = 4 * c4;
        const bool first = (s & 31) == 0; f32x4 c_[2];
#pragma unroll
        for (int bj = 0; bj < 2; ++bj) { const int col = 256 * (ch >> 7) + (ch & 127) + 128 * bj; const f32x4 z = (f32x4){0.f, 0.f, 0.f, 0.f};
            const f32x4 cur = *(const f32x4*)(RAW + ((size_t)s * 4 + 2 + k) * N_UP + col);
            const f32x4 t1 = first ? z : *(const f32x4*)(RAW + ((size_t)(s - 1) * 4 + 1) * N_UP + col), t0 = first ? z : *(const f32x4*)(RAW + ((size_t)(s - 1) * 4 + 0) * N_UP + col);
            const f32x4 r0 = *(const f32x4*)(RAW + ((size_t)s * 4 + 2) * N_UP + col);
            const f32x4 p1 = k == 1 ? r0 : t1, p2 = k == 1 ? t1 : t0;
            c_[bj] = *(const f32x4*)(cb + bj * DFF + ch) + *(const f32x4*)(cw + 0 * UPW + bj * DFF + ch) * p2 + *(const f32x4*)(cw + 1 * UPW + bj * DFF + ch) * p1 + *(const f32x4*)(cw + 2 * UPW + bj * DFF + ch) * cur; }
        f32x4 o;
#pragma unroll
        for (int i = 0; i < 4; ++i) o[i] = c_[0][i] * sigmoidf_(c_[0][i]) * c_[1][i];
        *(v2u*)(A + (size_t)(64 * s + k) * K_DN + ch) = (v2u){pk2(o[0], o[1]), pk2(o[2], o[3])}; }
}
namespace att {
constexpr int KBUF = 0, VBUF = 16384, OSTG = 32768, SLAB = 65536, SLABW = 4352, IMP = 102400, WSF = 108544, SELM = 110592;
__device__ __forceinline__ int crow(int r, int hi) { return (r & 3) + 8 * (r >> 2) + 4 * hi; }
#define SBAR() __builtin_amdgcn_sched_barrier(0)
__device__ __forceinline__ void glds16(const void* gsrc, unsigned lds_dst) { unsigned keep;
    asm volatile("s_mov_b32 %0, m0\n\ts_mov_b32 m0, %2\n\ts_nop 0\n\tglobal_load_lds_dwordx4 %1, off\n\ts_mov_b32 m0, %0" : "=&s"(keep) : "v"(gsrc), "s"(lds_dst) : "memory"); }
typedef float f32x2_t __attribute__((ext_vector_type(2))); typedef __bf16 bf16x2_t __attribute__((ext_vector_type(2)));
__device__ __forceinline__ unsigned cvtpk_s(float lo, float hi) { f32x2_t v = {lo, hi}; bf16x2_t b = __builtin_convertvector(v, bf16x2_t); return __builtin_bit_cast(unsigned, b); }
__device__ __forceinline__ void qkt(f32x16& p0, f32x16& p1, const LAS unsigned char* Kslot, const bf16x8* qr, const f32x16& cinit, int r32, int hi) {
    const LAS unsigned char* kb = Kslot + hi * 1024 + r32 * 16;
#pragma unroll
    for (int d0 = 0; d0 < 4; ++d0) {
        const bf16x8 b0 = *(const LAS bf16x8*)(kb + d0 * 2048);
        const bf16x8 b1 = *(const LAS bf16x8*)(kb + d0 * 2048 + 512);
        if (d0 == 0) { p0 = __builtin_amdgcn_mfma_f32_32x32x16_bf16(b0, qr[0], cinit, 0, 0, 0); p1 = __builtin_amdgcn_mfma_f32_32x32x16_bf16(b1, qr[0], cinit, 0, 0, 0); }
        else { p0 = __builtin_amdgcn_mfma_f32_32x32x16_bf16(b0, qr[d0], p0, 0, 0, 0); p1 = __builtin_amdgcn_mfma_f32_32x32x16_bf16(b1, qr[d0], p1, 0, 0, 0); } }
}
__device__ __forceinline__ void pv(f32x16* o, int vb, bf16x8 pa0, bf16x8 pa1, bf16x8 pa2, bf16x8 pa3) {
#pragma unroll
    for (int d0 = 0; d0 < 2; ++d0) { s16x4 lo[4], hi[4];
#pragma unroll
        for (int ks = 0; ks < 4; ++ks) {
            asm volatile("ds_read_b64_tr_b16 %0,%1 offset:%c2" : "=&v"(lo[ks]) : "v"(vb), "i"(d0 * 4096 + ks * 1024) : "memory");
            asm volatile("ds_read_b64_tr_b16 %0,%1 offset:%c2" : "=&v"(hi[ks]) : "v"(vb), "i"(d0 * 4096 + ks * 1024 + 512) : "memory"); }
        asm volatile("s_waitcnt lgkmcnt(0)" ::: "memory"); SBAR();
#define PK(k) (bf16x8){lo[k][0], lo[k][1], lo[k][2], lo[k][3], hi[k][0], hi[k][1], hi[k][2], hi[k][3]}
        o[d0] = __builtin_amdgcn_mfma_f32_32x32x16_bf16(pa0, PK(0), o[d0], 0, 0, 0);
        o[d0] = __builtin_amdgcn_mfma_f32_32x32x16_bf16(pa1, PK(1), o[d0], 0, 0, 0);
        o[d0] = __builtin_amdgcn_mfma_f32_32x32x16_bf16(pa2, PK(2), o[d0], 0, 0, 0);
        o[d0] = __builtin_amdgcn_mfma_f32_32x32x16_bf16(pa3, PK(3), o[d0], 0, 0, 0);
#undef PK
    }
}
__device__ __forceinline__ float rowmax(const f32x16& p0, const f32x16& p1) {
    float a = fmaxf(p0[0], p1[0]);
#pragma unroll
    for (int r = 1; r < 16; ++r) a = fmaxf(a, fmaxf(p0[r], p1[r]));
    return fmaxf(a, __shfl_xor(a, 32));
}
__device__ __forceinline__ void pack_p(const f32x16& p0, const f32x16& p1, bf16x8& pa0, bf16x8& pa1, bf16x8& pa2, bf16x8& pa3) {
    v4u w0 = {cvtpk_s(p0[0], p0[1]), cvtpk_s(p0[2], p0[3]), cvtpk_s(p0[4], p0[5]), cvtpk_s(p0[6], p0[7])};
    v4u w1 = {cvtpk_s(p0[8], p0[9]), cvtpk_s(p0[10], p0[11]), cvtpk_s(p0[12], p0[13]), cvtpk_s(p0[14], p0[15])};
    v4u w2 = {cvtpk_s(p1[0], p1[1]), cvtpk_s(p1[2], p1[3]), cvtpk_s(p1[4], p1[5]), cvtpk_s(p1[6], p1[7])};
    v4u w3 = {cvtpk_s(p1[8], p1[9]), cvtpk_s(p1[10], p1[11]), cvtpk_s(p1[12], p1[13]), cvtpk_s(p1[14], p1[15])};
    pa0 = __builtin_bit_cast(bf16x8, w0); pa1 = __builtin_bit_cast(bf16x8, w1); pa2 = __builtin_bit_cast(bf16x8, w2); pa3 = __builtin_bit_cast(bf16x8, w3);
}
#define WG_BAR() do { asm volatile("s_waitcnt vmcnt(0) lgkmcnt(0)" ::: "memory"); __builtin_amdgcn_s_barrier(); asm volatile("" ::: "memory"); } while (0)

template <int MODE>
__device__ __forceinline__ void stream_branch(f32x16 (&ofin)[2], const bf16x8 (&qr)[4], const bf16* Kg, const bf16* Vg, int thi, int tlo, int cur, int tq, unsigned selbits, float gate,
                                              LAS unsigned char* lds, unsigned lds0, int wid, int lane, int r32, int hi) {
    LAS float* wsf = (LAS float*)(lds + WSF) + wid * 64;
    const bf16* ksrc = Kg + (size_t)lane * 128 + wid * 8;
    const bf16* vsrc = Vg + (size_t)(16 * (wid & 3) + (lane >> 2)) * 128 + (wid >> 2) * 32 + (lane & 3) * 8;
    const unsigned kdst = lds0 + KBUF + wid * 1024, vdst = lds0 + VBUF + wid * 1024;
    const int vb0 = (int)(lds0 + VBUF) + ((lane >> 4) & 1) * 32 + (lane & 3) * 8 + (4 * hi + ((lane & 15) >> 2)) * 64;
    float mref = NEGBIG, lsum = 0.f; f32x16 o[2]; o[0] = f32x16{}; o[1] = f32x16{};
    const int nt = thi - tlo + 1;
    WG_BAR();
    glds16(ksrc + (size_t)thi * 64 * 128, (unsigned)__builtin_amdgcn_readfirstlane(kdst)); glds16(vsrc + (size_t)thi * 64 * 128, (unsigned)__builtin_amdgcn_readfirstlane(vdst));
    for (int i = 0; i < nt; ++i) {
        const int t = thi - i, buf = (i & 1) * 8192;
        WG_BAR();
        if (i + 1 < nt) { glds16(ksrc + (size_t)(t - 1) * 64 * 128, (unsigned)__builtin_amdgcn_readfirstlane(kdst + (8192 - buf))); glds16(vsrc + (size_t)(t - 1) * 64 * 128, (unsigned)__builtin_amdgcn_readfirstlane(vdst + (8192 - buf))); }
        f32x16 p0, p1;
        qkt(p0, p1, lds + KBUF + buf, qr, f32x16{}, r32, hi);
        if (MODE == 1) { const bool sel = (selbits >> t) & 1u;
#pragma unroll
            for (int r = 0; r < 16; ++r) { p0[r] = sel ? p0[r] : NEGBIG; p1[r] = sel ? p1[r] : NEGBIG; } }
        const bool edge = (t == cur) || (MODE == 2 && t == cur - 8);
        if (edge) {
            const int kb = 64 * t + 4 * hi, lo_ = (MODE == 2) ? tq - 511 : -(1 << 30);
#pragma unroll
            for (int r = 0; r < 16; ++r) { const int kp = kb + (r & 3) + 8 * (r >> 2); if (kp > tq || kp < lo_) p0[r] = NEGBIG; if (kp + 32 > tq || kp + 32 < lo_) p1[r] = NEGBIG; }
        }
        const float rm = rowmax(p0, p1);
        if (__any(rm > mref + 8.0f)) {
            const float mn = fmaxf(mref, rm), alpha = __builtin_amdgcn_exp2f(mref - mn);
            lsum *= alpha; mref = mn;
            if (hi == 0) wsf[r32] = alpha;
            LDS_WAIT(); asm volatile("" ::: "memory");
#pragma unroll
            for (int r = 0; r < 16; ++r) { const float f = wsf[crow(r, hi)]; o[0][r] *= f; o[1][r] *= f; }
            LDS_WAIT(); asm volatile("" ::: "memory");
        }
        float s = 0.f;
#pragma unroll
        for (int r = 0; r < 16; ++r) { p0[r] = __builtin_amdgcn_exp2f(p0[r] - mref); p1[r] = __builtin_amdgcn_exp2f(p1[r] - mref); s += p0[r] + p1[r]; }
        lsum += s;
        bf16x8 pa0, pa1, pa2, pa3; pack_p(p0, p1, pa0, pa1, pa2, pa3);
        pv(o, vb0 + buf, pa0, pa1, pa2, pa3);
    }
    const float lt = lsum + __shfl_xor(lsum, 32);
    if (hi == 0) wsf[r32] = gate / lt;
    LDS_WAIT(); asm volatile("" ::: "memory");
#pragma unroll
    for (int r = 0; r < 16; ++r) { const float f = wsf[crow(r, hi)]; ofin[0][r] += o[0][r] * f; ofin[1][r] += o[1][r] * f; }
    LDS_WAIT(); asm volatile("" ::: "memory");
}

__device__ __forceinline__ void attn_unit(const Args& a, int b, int g, int c, LAS unsigned char* lds) {
    int tid = threadIdx.x; asm volatile("" : "+v"(tid));
    const int lane = tid & 63, r32 = lane & 31, hi = lane >> 5; const int wid = __builtin_amdgcn_readfirstlane(tid >> 6);
    unsigned char* ws = a.ws;
    const unsigned lds0 = (unsigned)(uintptr_t)lds;
    const int head = g * 8 + wid, q0 = 32 * c, cur = c >> 1, tq = q0 + r32; const size_t m0 = (size_t)b * SEQ + q0;
    const bf16* Q = (const bf16*)(ws + WS_Q); const bf16* KVb = (const bf16*)(ws + WS_KV); const float* NG = (const float*)(ws + WS_NG);
    LAS float* wsf = (LAS float*)(lds + WSF) + wid * 64;
    LAS float* slab = (LAS float*)(lds + SLAB + wid * SLABW);
    LAS float* imp = (LAS float*)(lds + IMP);
    LAS unsigned* selm = (LAS unsigned*)(lds + SELM);
    bf16x8 qr[4];
#pragma unroll
    for (int d0 = 0; d0 < 4; ++d0) qr[d0] = *(const bf16x8*)(Q + (m0 + r32) * 1024 + head * 64 + d0 * 16 + hi * 8);
    const float g_c = NG[(m0 + r32) * 48 + head * 3 + 0], g_s = NG[(m0 + r32) * 48 + head * 3 + 1], g_w = NG[(m0 + r32) * 48 + head * 3 + 2];
    f32x16 ofin[2]; ofin[0] = f32x16{}; ofin[1] = f32x16{};
    {
        const int ntl = (c >= 32) ? 2 : 1;
        const bf16* KC = (const bf16*)(ws + WS_CMP) + (((size_t)0 * BATCH + b) * 2 + g) * 128 * 64;
        const bf16* VC = (const bf16*)(ws + WS_CMP) + (((size_t)1 * BATCH + b) * 2 + g) * 128 * 64;
        WG_BAR();
        if (tid < 32) selm[tid] = 0u;
        for (int t = 0; t < ntl; ++t) {
            glds16(KC + (size_t)(64 * t + lane) * 64 + wid * 8, (unsigned)__builtin_amdgcn_readfirstlane(lds0 + KBUF + t * 8192 + wid * 1024));
            glds16(VC + (size_t)(64 * t + 16 * (wid & 3) + (lane >> 2)) * 64 + (wid >> 2) * 32 + (lane & 3) * 8, (unsigned)__builtin_amdgcn_readfirstlane(lds0 + VBUF + t * 8192 + wid * 1024)); }
        WG_BAR();
        f32x16 s[4];
        qkt(s[0], s[1], lds + KBUF, qr, f32x16{}, r32, hi);
        if (ntl == 2) qkt(s[2], s[3], lds + KBUF + 8192, qr, f32x16{}, r32, hi);
        else {
#pragma unroll
            for (int r = 0; r < 16; ++r) { s[2][r] = NEGBIG; s[3][r] = NEGBIG; } }
        const int hiq = (tq - 31) >> 4;
#pragma unroll
        for (int k = 0; k < 4; ++k)
#pragma unroll
            for (int r = 0; r < 16; ++r) { const int n = 32 * k + crow(r, hi); if (n > hiq) s[k][r] = NEGBIG; }
        float mx = fmaxf(rowmax(s[0], s[1]), rowmax(s[2], s[3]));
        float sum = 0.f;
#pragma unroll
        for (int k = 0; k < 4; ++k)
#pragma unroll
            for (int r = 0; r < 16; ++r) { s[k][r] = __builtin_amdgcn_exp2f(s[k][r] - mx); sum += s[k][r]; }
        sum += __shfl_xor(sum, 32);
        const float inv = (hiq >= 0) ? 1.0f / sum : 0.f;
        float prevrecv = 0.f;
#pragma unroll
        for (int k = 0; k < 4; ++k)
#pragma unroll
            for (int a4 = 0; a4 < 4; ++a4) { const int idx = 4 * k + a4;
#pragma unroll
                for (int e = 0; e < 4; ++e) s[k][4 * a4 + e] *= inv;
                const float g4 = (s[k][4 * a4] + s[k][4 * a4 + 1]) + (s[k][4 * a4 + 2] + s[k][4 * a4 + 3]);
                const float recv = __shfl_xor(s[k][4 * a4 + 3], 32); const float add = hi ? recv : prevrecv; prevrecv = recv;
                slab[r32 * 33 + 2 * idx + hi] = g4 + add; }
#pragma unroll
        for (int k = 0; k < 4; ++k)
#pragma unroll
            for (int r = 0; r < 16; ++r) s[k][r] *= g_c;
        bf16x8 pa0, pa1, pa2, pa3;
        const int vb0 = (int)(lds0 + VBUF) + ((lane >> 4) & 1) * 32 + (lane & 3) * 8 + (4 * hi + ((lane & 15) >> 2)) * 64;
        pack_p(s[0], s[1], pa0, pa1, pa2, pa3); pv(ofin, vb0, pa0, pa1, pa2, pa3);
        if (ntl == 2) { pack_p(s[2], s[3], pa0, pa1, pa2, pa3); pv(ofin, vb0 + 8192, pa0, pa1, pa2, pa3); }
        WG_BAR();
        { const int q = tid >> 4, jp = tid & 15;
#pragma unroll
          for (int e = 0; e < 2; ++e) { const int j = 2 * jp + e; float t = 0.f;
#pragma unroll
              for (int w = 0; w < 8; ++w) t += ((LAS float*)(lds + SLAB + w * SLABW))[q * 33 + j];
              imp[q * 33 + j] = t; } }
        WG_BAR();
        { const int q = tid >> 4, jp = tid & 15, j0 = 2 * jp, j1 = j0 + 1;
          const float NINF = -1e30f;
          const float s0 = j0 <= cur ? imp[q * 33 + j0] + ((j0 == 0 || j0 == cur || j0 == cur - 1) ? 1000.f : 0.f) : NINF;
          const float s1 = j1 <= cur ? imp[q * 33 + j1] + ((j1 == 0 || j1 == cur || j1 == cur - 1) ? 1000.f : 0.f) : NINF;
          int rk0 = 0, rk1 = 0;
          for (int jj = 0; jj < 32; ++jj) { const float sj = jj <= cur ? imp[q * 33 + jj] + ((jj == 0 || jj == cur || jj == cur - 1) ? 1000.f : 0.f) : NINF;
              rk0 += (sj > s0 || (sj == s0 && jj < j0)) ? 1 : 0; rk1 += (sj > s1 || (sj == s1 && jj < j1)) ? 1 : 0; }
          const unsigned bits = (rk0 < 8 ? (1u << j0) : 0u) | (rk1 < 8 ? (1u << j1) : 0u);
          if (bits) atomicOr((unsigned*)(selm + q), bits); }
        WG_BAR();
    }
    const unsigned selbits = selm[r32];
    stream_branch<1>(ofin, qr, KVb + ((size_t)(1 * 2 + 0) * MTOK + (size_t)b * SEQ) * 128 + g * 64, KVb + ((size_t)(1 * 2 + 1) * MTOK + (size_t)b * SEQ) * 128 + g * 64,
                     cur, 0, cur, tq, selbits, g_s, lds, lds0, wid, lane, r32, hi);
    stream_branch<2>(ofin, qr, KVb + ((size_t)(2 * 2 + 0) * MTOK + (size_t)b * SEQ) * 128 + g * 64, KVb + ((size_t)(2 * 2 + 1) * MTOK + (size_t)b * SEQ) * 128 + g * 64,
                     cur, cur >= 8 ? cur - 8 : 0, cur, tq, 0u, g_w, lds, lds0, wid, lane, r32, hi);
    { LAS bf16* stg = (LAS bf16*)(lds + OSTG) + wid * 2048;
#pragma unroll
      for (int r = 0; r < 16; ++r) { const int orow = crow(r, hi);
#pragma unroll
          for (int d0 = 0; d0 < 2; ++d0) stg[orow * 64 + d0 * 32 + r32] = (bf16)(cvtpk_s(ofin[d0][r], 0.f) & 0xffffu); }
      LDS_WAIT(); asm volatile("" ::: "memory");
      bf16* Ow = (bf16*)(ws + WS_ATT) + m0 * 1024 + head * 64;
#pragma unroll
      for (int i = 0; i < 4; ++i) { const int row = i * 8 + (lane >> 3), ch = lane & 7; const v4u v = *(const LAS v4u*)(stg + row * 64 + ch * 8); *(v4u*)(Ow + (size_t)row * 1024 + ch * 8) = v; }
      LDS_WAIT(); asm volatile("" ::: "memory"); }
}

__device__ __forceinline__ void attn_phase(const Args& a, LAS unsigned char* lds, int vcu) {
    const int bg = vcu >> 2, qd = vcu & 3;
    for (int u = 0; u < 16; ++u) { const int i = qd + 4 * (u >> 2), k = u & 3; const int c = (k == 0) ? i : (k == 1) ? 31 - i : (k == 2) ? 32 + i : 63 - i;
        attn_unit(a, bg >> 1, bg & 1, c, lds); }
}
#undef SBAR
#undef WG_BAR
}
#ifndef MK_COOP
#define MK_COOP 1
#endif
constexpr int N_PHASES = 10;
__global__ void __launch_bounds__(NWAVES * 64, 2) fwd_megakernel(Args args) {
    extern __shared__ __attribute__((aligned(16))) unsigned char lds_raw[];
    LAS unsigned char* lds = (LAS unsigned char*)lds_raw;
    const int G = gridDim.x; const int bx = blockIdx.x; const int vcu = (G % 8 == 0) ? (bx % 8) * (G / 8) + bx / 8 : bx;
    unsigned char* ws = args.ws;
    const int lo = args.ph_lo, hi = args.ph_hi;
#ifndef PH_MASK
#define PH_MASK 0x3ff
#endif
#define PHON(k) (((PH_MASK) >> (k)) & 1)
#define IN(k) (PHON(k) && lo <= (k) && (k) < hi)
#if MK_COOP
    cg::grid_group grid = cg::this_grid();
#define GRID_BAR(k) do { if (IN(k) && IN((k) + 1)) { grid.sync(); } } while (0)
#else
#define GRID_BAR(k) do { } while (0)
#endif
    if (IN(0)) { p0_prologue(args, lds, vcu, G); }
    GRID_BAR(0);
    if (IN(1)) {
        pg8::Gemm g{(const bf16*)(ws + WS_XB), (const bf16*)(ws + WS_WIN), MTOK, N_IN, DM}; pg8::StaticOrder S; S.init(MTOK, N_IN, G, bx);
        EpiIn E{(const float*)(ws + WS_R1), (bf16*)(ws + WS_UPOOL), (bf16*)(ws + WS_Q), (bf16*)(ws + WS_KV), (bf16*)(ws + WS_MG), (float*)(ws + WS_NG), args.in[I_QNW], args.in[I_KNW], (const float*)(ws + WS_ROPE)};
        pg8::gemm_phase<EpiIn, pg8::StaticOrder, true, true>(lds, g, S, E);
    }
    GRID_BAR(1);
    if (IN(2)) { p2_pool_compress(args, lds, vcu, G); }
    GRID_BAR(2);
    if (IN(3)) { __syncthreads(); att::attn_phase(args, lds, vcu); }
    GRID_BAR(3);
    if (IN(4)) {
        { pg8::Gemm g{(const bf16*)(ws + WS_POOLED), (const bf16*)(ws + WS_WPB), MTOK, DM, 512}; pg8::StaticOrder S; S.init(MTOK, DM, G, bx);
          EpiGate E{(const bf16*)(ws + WS_MG), (bf16*)(ws + WS_PY), (bf16*)(ws + WS_MERGED), 1};
          pg8::gemm_phase<EpiGate, pg8::StaticOrder, true, true>(lds, g, S, E); }
        { pg8::Gemm g{(const bf16*)(ws + WS_ATT), (const bf16*)(ws + WS_WAB), MTOK, DM, DM}; pg8::StaticOrder S; S.init(MTOK, DM, G, bx);
          EpiGate E{(const bf16*)(ws + WS_MG), (bf16*)(ws + WS_PY), (bf16*)(ws + WS_MERGED), 0};
          pg8::gemm_phase<EpiGate, pg8::StaticOrder, true, true>(lds, g, S, E); }
    }
    GRID_BAR(4);
    if (IN(5)) {
        pg8::Gemm g{(const bf16*)(ws + WS_MERGED), (const bf16*)(ws + WS_WO), MTOK, DM, DM}; pg8::StaticOrder S; S.init(MTOK, DM, G, bx);
        EpiWo E{args.in[I_X], args.out, (bf16*)(ws + WS_X1B), (float*)(ws + WS_SSQ)};
        pg8::gemm_phase<EpiWo, pg8::StaticOrder, true, true>(lds, g, S, E);
    }
    GRID_BAR(5);
    if (IN(6)) { p5b_r2(args, vcu, G); }
    GRID_BAR(6);
    if (IN(7)) {
        pg8::Gemm g{(const bf16*)(ws + WS_X1B), (const bf16*)(ws + WS_WUP), MTOK, N_UP, DM}; pg8::StaticOrder S; S.init(MTOK, N_UP, G, bx);
        EpiUp E{(const float*)(ws + WS_R1), args.in[I_CONVW], args.in[I_CONVB], (bf16*)(ws + WS_A), (float*)(ws + WS_RAW)};
        pg8::gemm_phase<EpiUp, pg8::StaticOrder, true, true>(lds, g, S, E);
    }
    GRID_BAR(7);
    if (IN(8)) { p7_fixup(args, vcu, G); }
    GRID_BAR(8);
    if (IN(9)) {
        pg8::Gemm g{(const bf16*)(ws + WS_A), (const bf16*)(ws + WS_WDN), MTOK, DM, K_DN}; pg8::StaticOrder S; S.init(MTOK, DM, G, bx);
        EpiDown E{args.out};
        pg8::gemm_phase<EpiDown, pg8::StaticOrder, true, true>(lds, g, S, E);
    }
#undef IN
#undef GRID_BAR
}

extern "C" void kernel_launch(void* const* d_in, const int* in_sizes, int n_in, void* d_out, int out_size, void* d_ws, size_t ws_size, hipStream_t stream) {
    static int grid = 0;
    if (grid == 0) {
        if (n_in != 19 || in_sizes[0] != MTOK * DM || out_size != MTOK * DM || ws_size < WS_END) {
            fprintf(stderr, "kernel_launch: unexpected shapes: n_in %d in0 %d out %d ws %zu (need %zu)\n", n_in, n_in > 0 ? in_sizes[0] : -1, out_size, ws_size, (size_t)WS_END); grid = -1; return; }
        int dev = 0, cus = 0, per_cu = 0;
        hipGetDevice(&dev); hipDeviceGetAttribute(&cus, hipDeviceAttributeMultiprocessorCount, dev);
        if (hipFuncSetAttribute((const void*)fwd_megakernel, hipFuncAttributeMaxDynamicSharedMemorySize, LDS_BYTES) != hipSuccess) { fprintf(stderr, "kernel_launch: hipFuncSetAttribute failed\n"); grid = -1; return; }
        if (hipOccupancyMaxActiveBlocksPerMultiprocessor(&per_cu, (const void*)fwd_megakernel, NWAVES * 64, LDS_BYTES) != hipSuccess || per_cu < 1) { fprintf(stderr, "kernel_launch: occupancy query says %d\n", per_cu); per_cu = 1; }
        (void)hipGetLastError();
        grid = cus;
        if (grid != 256) fprintf(stderr, "kernel_launch: note: %d CUs (built for 256)\n", grid);
    }
    if (grid < 0) return;
    Args a{};
    for (int i = 0; i < 19; ++i) a.in[i] = (const float*)d_in[i];
    a.out = (float*)d_out; a.ws = (unsigned char*)d_ws;
#if MK_COOP
    a.ph_lo = 0; a.ph_hi = N_PHASES;
    void* kargs[] = {&a};
    hipError_t e = hipLaunchCooperativeKernel((const void*)fwd_megakernel, dim3(grid), dim3(NWAVES * 64), kargs, LDS_BYTES, stream);
    if (e != hipSuccess) fprintf(stderr, "kernel_launch: cooperative launch failed: %s (grid %d)\n", hipGetErrorString(e), grid);
#else
    for (int p = 0; p < N_PHASES; ++p) { a.ph_lo = p; a.ph_hi = p + 1; hipLaunchKernelGGL(fwd_megakernel, dim3(grid), dim3(NWAVES * 64), LDS_BYTES, stream, a); }
#endif
}
```

```cpp
#include <hip/hip_runtime.h>
#include <hip/hip_cooperative_groups.h>
#include <cstdio>
#include <cstdint>
namespace cg = cooperative_groups;
namespace pg8 {
#define PG8_LAS __attribute__((address_space(3)))
typedef unsigned short bf16_t;
typedef short bf16x8 __attribute__((ext_vector_type(8)));
typedef float f32x4 __attribute__((ext_vector_type(4)));
typedef unsigned u32x4 __attribute__((ext_vector_type(4)));
constexpr int BM = 256, BK = 64, HALF = 128, HTB = HALF * BK * 2  , STAGE_BYTES = 8 * HTB, NXCD = 8, WGM = 8;

__host__ __device__ __forceinline__ int lds_byte(int r, int c) { const int st = (r >> 4) * 2 + (c >> 5), rr = r & 15, cc = c & 31, ob = rr * 64 + cc * 2; return st * 1024 + (ob ^ (((ob >> 9) & 1) << 5)); }
__host__ __device__ __forceinline__ void stage_rc(int b, int& R, int& C) { const int st = b / 1024, sb = b % 1024, swz = sb ^ (((sb >> 9) & 1) << 5); R = (st >> 1) * 16 + swz / 64; C = (st & 1) * 32 + (swz % 64) / 2; }
__host__ __device__ __forceinline__ int perm32(int rho) { const int n = rho >> 4, i = rho & 15; return 8 * (i >> 2) + 4 * n + (i & 3); }

struct Unit { int pm, pn; };
struct Gemm { const bf16_t* A; const bf16_t* Bt; int M, N, K; };

struct StaticOrder {
    int nM, nN, nwg, G, c;
    __host__ __device__ void init(int M, int N, int G_, int c_) { nM = M / BM; nN = N / BM; nwg = nM * nN; G = G_; c = c_; }
    __host__ __device__ bool next(int i, Unit& u) const {
        const long L = (long)i * G + c; if (L >= nwg) return false;
        int wgid = (int)L; { const int q = nwg / NXCD, r = nwg % NXCD, xcd = wgid % NXCD, off = wgid / NXCD; wgid = (xcd < r ? xcd * (q + 1) : r * (q + 1) + (xcd - r) * q) + off; }
        const int nig = WGM * nN, gid = wgid / nig, fm = gid * WGM, gsz = (nM - fm) < WGM ? (nM - fm) : WGM;
        u.pm = fm + ((wgid % nig) % gsz); u.pn = (wgid % nig) / gsz; return true;
    }
    __device__ __forceinline__ void a_ready(const Unit&) const {}
    __device__ __forceinline__ void done(const Unit&) const {}
};

__device__ __forceinline__ unsigned cvt_pk_bf16(float lo, float hi) { unsigned r; asm volatile("v_cvt_pk_bf16_f32 %0, %1, %2" : "=v"(r) : "v"(lo), "v"(hi)); return r; }
typedef float f32x2 __attribute__((ext_vector_type(2)));
template <class Epi, class Sched, bool ALIGN_EPI = false, bool SP2 = false>
__device__ __forceinline__ void gemm_phase(PG8_LAS unsigned char* lds, const Gemm g, const Sched& S, const Epi& E) {
    const int tid = threadIdx.x, wid = __builtin_amdgcn_readfirstlane(tid >> 6), lane = tid & 63, wr = wid >> 2, wc = wid & 3, fr = lane & 15, fq = lane >> 4;
    const int K = g.K, nt = K / BK;
    unsigned voffA[2], voffB[2];
#pragma unroll
    for (int i = 0; i < 2; ++i) { int R, C; stage_rc(tid * 16 + i * 8192, R, C); const int Rb = Epi::PERM ? ((R & ~31) + perm32(R & 31)) : R;
        voffA[i] = (unsigned)(R * K + C) * 2u; voffB[i] = (unsigned)(Rb * K + C) * 2u; }
    const size_t kstep = (size_t)(BK * 2);
    const size_t hstep = (size_t)HALF * K * 2;
    const size_t tstep = 2 * hstep;
    const unsigned ldsw = (unsigned)wid * 1024u;
    const int aoff = lds_byte(wr * 64 + fr, fq * 8), boff = lds_byte(wc * 32 + fr, fq * 8);
#define PG8_SA(b, h) (((b) * 2 + (h)) * HTB)
#define PG8_SB(b, h) ((4 + (b) * 2 + (h)) * HTB)
#define PG8_STAGE(bufoff, gbase, voff) do { _Pragma("unroll") for (int _i = 0; _i < 2; ++_i) \
        __builtin_amdgcn_global_load_lds((const unsigned*)((const char*)(gbase) + (voff)[_i]), (PG8_LAS unsigned*)(lds + (bufoff) + ldsw + _i * 8192), 16, 0, 0); } while (0)
#define PG8_LDA(dst, b, h) do { _Pragma("unroll") for (int m = 0; m < 4; ++m) _Pragma("unroll") for (int k = 0; k < 2; ++k) dst[m][k] = *(const PG8_LAS bf16x8*)(lds + PG8_SA(b, h) + aoff + m * 2048 + k * 1024); } while (0)
#define PG8_LDB(dst, b, h) do { _Pragma("unroll") for (int n = 0; n < 2; ++n) _Pragma("unroll") for (int k = 0; k < 2; ++k) dst[n][k] = *(const PG8_LAS bf16x8*)(lds + PG8_SB(b, h) + boff + n * 2048 + k * 1024); } while (0)
#define PG8_MMA(ai, bj, At, Bt) do { __builtin_amdgcn_s_setprio(1); _Pragma("unroll") for (int m = 0; m < 4; ++m) _Pragma("unroll") for (int n = 0; n < 2; ++n) _Pragma("unroll") for (int k = 0; k < 2; ++k) \
        acc[ai][bj][m][n] = __builtin_amdgcn_mfma_f32_16x16x32_bf16(Bt[n][k], At[m][k], acc[ai][bj][m][n], 0, 0, 0); __builtin_amdgcn_s_setprio(0); } while (0)
#define PG8_WAIT_V(n) asm volatile("s_waitcnt vmcnt(" #n ")" ::: "memory")
#define PG8_WAIT_L(n) asm volatile("s_waitcnt lgkmcnt(" #n ")" ::: "memory")
#define PG8_BAR __builtin_amdgcn_s_barrier()
#define PG8_SCHED __builtin_amdgcn_sched_barrier(0)
    Unit cur, nxt; int ui = 0;
    if (!S.next(0, cur)) return;
    f32x4 acc[2][2][4][2];
#pragma unroll
    for (int a = 0; a < 2; ++a)
#pragma unroll
        for (int b = 0; b < 2; ++b)
#pragma unroll
            for (int m = 0; m < 4; ++m)
#pragma unroll
                for (int n = 0; n < 2; ++n) acc[a][b][m][n] = (f32x4){0.f, 0.f, 0.f, 0.f};
    bf16x8 At[4][2], B0[2][2], B1[2][2];
    const char* cA = (const char*)g.A + (size_t)cur.pm * tstep; const char* cB = (const char*)g.Bt + (size_t)cur.pn * tstep;
    S.a_ready(cur);
    if constexpr (SP2) {
        PG8_STAGE(PG8_SB(0, 0), cB, voffB); PG8_STAGE(PG8_SB(0, 1), cB + hstep, voffB); PG8_STAGE(PG8_SA(0, 0), cA, voffA); PG8_STAGE(PG8_SA(0, 1), cA + hstep, voffA);
        if (wr == 1) PG8_BAR;
        PG8_WAIT_V(2); PG8_BAR;
        PG8_STAGE(PG8_SB(1, 0), cB + kstep, voffB); PG8_STAGE(PG8_SA(1, 0), cA + kstep, voffA); PG8_STAGE(PG8_SB(1, 1), cB + hstep + kstep, voffB);
        PG8_WAIT_V(6); PG8_BAR;
    } else {
        PG8_STAGE(PG8_SB(0, 0), cB, voffB); PG8_STAGE(PG8_SA(0, 0), cA, voffA); PG8_STAGE(PG8_SB(0, 1), cB + hstep, voffB); PG8_STAGE(PG8_SA(0, 1), cA + hstep, voffA);
        if (wr == 1) PG8_BAR;
        PG8_WAIT_V(4); PG8_BAR;
        PG8_STAGE(PG8_SB(1, 0), cB + kstep, voffB); PG8_STAGE(PG8_SA(1, 0), cA + kstep, voffA); PG8_STAGE(PG8_SB(1, 1), cB + hstep + kstep, voffB);
        PG8_WAIT_V(6); PG8_BAR;
    }
    for (;;) {
        const bool has_next = S.next(ui + 1, nxt);
        const char* nA = has_next ? (const char*)g.A + (size_t)nxt.pm * tstep : cA; const char* nB = has_next ? (const char*)g.Bt + (size_t)nxt.pn * tstep : cB;
        for (int t = 0; t < nt; t += 2) {
            const bool last = (t == nt - 2);
            const char* a1 = cA + (size_t)(t + 1) * kstep;
            const char* a2 = last ? nA : cA + (size_t)(t + 2) * kstep; const char* b2 = last ? nB : cB + (size_t)(t + 2) * kstep;
            const char* a3 = a2 + kstep; const char* b3 = b2 + kstep;
            if (last && has_next) S.a_ready(nxt);
            if constexpr (SP2) {
            PG8_LDB(B0, 0, 0); PG8_LDB(B1, 0, 1); PG8_SCHED; PG8_LDA(At, 0, 0); PG8_STAGE(PG8_SA(1, 1), a1 + hstep, voffA);
            PG8_WAIT_V(8); PG8_WAIT_L(0); PG8_BAR; PG8_MMA(0, 0, At, B0); PG8_MMA(0, 1, At, B1); PG8_BAR; PG8_SCHED;
            PG8_LDA(At, 0, 1); PG8_STAGE(PG8_SB(0, 0), b2, voffB); PG8_STAGE(PG8_SB(0, 1), b2 + hstep, voffB); PG8_STAGE(PG8_SA(0, 0), a2, voffA);
            PG8_WAIT_V(8); PG8_WAIT_L(0); PG8_BAR; PG8_MMA(1, 0, At, B0); PG8_MMA(1, 1, At, B1); PG8_BAR; PG8_SCHED;
            PG8_LDB(B0, 1, 0); PG8_LDB(B1, 1, 1); PG8_SCHED; PG8_LDA(At, 1, 0); PG8_STAGE(PG8_SA(0, 1), a2 + hstep, voffA);
            PG8_WAIT_V(8); PG8_WAIT_L(0); PG8_BAR; PG8_MMA(0, 0, At, B0); PG8_MMA(0, 1, At, B1); PG8_BAR; PG8_SCHED;
            PG8_LDA(At, 1, 1); PG8_STAGE(PG8_SB(1, 0), b3, voffB); PG8_STAGE(PG8_SB(1, 1), b3 + hstep, voffB); PG8_STAGE(PG8_SA(1, 0), a3, voffA);
            PG8_WAIT_V(8); PG8_WAIT_L(0); PG8_BAR; PG8_MMA(1, 0, At, B0); PG8_MMA(1, 1, At, B1); PG8_BAR; PG8_SCHED;
            } else {
            PG8_LDB(B0, 0, 0); PG8_SCHED; PG8_LDA(At, 0, 0); PG8_STAGE(PG8_SA(1, 1), a1 + hstep, voffA);
            PG8_WAIT_L(8); PG8_BAR; PG8_WAIT_L(0); PG8_MMA(0, 0, At, B0); PG8_BAR; PG8_SCHED;
            PG8_LDB(B1, 0, 1); PG8_STAGE(PG8_SB(0, 0), b2, voffB);
            PG8_BAR; PG8_WAIT_L(0); PG8_MMA(0, 1, At, B1); PG8_BAR;
            PG8_LDA(At, 0, 1); PG8_STAGE(PG8_SA(0, 0), a2, voffA);
            PG8_BAR; PG8_WAIT_L(0); PG8_MMA(1, 0, At, B0); PG8_BAR; PG8_SCHED;
            PG8_STAGE(PG8_SB(0, 1), b2 + hstep, voffB);
            PG8_WAIT_V(6); PG8_BAR; PG8_MMA(1, 1, At, B1); PG8_BAR;
            PG8_LDB(B0, 1, 0); PG8_SCHED; PG8_LDA(At, 1, 0); PG8_STAGE(PG8_SA(0, 1), a2 + hstep, voffA);
            PG8_WAIT_L(8); PG8_BAR; PG8_WAIT_L(0); PG8_MMA(0, 0, At, B0); PG8_BAR; PG8_SCHED;
            PG8_LDB(B1, 1, 1); PG8_STAGE(PG8_SB(1, 0), b3, voffB);
            PG8_BAR; PG8_WAIT_L(0); PG8_MMA(0, 1, At, B1); PG8_BAR;
            PG8_LDA(At, 1, 1); PG8_STAGE(PG8_SA(1, 0), a3, voffA);
            PG8_BAR; PG8_WAIT_L(0); PG8_MMA(1, 0, At, B0); PG8_BAR; PG8_SCHED;
            PG8_STAGE(PG8_SB(1, 1), b3 + hstep, voffB);
            PG8_WAIT_V(6); PG8_BAR; PG8_MMA(1, 1, At, B1); PG8_BAR;
            }
        }
        if constexpr (ALIGN_EPI) { if (wr == 0) PG8_BAR; }
        if constexpr (!Epi::AFTER_DRAIN) { E(acc, cur, wr, wc, fr, fq); S.done(cur); }
        if (!has_next) break;
#pragma unroll
        for (int a = 0; a < 2; ++a)
#pragma unroll
            for (int b = 0; b < 2; ++b)
#pragma unroll
                for (int m = 0; m < 4; ++m)
#pragma unroll
                    for (int n = 0; n < 2; ++n) acc[a][b][m][n] = (f32x4){0.f, 0.f, 0.f, 0.f};
        cur = nxt; cA = nA; cB = nB; ++ui;
        if constexpr (ALIGN_EPI) { if (wr == 1) PG8_BAR; }
    }
    PG8_WAIT_V(0);
    if constexpr (!ALIGN_EPI) { if (wr == 0) PG8_BAR; }
    PG8_BAR;
    if constexpr (Epi::AFTER_DRAIN) { E.fused(acc, cur, wr, wc, fr, fq, lds, wid, lane); S.done(cur); }
#undef PG8_SA
#undef PG8_SB
#undef PG8_STAGE
#undef PG8_LDA
#undef PG8_LDB
#undef PG8_MMA
#undef PG8_WAIT_V
#undef PG8_WAIT_L
#undef PG8_BAR
#undef PG8_SCHED
}
}
constexpr int BATCH = 32, SEQ = 2048, DM = 1024, MTOK = BATCH * SEQ;
constexpr int IN_W = 4400, N_IN = 4608, DFF = 2752, N_UP = 5632, K_DN = 2816, UPW = 5504;
constexpr float EPS = 1e-6f, QSCALE = 0.125f * 1.4426950408889634f, NEGBIG = -1e30f;
constexpr size_t MiB = 1u << 20;
constexpr size_t WS_CTL = 0, CTL_ZERO_BYTES = 1 * MiB;
constexpr size_t WS_WIN = 2 * MiB, WS_WPB = 11 * MiB, WS_WAB = 12 * MiB, WS_WO = 14 * MiB, WS_WUP = 16 * MiB, WS_WDN = 27 * MiB, WS_W1T = 33 * MiB;
constexpr size_t WS_W2T = 34 * MiB, WS_B1 = 34 * MiB + 65536, WS_ROPE = 35 * MiB, WS_R1 = 36 * MiB, WS_SSQ = 37 * MiB, WS_CMP = 41 * MiB, WS_NG = 44 * MiB, WS_RAW = 56 * MiB;
constexpr size_t WS_XB = 144 * MiB, WS_UPOOL = 272 * MiB, WS_Q = 336 * MiB, WS_KV = 464 * MiB, WS_MG = 560 * MiB, WS_POOLED = 816 * MiB, WS_ATT = 880 * MiB, WS_END = 1008 * MiB;
constexpr size_t WS_PY = WS_Q, WS_MERGED = WS_XB, WS_X1B = WS_Q, WS_A = WS_KV;
constexpr int LDS_BYTES = 147456, NWAVES = 8;

#define GAS __attribute__((address_space(1)))
#define LAS __attribute__((address_space(3)))
typedef unsigned short bf16;
typedef unsigned v4u __attribute__((ext_vector_type(4)));
typedef unsigned v2u __attribute__((ext_vector_type(2)));
typedef float f32x4 __attribute__((ext_vector_type(4)));
typedef float f32x16 __attribute__((ext_vector_type(16)));
typedef short bf16x8 __attribute__((ext_vector_type(8)));
typedef short s16x4 __attribute__((ext_vector_type(4)));
#define LDS_WAIT() asm volatile("s_waitcnt lgkmcnt(0)" ::: "memory")
#define VM_WAIT() asm volatile("s_waitcnt vmcnt(0)" ::: "memory")
__device__ __forceinline__ unsigned pk2(float lo, float hi) { return pg8::cvt_pk_bf16(lo, hi); }
__device__ __forceinline__ float bflo(unsigned w) { return __uint_as_float(w << 16); }
__device__ __forceinline__ float bfhi(unsigned w) { return __uint_as_float(w & 0xffff0000u); }
__device__ __forceinline__ float sigmoidf_(float z) { return 1.0f / (1.0f + __expf(-z)); }
__device__ __forceinline__ float wave_sum(float v) {
#pragma unroll
    for (int o = 1; o < 64; o <<= 1) v += __shfl_xor(v, o);
    return v;
}

struct Args {
    const float* in[19];
    float* out; unsigned char* ws;
    int ph_lo, ph_hi;
};
enum { I_X = 0, I_ANW, I_WIN, I_POOLW, I_POOLS, I_QNW, I_KNW, I_CPOS, I_CW1, I_CB1, I_CW2, I_WPB, I_WAB, I_WO, I_FNW, I_WUP, I_CONVW, I_CONVB, I_WDN };

struct MapId { __device__ __forceinline__ int operator()(int s) const { return s; } };
struct MapIn { __device__ __forceinline__ int operator()(int s) const {
    if (s < 512) return s;
    if (s < 1536) { const int t = s - 512, hq = t >> 6, d = t & 63; return 256 * (2 + (hq >> 2)) + 128 * (d >> 5) + 32 * (hq & 3) + (d & 31); }
    if (s < 2304) { const int t = s - 1536, u = t >> 6, d = t & 63; return 256 * (6 + (u >> 2)) + 128 * (d >> 5) + 32 * (u & 3) + (d & 31); }
    if (s < 2352) return 256 * 17 + (s - 2304);
    return 256 * 9 + (s - 2352); } };
struct MapUp { __device__ __forceinline__ int operator()(int s) const { const int ch = s < DFF ? s : s - DFF; const int base = 256 * (ch >> 7) + (ch & 127); return s < DFF ? base : base + 128; } };

template <class RowMap>
__device__ __forceinline__ void transpose_item(const float* W, int N, bf16* WT, int ldk, const float* kscale, LAS float* scr, int item, int lane, RowMap rm) {
    const int nblk = (N + 31) / 32, kb = item / nblk, nb = item % nblk, k0 = 64 * kb, n0 = 32 * nb;
    const int nsrc = n0 + (lane & 31); const bool nok = nsrc < N;
#pragma unroll 8
    for (int i = 0; i < 32; ++i) { const int kk = 2 * i + (lane >> 5); float v = nok ? W[(size_t)(k0 + kk) * N + nsrc] : 0.f; if (kscale) v *= kscale[k0 + kk]; scr[kk * 33 + (lane & 31)] = v; }
    LDS_WAIT(); asm volatile("" ::: "memory");
    const int c = lane & 7;
#pragma unroll
    for (int j = 0; j < 4; ++j) { const int n = (lane >> 3) + 8 * j; const LAS float* s = scr + (8 * c) * 33 + n;
        v4u o; o.x = pk2(s[0 * 33], s[1 * 33]); o.y = pk2(s[2 * 33], s[3 * 33]); o.z = pk2(s[4 * 33], s[5 * 33]); o.w = pk2(s[6 * 33], s[7 * 33]);
        if (n0 + n < N) *(GAS v4u*)(WT + (size_t)rm(n0 + n) * ldk + k0 + 8 * c) = o; }
    LDS_WAIT(); asm volatile("" ::: "memory");
}

__device__ __forceinline__ void p0_prologue(const Args& a, LAS unsigned char* lds, int vcu, int G) {
    const int tid = threadIdx.x, lane = tid & 63, wave = __builtin_amdgcn_readfirstlane(tid >> 6);
    unsigned char* ws = a.ws;
    LAS float* scr = (LAS float*)(lds + wave * 16384);
    const int gw = vcu * NWAVES + wave, NGW = G * NWAVES;
    const long gt = (long)gw * 64 + lane, NGT = (long)NGW * 64;
    bf16* WIN = (bf16*)(ws + WS_WIN); bf16* WUP = (bf16*)(ws + WS_WUP); bf16* WDN = (bf16*)(ws + WS_WDN);
    constexpr int I_IN = 16 * 138, I_AB = 16 * 32, I_O = 16 * 32, I_UP = 16 * 172, I_DN = 43 * 32, I_C1 = 32 * 4;
    constexpr int NITEMS = I_IN + I_AB + I_O + I_UP + I_DN + 2 * I_C1;
    for (int it = gw; it < NITEMS; it += NGW) {
        int r = it;
        if (r < I_IN) { transpose_item(a.in[I_WIN], IN_W, WIN, DM, a.in[I_ANW], scr, r, lane, MapIn()); continue; } r -= I_IN;
        if (r < I_AB) { transpose_item(a.in[I_WAB], DM, (bf16*)(ws + WS_WAB), DM, nullptr, scr, r, lane, MapId()); continue; } r -= I_AB;
        if (r < I_O) { transpose_item(a.in[I_WO], DM, (bf16*)(ws + WS_WO), DM, nullptr, scr, r, lane, MapId()); continue; } r -= I_O;
        if (r < I_UP) { transpose_item(a.in[I_WUP], UPW, WUP, DM, a.in[I_FNW], scr, r, lane, MapUp()); continue; } r -= I_UP;
        if (r < I_DN) { transpose_item(a.in[I_WDN], DM, WDN, K_DN, nullptr, scr, r, lane, MapId()); continue; } r -= I_DN;
        if (r < I_C1) { transpose_item(a.in[I_CW1], 128, (bf16*)(ws + WS_W1T), 2048, nullptr, scr, r, lane, MapId()); continue; } r -= I_C1;
        transpose_item(a.in[I_CW1] + 2048 * 128, 128, (bf16*)(ws + WS_W1T) + 128 * 2048, 2048, nullptr, scr, r, lane, MapId());
    }
    for (long i = gt; i < 208L * DM / 8; i += NGT) *(GAS v4u*)(WIN + (size_t)(256 * 17 + 48) * DM + i * 8) = (v4u){0u, 0u, 0u, 0u};
    for (long i = gt; i < 128L * DM / 8; i += NGT) { const long e = i * 8; const int rr = (int)(e / DM), cc = (int)(e % DM); const int row = 256 * 21 + (rr < 64 ? 64 + rr : 192 + (rr - 64));
        *(GAS v4u*)(WUP + (size_t)row * DM + cc) = (v4u){0u, 0u, 0u, 0u}; }
    for (long i = gt; i < 1024L * 8; i += NGT) { const int row = (int)(i >> 3), c8 = (int)(i & 7); *(GAS v4u*)(WDN + (size_t)row * K_DN + DFF + c8 * 8) = (v4u){0u, 0u, 0u, 0u}; }
    for (long i = gt; i < 128L * 8; i += NGT) { const int t = (int)(i >> 3), c8 = (int)(i & 7); *(GAS v4u*)((bf16*)(ws + WS_CMP) + ((size_t)t * 128 + 127) * 64 + c8 * 8) = (v4u){0u, 0u, 0u, 0u}; }
    { const float* pw = a.in[I_POOLW]; const float* ps = a.in[I_POOLS]; const float* wb = a.in[I_WPB]; bf16* WPB = (bf16*)(ws + WS_WPB);
      for (long i = gt; i < 512L * 256; i += NGT) { const int n4 = (int)(i & 255) * 4, k = __builtin_amdgcn_readfirstlane((int)(i >> 8)), g = k >> 7; f32x4 s = (f32x4){0.f, 0.f, 0.f, 0.f};
          const float* pwr = pw + (size_t)k * 128; const float* psr = ps + g * 128; const float* wbr = wb + (size_t)(g * 128) * 1024 + n4;
#pragma unroll 8
          for (int d = 0; d < 128; ++d) s += (pwr[d] * psr[d]) * *(const f32x4*)(wbr + (size_t)d * 1024);
#pragma unroll
          for (int e = 0; e < 4; ++e) WPB[(size_t)(n4 + e) * 512 + k] = (bf16)(pk2(s[e], 0.f) & 0xffffu); } }
    for (int i = gw; i < 256; i += NGW) { const int kv = i >> 7, hc = i & 127; const float* w1 = a.in[I_CW1] + (size_t)kv * 2048 * 128; const float* pos = a.in[I_CPOS] + kv * 2048;
        float s = 0.f; for (int k = lane; k < 2048; k += 64) s += pos[k] * w1[(size_t)k * 128 + hc];
        s = wave_sum(s); if (lane == 0) ((float*)(ws + WS_B1))[i] = s + a.in[I_CB1][kv * 128 + hc]; }
    for (long i = gt; i < 2 * 64 * 128; i += NGT) { const int kv = (int)(i >> 13), d = (int)((i >> 7) & 63), h = (int)(i & 127);
        ((bf16*)(ws + WS_W2T))[i] = (bf16)(pk2(a.in[I_CW2][(size_t)kv * 128 * 64 + h * 64 + d], 0.f) & 0xffffu); }
    for (long i = gt; i < 2048L * 32; i += NGT) { const int p = (int)(i >> 5), j = (int)(i & 31); const float fr = (float)pow(10000.0, -(double)j / 32.0); const float ang = (float)p * fr;
        ((float*)(ws + WS_ROPE))[i] = (float)cos((double)ang); ((float*)(ws + WS_ROPE))[65536 + i] = (float)sin((double)ang); }
    { const float* x = a.in[I_X]; bf16* XB = (bf16*)(ws + WS_XB); float* R1 = (float*)(ws + WS_R1);
      for (int m4 = gw * 4; m4 < MTOK; m4 += NGW * 4) { f32x4 v[4][4]; float s[4];
#pragma unroll
          for (int r = 0; r < 4; ++r) { const GAS f32x4* xr = (const GAS f32x4*)(x + (size_t)(m4 + r) * DM) + lane;
#pragma unroll
              for (int j = 0; j < 4; ++j) v[r][j] = __builtin_nontemporal_load(xr + 64 * j); }
#pragma unroll
          for (int r = 0; r < 4; ++r) { s[r] = 0.f;
#pragma unroll
              for (int j = 0; j < 4; ++j) s[r] += (v[r][j].x * v[r][j].x + v[r][j].y * v[r][j].y) + (v[r][j].z * v[r][j].z + v[r][j].w * v[r][j].w); }
#pragma unroll
          for (int o = 1; o < 64; o <<= 1) {
#pragma unroll
              for (int r = 0; r < 4; ++r) s[r] += __shfl_xor(s[r], o); }
          if (lane < 4) R1[m4 + lane] = 1.0f / sqrtf((lane == 0 ? s[0] : lane == 1 ? s[1] : lane == 2 ? s[2] : s[3]) * (1.0f / DM) + EPS);
#pragma unroll
          for (int r = 0; r < 4; ++r) { GAS v2u* o8 = (GAS v2u*)(XB + (size_t)(m4 + r) * DM) + lane;
#pragma unroll
              for (int j = 0; j < 4; ++j) o8[64 * j] = (v2u){pk2(v[r][j].x, v[r][j].y), pk2(v[r][j].z, v[r][j].w)}; } } }
}

using pg8::Unit;
__device__ __forceinline__ v4u pack8(const f32x4& a, const f32x4& b) { v4u w; w.x = pk2(a[0], a[1]); w.y = pk2(a[2], a[3]); w.z = pk2(b[0], b[1]); w.w = pk2(b[2], b[3]); return w; }
__device__ __forceinline__ void unpack8(const v4u& w, f32x4& a, f32x4& b) { a = (f32x4){bflo(w.x), bfhi(w.x), bflo(w.y), bfhi(w.y)}; b = (f32x4){bflo(w.z), bfhi(w.z), bflo(w.w), bfhi(w.w)}; }

struct EpiIn {
    static constexpr bool PERM = true, AFTER_DRAIN = false;
    const float* r1; bf16* UPOOL; bf16* Q; bf16* KV; bf16* MG; float* NG; const float* qnw; const float* knw; const float* rope;
    __device__ __forceinline__ void operator()(const f32x4 (&acc)[2][2][4][2], const Unit& u, int wr, int wc, int fr, int fq) const {
        const int row0 = u.pm * 256 + wr * 64 + fr, pn = u.pn;
        if (pn < 2 || (pn >= 9 && pn < 17)) {
            const bool gate = pn >= 9; bf16* base = gate ? MG : UPOOL; const int ld = gate ? 2048 : 512; const int col0 = (gate ? 256 * (pn - 9) : 256 * pn) + 32 * wc + 8 * fq;
#pragma unroll
            for (int ai = 0; ai < 2; ++ai)
#pragma unroll
                for (int m = 0; m < 4; ++m) { const int row = row0 + ai * 128 + m * 16; const float rs = r1[row];
#pragma unroll
                    for (int bj = 0; bj < 2; ++bj) { f32x4 v0 = acc[ai][bj][m][0] * rs, v1 = acc[ai][bj][m][1] * rs;
                        if (gate) {
#pragma unroll
                            for (int i = 0; i < 4; ++i) { v0[i] = sigmoidf_(v0[i]); v1[i] = sigmoidf_(v1[i]); } }
                        *(v4u*)(base + (size_t)row * ld + col0 + 128 * bj) = pack8(v0, v1); } }
        } else if (pn < 9) {
            const bool isq = pn < 6; const int br = pn - 6, kvsel = wc >> 1, g = wc & 1; const bool donorm = isq || kvsel == 0;
            const float* nw = isq ? qnw : knw + br * 64;
            f32x4 w[2][2];
#pragma unroll
            for (int bj = 0; bj < 2; ++bj)
#pragma unroll
                for (int n = 0; n < 2; ++n) w[bj][n] = *(const f32x4*)(nw + 32 * bj + 8 * fq + 4 * n);
            const float osc = isq ? QSCALE : 1.0f;
            bf16* base = isq ? Q + (4 * (pn - 2) + wc) * 64 : KV + (size_t)(br * 2 + kvsel) * MTOK * 128 + g * 64; const int ld = isq ? 1024 : 128;
#pragma unroll
            for (int ai = 0; ai < 2; ++ai)
#pragma unroll
                for (int m = 0; m < 4; ++m) { const int row = row0 + ai * 128 + m * 16; const float rs = r1[row]; const int pos = row & (SEQ - 1);
                    f32x4 z[2][2]; float ss = 0.f;
#pragma unroll
                    for (int bj = 0; bj < 2; ++bj)
#pragma unroll
                        for (int n = 0; n < 2; ++n) { z[bj][n] = acc[ai][bj][m][n] * rs; const f32x4 t = z[bj][n]; ss += (t[0] * t[0] + t[1] * t[1]) + (t[2] * t[2] + t[3] * t[3]); }
                    if (donorm) {
                        ss += __shfl_xor(ss, 16); ss += __shfl_xor(ss, 32);
                        const float rn = 1.0f / sqrtf(ss * (1.0f / 64.0f) + EPS);
#pragma unroll
                        for (int n = 0; n < 2; ++n) { const f32x4 cs = *(const f32x4*)(rope + pos * 32 + 8 * fq + 4 * n), sn = *(const f32x4*)(rope + 65536 + pos * 32 + 8 * fq + 4 * n);
                            const f32x4 y0 = z[0][n] * rn * w[0][n], y1 = z[1][n] * rn * w[1][n];
                            z[0][n] = (y0 * cs - y1 * sn) * osc; z[1][n] = (y1 * cs + y0 * sn) * osc; }
                    }
#pragma unroll
                    for (int bj = 0; bj < 2; ++bj) *(v4u*)(base + (size_t)row * ld + 32 * bj + 8 * fq) = pack8(z[bj][0], z[bj][1]); }
        } else {
            if (wc < 2) {
#pragma unroll
                for (int ai = 0; ai < 2; ++ai)
#pragma unroll
                    for (int m = 0; m < 4; ++m) { const int row = row0 + ai * 128 + m * 16; const float rs = r1[row];
#pragma unroll
                        for (int n = 0; n < 2; ++n) { const int col = 32 * wc + 8 * fq + 4 * n; if (col < 48) { f32x4 v = acc[ai][0][m][n] * rs;
#pragma unroll
                                for (int i = 0; i < 4; ++i) v[i] = sigmoidf_(v[i]);
                                *(f32x4*)(NG + (size_t)row * 48 + col) = v; } } }
            }
        }
    }
};

struct EpiGate {
    static constexpr bool PERM = true, AFTER_DRAIN = false;
    const bf16* MG; bf16* PY; bf16* OUT; int first;
    __device__ __forceinline__ void operator()(const f32x4 (&acc)[2][2][4][2], const Unit& u, int wr, int wc, int fr, int fq) const {
        const int row0 = u.pm * 256 + wr * 64 + fr, col0 = 256 * u.pn + 32 * wc + 8 * fq;
#pragma unroll
        for (int ai = 0; ai < 2; ++ai)
#pragma unroll
            for (int m = 0; m < 4; ++m) { const int row = row0 + ai * 128 + m * 16;
#pragma unroll
                for (int bj = 0; bj < 2; ++bj) { const int col = col0 + 128 * bj; f32x4 g0, g1; unpack8(*(const v4u*)(MG + (size_t)row * 2048 + (first ? 0 : 1024) + col), g0, g1);
                    f32x4 v0 = acc[ai][bj][m][0] * g0, v1 = acc[ai][bj][m][1] * g1;
                    if (!first) { f32x4 p0, p1; unpack8(*(const v4u*)(PY + (size_t)row * 1024 + col), p0, p1); v0 += p0; v1 += p1; }
                    *(v4u*)((first ? PY : OUT) + (size_t)row * 1024 + col) = pack8(v0, v1); } }
    }
};

struct EpiWo {
    static constexpr bool PERM = true, AFTER_DRAIN = false;
    const float* x; float* out; bf16* X1B; float* ssq;
    __device__ __forceinline__ void operator()(const f32x4 (&acc)[2][2][4][2], const Unit& u, int wr, int wc, int fr, int fq) const {
        const int row0 = u.pm * 256 + wr * 64 + fr, col0 = 256 * u.pn + 32 * wc + 8 * fq;
#pragma unroll
        for (int ai = 0; ai < 2; ++ai)
#pragma unroll
            for (int m = 0; m < 4; ++m) { const int row = row0 + ai * 128 + m * 16; float ss = 0.f;
#pragma unroll
                for (int bj = 0; bj < 2; ++bj) { const size_t off = (size_t)row * 1024 + col0 + 128 * bj;
                    const f32x4 v0 = *(const f32x4*)(x + off) + acc[ai][bj][m][0], v1 = *(const f32x4*)(x + off + 4) + acc[ai][bj][m][1];
                    *(f32x4*)(out + off) = v0; *(f32x4*)(out + off + 4) = v1; *(v4u*)(X1B + off) = pack8(v0, v1);
                    ss += (v0[0] * v0[0] + v0[1] * v0[1]) + (v0[2] * v0[2] + v0[3] * v0[3]) + (v1[0] * v1[0] + v1[1] * v1[1]) + (v1[2] * v1[2] + v1[3] * v1[3]); }
                ss += __shfl_xor(ss, 16); ss += __shfl_xor(ss, 32);
                if (fq == 0) ssq[(size_t)row * 16 + u.pn * 4 + wc] = ss; }
    }
};

struct EpiUp {
    static constexpr bool PERM = true, AFTER_DRAIN = false;
    const float* r2; const float* cw; const float* cb; bf16* A; float* RAW;
    __device__ __forceinline__ void operator()(const f32x4 (&acc)[2][2][4][2], const Unit& u, int wr, int wc, int fr, int fq) const {
        const int lane = fr + 16 * fq, row0 = u.pm * 256 + wr * 64 + fr;
        const int chb = 128 * u.pn + 32 * wc + 8 * fq; const bool chok = chb < DFF;
        float rs[2][4];
#pragma unroll
        for (int ai = 0; ai < 2; ++ai)
#pragma unroll
            for (int m = 0; m < 4; ++m) rs[ai][m] = r2[row0 + ai * 128 + m * 16];
        const int l1 = (lane - 1) & 63, l2 = (lane - 2) & 63, l15 = (lane + 15) & 63, l14 = (lane + 14) & 63;
#pragma unroll
        for (int ai = 0; ai < 2; ++ai) {
            if (fr >= 14) { const int row = row0 + ai * 128 + 48;
#pragma unroll
                for (int bj = 0; bj < 2; ++bj)
#pragma unroll
                    for (int n = 0; n < 2; ++n) *(f32x4*)(RAW + ((size_t)(row >> 6) * 4 + (fr - 14)) * N_UP + 256 * u.pn + 128 * bj + 32 * wc + 8 * fq + 4 * n) = acc[ai][bj][3][n] * rs[ai][3]; }
            if (fr < 2) { const int row = row0 + ai * 128;
#pragma unroll
                for (int bj = 0; bj < 2; ++bj)
#pragma unroll
                    for (int n = 0; n < 2; ++n) *(f32x4*)(RAW + ((size_t)(row >> 6) * 4 + 2 + fr) * N_UP + 256 * u.pn + 128 * bj + 32 * wc + 8 * fq + 4 * n) = acc[ai][bj][0][n] * rs[ai][0]; }
        }
#pragma unroll
        for (int n = 0; n < 2; ++n)
#pragma unroll
            for (int hp = 0; hp < 2; ++hp) {
                asm volatile("" ::: "memory");
                const int ch = chb + 4 * n + 2 * hp; const int cg_ = chok ? ch : 0;
                float wgt[2][3][2], bia[2][2];
#pragma unroll
                for (int bj = 0; bj < 2; ++bj) { const float2 bb = *(const float2*)(cb + bj * DFF + cg_); bia[bj][0] = bb.x; bia[bj][1] = bb.y;
#pragma unroll
                    for (int t = 0; t < 3; ++t) { const float2 ww = *(const float2*)(cw + t * UPW + bj * DFF + cg_); wgt[bj][t][0] = ww.x; wgt[bj][t][1] = ww.y; } }
#pragma unroll
                for (int ai = 0; ai < 2; ++ai) {
                    float pvv[2][2] = {{0.f, 0.f}, {0.f, 0.f}};
#pragma unroll
                    for (int m = 0; m < 4; ++m) { const int row = row0 + ai * 128 + m * 16; float c_[2][2];
#pragma unroll
                        for (int bj = 0; bj < 2; ++bj)
#pragma unroll
                            for (int e = 0; e < 2; ++e) { const float cur = acc[ai][bj][m][n][2 * hp + e] * rs[ai][m];
                                const float a1 = __shfl(cur, l1), b1 = __shfl(pvv[bj][e], l15), a2 = __shfl(cur, l2), b2 = __shfl(pvv[bj][e], l14);
                                const float p1 = fr >= 1 ? a1 : b1, p2 = fr >= 2 ? a2 : b2;
                                c_[bj][e] = bia[bj][e] + wgt[bj][0][e] * p2 + wgt[bj][1][e] * p1 + wgt[bj][2][e] * cur; pvv[bj][e] = cur; }
                        const float o0 = c_[0][0] * sigmoidf_(c_[0][0]) * c_[1][0], o1 = c_[0][1] * sigmoidf_(c_[0][1]) * c_[1][1];
                        if (!chok) *(unsigned*)(A + (size_t)row * K_DN + ch) = 0u;
                        else if (!(m == 0 && fr < 2)) *(unsigned*)(A + (size_t)row * K_DN + ch) = pk2(o0, o1); }
                }
            }
    }
};

struct EpiDown {
    static constexpr bool PERM = true, AFTER_DRAIN = false;
    float* out;
    __device__ __forceinline__ void operator()(const f32x4 (&acc)[2][2][4][2], const Unit& u, int wr, int wc, int fr, int fq) const {
        const int row0 = u.pm * 256 + wr * 64 + fr, col0 = 256 * u.pn + 32 * wc + 8 * fq;
#pragma unroll
        for (int ai = 0; ai < 2; ++ai)
#pragma unroll
            for (int m = 0; m < 4; ++m) { const int row = row0 + ai * 128 + m * 16;
#pragma unroll
                for (int bj = 0; bj < 2; ++bj) { const size_t off = (size_t)row * 1024 + col0 + 128 * bj;
                    *(f32x4*)(out + off) = *(const f32x4*)(out + off) + acc[ai][bj][m][0]; *(f32x4*)(out + off + 4) = *(const f32x4*)(out + off + 4) + acc[ai][bj][m][1]; } }
    }
};

__device__ __forceinline__ float gelu_tanh(float x) { const float y = 0.7978845608028654f * (x + 0.044715f * x * x * x); const float e = __expf(2.0f * y); return 0.5f * x * (2.0f - 2.0f / (e + 1.0f)); }

__device__ __forceinline__ void p2_pool_compress(const Args& a, LAS unsigned char* lds, int vcu, int G) {
    const int tid = threadIdx.x, lane = tid & 63, wave = __builtin_amdgcn_readfirstlane(tid >> 6);
    unsigned char* ws = a.ws;
    const int gw = vcu * NWAVES + wave, NGW = G * NWAVES;
    {
        LAS unsigned char* wl = lds + wave * 4608;
        const bf16* W1T = (const bf16*)(ws + WS_W1T); const bf16* W2T = (const bf16*)(ws + WS_W2T); const float* B1 = (const float*)(ws + WS_B1);
        const int fr = lane & 15, fq = lane >> 4;
        for (int unit = wave * G + vcu; unit < 1024; unit += NGW) {
            const int kv = unit >> 9, rest = unit & 511, b = rest >> 4, g = (rest >> 3) & 1, n0 = 16 * (rest & 7);
            const int n = n0 + fr, nn = n < 126 ? n : 126;
            const bf16* arow = (const bf16*)(ws + WS_KV) + ((size_t)kv * MTOK + (size_t)b * SEQ + 16 * nn) * 128 + g * 64 + 8 * fq;
            const bf16* w1 = W1T + (size_t)kv * 128 * 2048 + (size_t)fr * 2048 + 8 * fq;
            f32x4 acc[8];
#pragma unroll
            for (int hb = 0; hb < 8; ++hb) acc[hb] = (f32x4){0.f, 0.f, 0.f, 0.f};
#pragma unroll 4
            for (int ks = 0; ks < 64; ++ks) {
                const bf16x8 bfrag = *(const bf16x8*)(arow + (ks >> 1) * 128 + (ks & 1) * 32);
#pragma unroll
                for (int hb = 0; hb < 8; ++hb) { const bf16x8 afrag = *(const bf16x8*)(w1 + (size_t)hb * 16 * 2048 + 32 * ks);
                    acc[hb] = __builtin_amdgcn_mfma_f32_16x16x32_bf16(afrag, bfrag, acc[hb], 0, 0, 0); }
            }
#pragma unroll
            for (int hb = 0; hb < 8; ++hb) { const f32x4 bv = *(const f32x4*)(B1 + kv * 128 + 16 * hb + 4 * fq); f32x4 h = acc[hb] + bv;
#pragma unroll
                for (int i = 0; i < 4; ++i) h[i] = gelu_tanh(h[i]);
                *(LAS v2u*)(wl + fr * 272 + (16 * hb + 4 * fq) * 2) = (v2u){pk2(h[0], h[1]), pk2(h[2], h[3])}; }
            LDS_WAIT(); asm volatile("" ::: "memory");
            f32x4 o[4];
#pragma unroll
            for (int db = 0; db < 4; ++db) o[db] = (f32x4){0.f, 0.f, 0.f, 0.f};
#pragma unroll
            for (int ks = 0; ks < 4; ++ks) { const bf16x8 bfrag = *(const LAS bf16x8*)(wl + fr * 272 + 64 * ks + 16 * fq);
#pragma unroll
                for (int db = 0; db < 4; ++db) { const bf16x8 afrag = *(const bf16x8*)(W2T + (size_t)kv * 64 * 128 + (16 * db + fr) * 128 + 32 * ks + 8 * fq);
                    o[db] = __builtin_amdgcn_mfma_f32_16x16x32_bf16(afrag, bfrag, o[db], 0, 0, 0); } }
            LDS_WAIT(); asm volatile("" ::: "memory");
            if (n < 127) { bf16* dst = (bf16*)(ws + WS_CMP) + (((size_t)kv * BATCH + b) * 2 + g) * 128 * 64 + (size_t)n * 64;
#pragma unroll
                for (int db = 0; db < 4; ++db) *(v2u*)(dst + 16 * db + 4 * fq) = (v2u){pk2(o[db][0], o[db][1]), pk2(o[db][2], o[db][3])}; }
        }
    }
    {
        const bf16* U = (const bf16*)(ws + WS_UPOOL); bf16* P = (bf16*)(ws + WS_POOLED);
        const long gt = (long)gw * 64 + lane, NGT = (long)NGW * 64;
#define POOL_GROUP(GI, W) \
        for (long it = gt; it < (long)MTOK * 16; it += NGT) { const int row = (int)(it >> 4), c8 = (GI) * 16 + (int)(it & 15), t = row & (SEQ - 1); const int cnt = (t + 1 < (W)) ? t + 1 : (W); \
            v4u raw[W]; \
            _Pragma("unroll") for (int p = 0; p < (W); ++p) raw[p] = *(const v4u*)(U + (size_t)(row - (p < cnt ? p : 0)) * 512 + c8 * 8); \
            f32x4 s0 = (f32x4){0.f, 0.f, 0.f, 0.f}, s1 = s0, u0, u1; unpack8(raw[0], u0, u1); \
            _Pragma("unroll") for (int p = 0; p < (W); ++p) { f32x4 x0, x1; unpack8(raw[p], x0, x1); const float m = p < cnt ? 1.f : 0.f; s0 += x0 * m; s1 += x1 * m; } \
            const float inv = 1.0f / (float)cnt; \
            *(v4u*)(P + (size_t)row * 512 + c8 * 8) = pack8(s0 * inv - u0, s1 * inv - u1); }
        POOL_GROUP(0, 2) POOL_GROUP(1, 4) POOL_GROUP(2, 8) POOL_GROUP(3, 16)
#undef POOL_GROUP
    }
}

__device__ __forceinline__ void p5b_r2(const Args& a, int vcu, int G) {
    const long gt = ((long)vcu * NWAVES * 64) + threadIdx.x, NGT = (long)G * NWAVES * 64;
    const float* ssq = (const float*)(a.ws + WS_SSQ); float* R2 = (float*)(a.ws + WS_R1);
    for (long row = gt; row < MTOK; row += NGT) { const f32x4* p = (const f32x4*)(ssq + (size_t)row * 16); const f32x4 s = (p[0] + p[1]) + (p[2] + p[3]);
        R2[row] = 1.0f / sqrtf(((s[0] + s[1]) + (s[2] + s[3])) * (1.0f / DM) + EPS); }
}
__device__ __forceinline__ void p7_fixup(const Args& a, int vcu, int G) {
    const long gt = ((long)vcu * NWAVES * 64) + threadIdx.x, NGT = (long)G * NWAVES * 64;
    const float* RAW = (const float*)(a.ws + WS_RAW); bf16* A = (bf16*)(a.ws + WS_A); const float* cw = a.in[I_CONVW]; const float* cb = a.in[I_CONVB];
    for (long it = gt; it < 2048L * (DFF / 4); it += NGT) { const int c4 = (int)(it % (DFF / 4)), rk = (int)(it / (DFF / 4)), s = rk >> 1, k = rk & 1, ch = 4 * c4;
        const bool first = (s & 31) == 0; f32x4 c_[2];
#pragma unroll
        for (int bj = 0; bj < 2; ++bj) { const int col = 256 * (ch >> 7) + (ch & 127) + 128 * bj; const f32x4 z = (f32x4){0.f, 0.f, 0.f, 0.f};
            const f32x4 cur = *(const f32x4*)(RAW + ((size_t)s * 4 + 2 + k) * N_UP + col);
            const f32x4 t1 = first ? z : *(const f32x4*)(RAW + ((size_t)(s - 1) * 4 + 1) * N_UP + col), t0 = first ? z : *(const f32x4*)(RAW + ((size_t)(s - 1) * 4 + 0) * N_UP + col);
            const f32x4 r0 = *(const f32x4*)(RAW + ((size_t)s * 4 + 2) * N_UP + col);
            const f32x4 p1 = k == 1 ? r0 : t1, p2 = k == 1 ? t1 : t0;
            c_[bj] = *(const f32x4*)(cb + bj * DFF + ch) + *(const f32x4*)(cw + 0 * UPW + bj * DFF + ch) * p2 + *(const f32x4*)(cw + 1 * UPW + bj * DFF + ch) * p1 + *(const f32x4*)(cw + 2 * UPW + bj * DFF + ch) * cur; }
        f32x4 o;
#pragma unroll
        for (int i = 0; i < 4; ++i) o[i] = c_[0][i] * sigmoidf_(c_[0][i]) * c_[1][i];
        *(v2u*)(A + (size_t)(64 * s + k) * K_DN + ch) = (v2u){pk2(o[0], o[1]), pk2(o[2], o[3])}; }
}
#define XB_TMO      128
#define XB_XCNT(j)  (256  + 64 * (j))
#define XB_XSUB(j)  (1280 + 64 * (j))
#define XB_XGEN(j)  (2304 + 64 * (j))
#define XB_TOP      3328
#define XB_TOPGEN   3392
#define XCD_BAR_WORDS 3456
#define XB_SPIN_CAP (1u << 18)

__device__ __forceinline__ unsigned xb_ld(unsigned* p)              { return __hip_atomic_load(p, __ATOMIC_RELAXED, __HIP_MEMORY_SCOPE_AGENT); }
__device__ __forceinline__ unsigned xb_add(unsigned* p, unsigned v) { return __hip_atomic_fetch_add(p, v, __ATOMIC_RELAXED, __HIP_MEMORY_SCOPE_AGENT); }
__device__ __forceinline__ unsigned xb_xcc_id() { return (unsigned)__builtin_amdgcn_s_getreg((3 << 11) | 20) & 0xFu; }
#define XB_SPIN(cond, bar) do { unsigned _sp = 0; while (cond) { __builtin_amdgcn_s_sleep(1); \
    if ((++_sp & 255u) == 0u) { if (xb_ld(&(bar)[XB_TMO])) break; if (_sp > XB_SPIN_CAP) { atomicAdd(&(bar)[XB_TMO], 1u); break; } } } } while (0)

struct XcdBarrier {
    unsigned* bar; unsigned x;
    volatile LAS unsigned* st;
};

__device__ __forceinline__ XcdBarrier xcd_barrier_post(unsigned* bar, volatile LAS unsigned* st) {
    XcdBarrier b; b.bar = bar; b.x = xb_xcc_id(); b.st = st;
    if (threadIdx.x == 0) (void)xb_add(&bar[XB_XCNT(b.x)], 1u);
    return b;
}
__device__ __forceinline__ void xcd_barrier_complete(unsigned* bar, unsigned x, unsigned& nloc, unsigned& nx) {
    const unsigned G = gridDim.x * gridDim.y * gridDim.z;
    unsigned sum, cnt, mine, sp = 0u;
    for (;;) {
        sum = 0u; cnt = 0u; mine = 0u;
#pragma unroll
        for (unsigned j = 0; j < 16; ++j) { const unsigned c = xb_ld(&bar[XB_XCNT(j)]); sum += c; cnt += (c > 0u) ? 1u : 0u; mine = (j == x) ? c : mine; }
        if (sum == G) break;
        __builtin_amdgcn_s_sleep(1);
        if ((++sp & 255u) == 0u) { if (xb_ld(&bar[XB_TMO])) break; if (sp > XB_SPIN_CAP) { atomicAdd(&bar[XB_TMO], 1u); break; } }
    }
    nloc = mine > 0u ? mine : 1u; nx = cnt > 0u ? cnt : 1u;
}

__device__ __forceinline__ void xcd_barrier(const XcdBarrier& b) {
    asm volatile("s_waitcnt vmcnt(0)" ::: "memory");
    __syncthreads();
    if (threadIdx.x == 0) {
        unsigned* bar = b.bar;
        __builtin_amdgcn_s_waitcnt(0);
        unsigned nloc = b.st[0], nx = b.st[1];
        if (nloc == 0u) { xcd_barrier_complete(bar, b.x, nloc, nx); b.st[0] = nloc; b.st[1] = nx; }
        const unsigned old = xb_add(&bar[XB_XSUB(b.x)], 1u);
        const unsigned gen = old / nloc;
        if (old + 1u == (gen + 1u) * nloc) {
            __builtin_amdgcn_fence(__ATOMIC_RELEASE, "agent");
            asm volatile("s_waitcnt vmcnt(0)" ::: "memory");
            const unsigned og = xb_add(&bar[XB_TOP], 1u);
            const unsigned tg = og / nx;
            if (og + 1u == (tg + 1u) * nx) xb_add(&bar[XB_TOPGEN], 1u);
            else XB_SPIN(xb_ld(&bar[XB_TOPGEN]) == tg, bar);
            __builtin_amdgcn_fence(__ATOMIC_ACQUIRE, "agent");
            xb_add(&bar[XB_XGEN(b.x)], 1u);
            asm volatile("s_waitcnt vmcnt(0)" ::: "memory");
        } else {
            XB_SPIN(xb_ld(&bar[XB_XGEN(b.x)]) == gen, bar);
            __builtin_amdgcn_fence(__ATOMIC_ACQUIRE, "agent");
            asm volatile("s_waitcnt vmcnt(0)" ::: "memory");
        }
    }
    __syncthreads();
}
#ifndef ATT_REP
#define ATT_REP 1
#endif
namespace att {
constexpr int SLOTB = 16384, VOFF = 8192, OSTG = 65536, SLAB = 65536, SLABW = 4352, IMP = 100352, WSF = 104704, SELM = 106752;
__device__ __forceinline__ int crow(int r, int hi) { return (r & 3) + 8 * (r >> 2) + 4 * hi; }
#define SBAR() __builtin_amdgcn_sched_barrier(0)
__device__ __forceinline__ void glds16(const void* gsrc, unsigned lds_dst) { unsigned keep;
    asm volatile("s_mov_b32 %0, m0\n\ts_mov_b32 m0, %2\n\ts_nop 0\n\tglobal_load_lds_dwordx4 %1, off\n\ts_mov_b32 m0, %0" : "=&s"(keep) : "v"(gsrc), "s"(lds_dst) : "memory"); }
typedef float f32x2_t __attribute__((ext_vector_type(2))); typedef __bf16 bf16x2_t __attribute__((ext_vector_type(2)));
__device__ __forceinline__ unsigned cvtpk_s(float lo, float hi) { f32x2_t v = {lo, hi}; bf16x2_t b = __builtin_convertvector(v, bf16x2_t); return __builtin_bit_cast(unsigned, b); }
__device__ __forceinline__ void qkt(f32x16& p0, f32x16& p1, const LAS unsigned char* Kslot, const bf16x8* qr, int r32, int hi) {
    const LAS unsigned char* kb = Kslot + hi * 1024 + r32 * 16;
#pragma unroll
    for (int d0 = 0; d0 < 4; ++d0) {
        const bf16x8 b0 = *(const LAS bf16x8*)(kb + d0 * 2048);
        const bf16x8 b1 = *(const LAS bf16x8*)(kb + d0 * 2048 + 512);
        if (d0 == 0) { p0 = __builtin_amdgcn_mfma_f32_32x32x16_bf16(b0, qr[0], f32x16{}, 0, 0, 0); p1 = __builtin_amdgcn_mfma_f32_32x32x16_bf16(b1, qr[0], f32x16{}, 0, 0, 0); }
        else { p0 = __builtin_amdgcn_mfma_f32_32x32x16_bf16(b0, qr[d0], p0, 0, 0, 0); p1 = __builtin_amdgcn_mfma_f32_32x32x16_bf16(b1, qr[d0], p1, 0, 0, 0); } }
}
__device__ __forceinline__ void pv(f32x16* o, int vb, bf16x8 pa0, bf16x8 pa1, bf16x8 pa2, bf16x8 pa3) {
#pragma unroll
    for (int d0 = 0; d0 < 2; ++d0) { s16x4 lo[4], hi[4];
#pragma unroll
        for (int ks = 0; ks < 4; ++ks) {
            asm volatile("ds_read_b64_tr_b16 %0,%1 offset:%c2" : "=&v"(lo[ks]) : "v"(vb), "i"(d0 * 4096 + ks * 1024) : "memory");
            asm volatile("ds_read_b64_tr_b16 %0,%1 offset:%c2" : "=&v"(hi[ks]) : "v"(vb), "i"(d0 * 4096 + ks * 1024 + 512) : "memory"); }
        asm volatile("s_waitcnt lgkmcnt(0)" ::: "memory"); SBAR();
#define PK(k) (bf16x8){lo[k][0], lo[k][1], lo[k][2], lo[k][3], hi[k][0], hi[k][1], hi[k][2], hi[k][3]}
        o[d0] = __builtin_amdgcn_mfma_f32_32x32x16_bf16(pa0, PK(0), o[d0], 0, 0, 0);
        o[d0] = __builtin_amdgcn_mfma_f32_32x32x16_bf16(pa1, PK(1), o[d0], 0, 0, 0);
        o[d0] = __builtin_amdgcn_mfma_f32_32x32x16_bf16(pa2, PK(2), o[d0], 0, 0, 0);
        o[d0] = __builtin_amdgcn_mfma_f32_32x32x16_bf16(pa3, PK(3), o[d0], 0, 0, 0);
#undef PK
    }
}
__device__ __forceinline__ float rowmax(const f32x16& p0, const f32x16& p1) {
    float a = fmaxf(p0[0], p1[0]);
#pragma unroll
    for (int r = 1; r < 16; ++r) a = fmaxf(a, fmaxf(p0[r], p1[r]));
    return fmaxf(a, __shfl_xor(a, 32));
}
__device__ __forceinline__ void pack_p(const f32x16& p0, const f32x16& p1, bf16x8& pa0, bf16x8& pa1, bf16x8& pa2, bf16x8& pa3) {
    v4u w0 = {cvtpk_s(p0[0], p0[1]), cvtpk_s(p0[2], p0[3]), cvtpk_s(p0[4], p0[5]), cvtpk_s(p0[6], p0[7])};
    v4u w1 = {cvtpk_s(p0[8], p0[9]), cvtpk_s(p0[10], p0[11]), cvtpk_s(p0[12], p0[13]), cvtpk_s(p0[14], p0[15])};
    v4u w2 = {cvtpk_s(p1[0], p1[1]), cvtpk_s(p1[2], p1[3]), cvtpk_s(p1[4], p1[5]), cvtpk_s(p1[6], p1[7])};
    v4u w3 = {cvtpk_s(p1[8], p1[9]), cvtpk_s(p1[10], p1[11]), cvtpk_s(p1[12], p1[13]), cvtpk_s(p1[14], p1[15])};
    pa0 = __builtin_bit_cast(bf16x8, w0); pa1 = __builtin_bit_cast(bf16x8, w1); pa2 = __builtin_bit_cast(bf16x8, w2); pa3 = __builtin_bit_cast(bf16x8, w3);
}
#define LBAR() do { asm volatile("s_waitcnt lgkmcnt(0)" ::: "memory"); __builtin_amdgcn_s_barrier(); asm volatile("" ::: "memory"); } while (0)

__device__ __forceinline__ void attn_unit(const Args& a, int b, int g, int c, LAS unsigned char* lds) {
    int tid = threadIdx.x; asm volatile("" : "+v"(tid));
    const int lane = tid & 63, r32 = lane & 31, hi = lane >> 5; const int wid = __builtin_amdgcn_readfirstlane(tid >> 6);
    unsigned char* ws = a.ws;
    const unsigned lds0 = (unsigned)(uintptr_t)lds;
    const int head = g * 8 + wid, q0 = 32 * c, cur = c >> 1, tq = q0 + r32; const size_t m0 = (size_t)b * SEQ + q0;
    const bf16* Q = (const bf16*)(ws + WS_Q); const float* NG = (const float*)(ws + WS_NG);
    LAS float* wsf = (LAS float*)(lds + WSF) + wid * 64;
    LAS float* slab = (LAS float*)(lds + SLAB + wid * SLABW);
    LAS float* imp = (LAS float*)(lds + IMP);
    LAS unsigned* selm = (LAS unsigned*)(lds + SELM);
    const int ncmp = (c >= 32) ? 2 : 1, nsel = cur + 1, nwin = (cur < 8 ? cur : 8) + 1, NS = ncmp + nsel + nwin;
    const unsigned cmp_e = (unsigned)(WS_CMP / 2) + (unsigned)((b * 2 + g) * 8192);
    const unsigned kv_e = (unsigned)(WS_KV / 2) + (unsigned)(b * SEQ * 128 + g * 64);
    const unsigned krow = lane, kcol = wid * 8, vrow = 16 * (wid & 3) + (lane >> 2), vcol = (wid >> 2) * 32 + (lane & 3) * 8;
    const unsigned kdst = lds0 + wid * 1024, vdst = lds0 + VOFF + wid * 1024;
    const bf16* wsb = (const bf16*)ws;
#define ISSUE(s_) do { const int s__ = (s_); unsigned ke_, ve_; \
        if (s__ < ncmp) { ke_ = cmp_e + (unsigned)(s__ * 4096) + krow * 64 + kcol; ve_ = cmp_e + (unsigned)(BATCH * 2 * 8192 + s__ * 4096) + vrow * 64 + vcol; } \
        else { const bool sl_ = s__ < ncmp + nsel; const int t_ = cur - (sl_ ? s__ - ncmp : s__ - ncmp - nsel); const unsigned be_ = kv_e + (unsigned)((sl_ ? 2 : 4) * (MTOK * 128)) + (unsigned)(t_ * 8192); \
               ke_ = be_ + krow * 128 + kcol; ve_ = be_ + (unsigned)(MTOK * 128) + vrow * 128 + vcol; } \
        glds16(wsb + ke_, (unsigned)__builtin_amdgcn_readfirstlane(kdst + (s__ & 3) * SLOTB)); glds16(wsb + ve_, (unsigned)__builtin_amdgcn_readfirstlane(vdst + (s__ & 3) * SLOTB)); } while (0)
#define STEP_SYNC(s_) do { if ((s_) + 1 < NS) asm volatile("s_waitcnt vmcnt(2) lgkmcnt(0)" ::: "memory"); else asm volatile("s_waitcnt vmcnt(0) lgkmcnt(0)" ::: "memory"); \
        __builtin_amdgcn_s_barrier(); asm volatile("" ::: "memory"); if ((s_) + 2 < NS) ISSUE((s_) + 2); } while (0)
    asm volatile("s_waitcnt vmcnt(0) lgkmcnt(0)" ::: "memory"); __builtin_amdgcn_s_barrier(); asm volatile("" ::: "memory");
    ISSUE(0); ISSUE(1);
    if (tid < 32) selm[tid] = 0u;
    bf16x8 qr[4];
#pragma unroll
    for (int d0 = 0; d0 < 4; ++d0) qr[d0] = *(const bf16x8*)(Q + (m0 + r32) * 1024 + head * 64 + d0 * 16 + hi * 8);
    const float g_c = NG[(m0 + r32) * 48 + head * 3 + 0], g_s = NG[(m0 + r32) * 48 + head * 3 + 1], g_w = NG[(m0 + r32) * 48 + head * 3 + 2];
    f32x16 ofin[2]; ofin[0] = f32x16{}; ofin[1] = f32x16{};
    const int vbl = (int)(lds0 + VOFF) + ((lane >> 4) & 1) * 32 + (lane & 3) * 8 + (4 * hi + ((lane & 15) >> 2)) * 64;
    unsigned selbits = 0u;
    STEP_SYNC(0);
    if (ncmp == 2) STEP_SYNC(1);
    {
            f32x16 sc[4];
            qkt(sc[0], sc[1], lds, qr, r32, hi);
            if (ncmp == 2) qkt(sc[2], sc[3], lds + SLOTB, qr, r32, hi);
            else {
#pragma unroll
                for (int r = 0; r < 16; ++r) { sc[2][r] = NEGBIG; sc[3][r] = NEGBIG; } }
            const int hiq = (tq - 31) >> 4;
#pragma unroll
            for (int k = 0; k < 4; ++k)
#pragma unroll
                for (int r = 0; r < 16; ++r) { const int n = 32 * k + crow(r, hi); if (n > hiq) sc[k][r] = NEGBIG; }
            const float mx = fmaxf(rowmax(sc[0], sc[1]), rowmax(sc[2], sc[3]));
            float sum = 0.f;
#pragma unroll
            for (int k = 0; k < 4; ++k)
#pragma unroll
                for (int r = 0; r < 16; ++r) { sc[k][r] = __builtin_amdgcn_exp2f(sc[k][r] - mx); sum += sc[k][r]; }
            sum += __shfl_xor(sum, 32);
            const float inv = (hiq >= 0) ? 1.0f / sum : 0.f;
            float prevrecv = 0.f;
#pragma unroll
            for (int k = 0; k < 4; ++k)
#pragma unroll
                for (int a4 = 0; a4 < 4; ++a4) { const int idx = 4 * k + a4;
#pragma unroll
                    for (int e = 0; e < 4; ++e) sc[k][4 * a4 + e] *= inv;
                    const float g4 = (sc[k][4 * a4] + sc[k][4 * a4 + 1]) + (sc[k][4 * a4 + 2] + sc[k][4 * a4 + 3]);
                    const float recv = __shfl_xor(sc[k][4 * a4 + 3], 32); const float add = hi ? recv : prevrecv; prevrecv = recv;
                    slab[r32 * 33 + 2 * idx + hi] = g4 + add; }
#pragma unroll
            for (int k = 0; k < 4; ++k)
#pragma unroll
                for (int r = 0; r < 16; ++r) sc[k][r] *= g_c;
            bf16x8 pa0, pa1, pa2, pa3;
            pack_p(sc[0], sc[1], pa0, pa1, pa2, pa3); pv(ofin, vbl, pa0, pa1, pa2, pa3);
            if (ncmp == 2) { pack_p(sc[2], sc[3], pa0, pa1, pa2, pa3); pv(ofin, vbl + SLOTB, pa0, pa1, pa2, pa3); }
            LBAR();
            { const int q = tid >> 4, jp = tid & 15;
#pragma unroll
              for (int e = 0; e < 2; ++e) { const int j = 2 * jp + e; float t = 0.f;
#pragma unroll
                  for (int w = 0; w < 8; ++w) t += ((LAS float*)(lds + SLAB + w * SLABW))[q * 33 + j];
                  imp[q * 33 + j] = t; } }
            LBAR();
            { const int q = tid >> 4, jp = tid & 15, j0 = 2 * jp, j1 = j0 + 1;
              const float NINF = -1e30f;
              const float s0 = j0 <= cur ? imp[q * 33 + j0] + ((j0 == 0 || j0 == cur || j0 == cur - 1) ? 1000.f : 0.f) : NINF;
              const float s1 = j1 <= cur ? imp[q * 33 + j1] + ((j1 == 0 || j1 == cur || j1 == cur - 1) ? 1000.f : 0.f) : NINF;
              int rk0 = 0, rk1 = 0;
              for (int jj = 0; jj < 32; ++jj) { const float sj = jj <= cur ? imp[q * 33 + jj] + ((jj == 0 || jj == cur || jj == cur - 1) ? 1000.f : 0.f) : NINF;
                  rk0 += (sj > s0 || (sj == s0 && jj < j0)) ? 1 : 0; rk1 += (sj > s1 || (sj == s1 && jj < j1)) ? 1 : 0; }
              const unsigned bits = (rk0 < 8 ? (1u << j0) : 0u) | (rk1 < 8 ? (1u << j1) : 0u);
              if (bits) atomicOr((unsigned*)(selm + q), bits); }
            LBAR();
            selbits = selm[r32];
    }
    float mref = NEGBIG, lsum = 0.f; f32x16 o[2]; o[0] = f32x16{}; o[1] = f32x16{};
#pragma unroll 1
    for (int s = ncmp; s < NS; ++s) {
        STEP_SYNC(s);
        const int slot = (s & 3) * SLOTB;
        const bool issel = s < ncmp + nsel;
        const int j = issel ? s - ncmp : s - ncmp - nsel, t = cur - j;
        const bool lastt = issel ? (j == nsel - 1) : (j == nwin - 1);
        f32x16 p0, p1;
        qkt(p0, p1, lds + slot, qr, r32, hi);
        if (issel) { const bool sel = (selbits >> t) & 1u;
#pragma unroll
            for (int r = 0; r < 16; ++r) { p0[r] = sel ? p0[r] : NEGBIG; p1[r] = sel ? p1[r] : NEGBIG; } }
        if (t == cur || (!issel && t == cur - 8)) {
            const int kb = 64 * t + 4 * hi, lo_ = issel ? -(1 << 30) : tq - 511;
#pragma unroll
            for (int r = 0; r < 16; ++r) { const int kp = kb + (r & 3) + 8 * (r >> 2); if (kp > tq || kp < lo_) p0[r] = NEGBIG; if (kp + 32 > tq || kp + 32 < lo_) p1[r] = NEGBIG; }
        }
        const float rm = rowmax(p0, p1);
        if (__any(rm > mref + 8.0f)) {
            const float mn = fmaxf(mref, rm), alpha = __builtin_amdgcn_exp2f(mref - mn);
            lsum *= alpha; mref = mn;
            if (hi == 0) wsf[r32] = alpha;
            LDS_WAIT(); asm volatile("" ::: "memory");
#pragma unroll
            for (int r = 0; r < 16; ++r) { const float f = wsf[crow(r, hi)]; o[0][r] *= f; o[1][r] *= f; }
            LDS_WAIT(); asm volatile("" ::: "memory");
        }
        float sm = 0.f;
#pragma unroll
        for (int r = 0; r < 16; ++r) { p0[r] = __builtin_amdgcn_exp2f(p0[r] - mref); p1[r] = __builtin_amdgcn_exp2f(p1[r] - mref); sm += p0[r] + p1[r]; }
        lsum += sm;
        { bf16x8 pa0, pa1, pa2, pa3; pack_p(p0, p1, pa0, pa1, pa2, pa3); pv(o, vbl + slot, pa0, pa1, pa2, pa3); }
        if (lastt) {
            const float lt = lsum + __shfl_xor(lsum, 32);
            if (hi == 0) wsf[r32] = (issel ? g_s : g_w) / lt;
            LDS_WAIT(); asm volatile("" ::: "memory");
#pragma unroll
            for (int r = 0; r < 16; ++r) { const float f = wsf[crow(r, hi)]; ofin[0][r] += o[0][r] * f; ofin[1][r] += o[1][r] * f; }
            LDS_WAIT(); asm volatile("" ::: "memory");
            mref = NEGBIG; lsum = 0.f; o[0] = f32x16{}; o[1] = f32x16{};
        }
    }
#undef ISSUE
#undef STEP_SYNC
    { LAS bf16* stg = (LAS bf16*)(lds + OSTG) + wid * 2048;
#pragma unroll
      for (int r = 0; r < 16; ++r) { const int orow = crow(r, hi);
#pragma unroll
          for (int d0 = 0; d0 < 2; ++d0) stg[orow * 64 + d0 * 32 + r32] = (bf16)(cvtpk_s(ofin[d0][r], 0.f) & 0xffffu); }
      LDS_WAIT(); asm volatile("" ::: "memory");
      bf16* Ow = (bf16*)(ws + WS_ATT) + m0 * 1024 + head * 64;
#pragma unroll
      for (int i = 0; i < 4; ++i) { const int row = i * 8 + (lane >> 3), ch = lane & 7; const v4u v = *(const LAS v4u*)(stg + row * 64 + ch * 8); *(v4u*)(Ow + (size_t)row * 1024 + ch * 8) = v; }
      LDS_WAIT(); asm volatile("" ::: "memory"); }
}

__device__ __forceinline__ void attn_phase(const Args& a, LAS unsigned char* lds, int vcu) {
    const int bg = vcu >> 2, qd = vcu & 3;
    for (int uu = 0; uu < 16 * ATT_REP; ++uu) { const int u = uu & 15; const int i = qd + 4 * (u >> 2), k = u & 3; const int c = (k == 0) ? i : (k == 1) ? 31 - i : (k == 2) ? 32 + i : 63 - i;
        attn_unit(a, bg >> 1, bg & 1, c, lds); }
}
#undef SBAR
#undef LBAR
}
#ifndef MK_COOP
#define MK_COOP 1
#endif
constexpr int N_PHASES = 10;
#ifndef GREP1
#define GREP1 1
#define GREP4 1
#define GREP5 1
#define GREP7 1
#endif
template <int REPS> struct RepOrder { pg8::StaticOrder b; int per;
    __device__ __forceinline__ void init(int M, int N, int G, int c) { b.init(M, N, G, c); per = b.nwg / G; }
    __device__ __forceinline__ bool next(int i, pg8::Unit& u) const { if constexpr (REPS == 1) return b.next(i, u); else { if (i >= per * REPS) return false; return b.next(i % per, u); } }
    __device__ __forceinline__ void a_ready(const pg8::Unit&) const {}
    __device__ __forceinline__ void done(const pg8::Unit&) const {} };
__global__ void __launch_bounds__(NWAVES * 64, 2) fwd_megakernel(Args args) {
    extern __shared__ __attribute__((aligned(16))) unsigned char lds_raw[];
    LAS unsigned char* lds = (LAS unsigned char*)lds_raw;
    const int G = gridDim.x; const int bx = blockIdx.x; const int vcu = (G % 8 == 0) ? (bx % 8) * (G / 8) + bx / 8 : bx;
    unsigned char* ws = args.ws;
    const int lo = args.ph_lo, hi = args.ph_hi;
#ifndef PH_MASK
#define PH_MASK 0x3ff
#endif
#ifndef DUP_MASK
#define DUP_MASK 0
#endif
#define REP(k) _Pragma("nounroll") for (int rep_ = 0; rep_ < 1 + (((DUP_MASK) >> (k)) & 1); ++rep_)
#define PHON(k) (((PH_MASK) >> (k)) & 1)
#define IN(k) (PHON(k) && lo <= (k) && (k) < hi)
    cg::grid_group grid = cg::this_grid();
    volatile LAS unsigned* MISC = (volatile LAS unsigned*)(lds + 131072 + 320);
    for (int u = threadIdx.x; u < (LDS_BYTES - 131072) / 4; u += NWAVES * 64) ((LAS unsigned*)(lds + 131072))[u] = 0u;
    __syncthreads();
    XcdBarrier bar = xcd_barrier_post((unsigned*)(ws + WS_CTL) + 4096, MISC + 8);
#define GRID_BAR(k) do { if (IN(k) && IN((k) + 1)) { if ((k) == 0) grid.sync(); else xcd_barrier(bar); } } while (0)
    REP(0) if (IN(0)) { p0_prologue(args, lds, vcu, G); }
    GRID_BAR(0);
    REP(1) if (IN(1)) {
        pg8::Gemm g{(const bf16*)(ws + WS_XB), (const bf16*)(ws + WS_WIN), MTOK, N_IN, DM}; RepOrder<GREP1> S; S.init(MTOK, N_IN, G, bx);
        EpiIn E{(const float*)(ws + WS_R1), (bf16*)(ws + WS_UPOOL), (bf16*)(ws + WS_Q), (bf16*)(ws + WS_KV), (bf16*)(ws + WS_MG), (float*)(ws + WS_NG), args.in[I_QNW], args.in[I_KNW], (const float*)(ws + WS_ROPE)};
        pg8::gemm_phase<EpiIn, RepOrder<GREP1>, true, true>(lds, g, S, E);
    }
    GRID_BAR(1);
    REP(2) if (IN(2)) { p2_pool_compress(args, lds, vcu, G); }
    GRID_BAR(2);
    REP(3) if (IN(3)) { __syncthreads(); att::attn_phase(args, lds, vcu); }
    GRID_BAR(3);
    REP(4) if (IN(4)) {
        { pg8::Gemm g{(const bf16*)(ws + WS_POOLED), (const bf16*)(ws + WS_WPB), MTOK, DM, 512}; RepOrder<GREP4> S; S.init(MTOK, DM, G, bx);
          EpiGate E{(const bf16*)(ws + WS_MG), (bf16*)(ws + WS_PY), (bf16*)(ws + WS_MERGED), 1};
          pg8::gemm_phase<EpiGate, RepOrder<GREP4>, true, true>(lds, g, S, E); }
        { pg8::Gemm g{(const bf16*)(ws + WS_ATT), (const bf16*)(ws + WS_WAB), MTOK, DM, DM}; RepOrder<GREP4> S; S.init(MTOK, DM, G, bx);
          EpiGate E{(const bf16*)(ws + WS_MG), (bf16*)(ws + WS_PY), (bf16*)(ws + WS_MERGED), 0};
          pg8::gemm_phase<EpiGate, RepOrder<GREP4>, true, true>(lds, g, S, E); }
    }
    GRID_BAR(4);
    REP(5) if (IN(5)) {
        pg8::Gemm g{(const bf16*)(ws + WS_MERGED), (const bf16*)(ws + WS_WO), MTOK, DM, DM}; RepOrder<GREP5> S; S.init(MTOK, DM, G, bx);
        EpiWo E{args.in[I_X], args.out, (bf16*)(ws + WS_X1B), (float*)(ws + WS_SSQ)};
        pg8::gemm_phase<EpiWo, RepOrder<GREP5>, true, true>(lds, g, S, E);
    }
    GRID_BAR(5);
    REP(6) if (IN(6)) { p5b_r2(args, vcu, G); }
    GRID_BAR(6);
    REP(7) if (IN(7)) {
        pg8::Gemm g{(const bf16*)(ws + WS_X1B), (const bf16*)(ws + WS_WUP), MTOK, N_UP, DM}; RepOrder<GREP7> S; S.init(MTOK, N_UP, G, bx);
        EpiUp E{(const float*)(ws + WS_R1), args.in[I_CONVW], args.in[I_CONVB], (bf16*)(ws + WS_A), (float*)(ws + WS_RAW)};
        pg8::gemm_phase<EpiUp, RepOrder<GREP7>, true, true>(lds, g, S, E);
    }
    GRID_BAR(7);
    REP(8) if (IN(8)) { p7_fixup(args, vcu, G); }
    GRID_BAR(8);
    REP(9) if (IN(9)) {
        pg8::Gemm g{(const bf16*)(ws + WS_A), (const bf16*)(ws + WS_WDN), MTOK, DM, K_DN}; pg8::StaticOrder S; S.init(MTOK, DM, G, bx);
        EpiDown E{args.out};
        pg8::gemm_phase<EpiDown, pg8::StaticOrder, true, true>(lds, g, S, E);
    }
#undef IN
#undef GRID_BAR
}

extern "C" void kernel_launch(void* const* d_in, const int* in_sizes, int n_in, void* d_out, int out_size, void* d_ws, size_t ws_size, hipStream_t stream) {
    static int grid = 0;
    if (grid == 0) {
        if (n_in != 19 || in_sizes[0] != MTOK * DM || out_size != MTOK * DM || ws_size < WS_END) {
            fprintf(stderr, "kernel_launch: unexpected shapes: n_in %d in0 %d out %d ws %zu (need %zu)\n", n_in, n_in > 0 ? in_sizes[0] : -1, out_size, ws_size, (size_t)WS_END); grid = -1; return; }
        int dev = 0, cus = 0, per_cu = 0;
        hipGetDevice(&dev); hipDeviceGetAttribute(&cus, hipDeviceAttributeMultiprocessorCount, dev);
        if (hipFuncSetAttribute((const void*)fwd_megakernel, hipFuncAttributeMaxDynamicSharedMemorySize, LDS_BYTES) != hipSuccess) { fprintf(stderr, "kernel_launch: hipFuncSetAttribute failed\n"); grid = -1; return; }
        if (hipOccupancyMaxActiveBlocksPerMultiprocessor(&per_cu, (const void*)fwd_megakernel, NWAVES * 64, LDS_BYTES) != hipSuccess || per_cu < 1) { fprintf(stderr, "kernel_launch: occupancy query says %d\n", per_cu); per_cu = 1; }
        (void)hipGetLastError();
        grid = cus;
        if (grid != 256) fprintf(stderr, "kernel_launch: note: %d CUs (built for 256)\n", grid);
    }
    if (grid < 0) return;
    Args a{};
    for (int i = 0; i < 19; ++i) a.in[i] = (const float*)d_in[i];
    a.out = (float*)d_out; a.ws = (unsigned char*)d_ws;
#if MK_COOP
    a.ph_lo = 0; a.ph_hi = N_PHASES;
    if (hipMemsetAsync((char*)d_ws + WS_CTL, 0, CTL_ZERO_BYTES, stream) != hipSuccess) { fprintf(stderr, "kernel_launch: hipMemsetAsync failed\n"); return; }
    void* kargs[] = {&a};
    hipError_t e = hipLaunchCooperativeKernel((const void*)fwd_megakernel, dim3(grid), dim3(NWAVES * 64), kargs, LDS_BYTES, stream);
    if (e != hipSuccess) fprintf(stderr, "kernel_launch: cooperative launch failed: %s (grid %d)\n", hipGetErrorString(e), grid);
#else
    for (int p = 0; p < N_PHASES; ++p) { a.ph_lo = p; a.ph_hi = p + 1; hipLaunchKernelGGL(fwd_megakernel, dim3(grid), dim3(NWAVES * 64), LDS_BYTES, stream, a); }
#endif
}
```

```cpp
#include <hip/hip_runtime.h>
#include <hip/hip_cooperative_groups.h>
#include <cstdio>
#include <cstdint>
namespace cg = cooperative_groups;
namespace pg8 {
#define PG8_LAS __attribute__((address_space(3)))
typedef unsigned short bf16_t;
typedef short bf16x8 __attribute__((ext_vector_type(8)));
typedef float f32x4 __attribute__((ext_vector_type(4)));
typedef unsigned u32x4 __attribute__((ext_vector_type(4)));
constexpr int BM = 256, BK = 64, HALF = 128, HTB = HALF * BK * 2  , STAGE_BYTES = 8 * HTB, NXCD = 8, WGM = 8;

__host__ __device__ __forceinline__ int lds_byte(int r, int c) { const int st = (r >> 4) * 2 + (c >> 5), rr = r & 15, cc = c & 31, ob = rr * 64 + cc * 2; return st * 1024 + (ob ^ (((ob >> 9) & 1) << 5)); }
__host__ __device__ __forceinline__ void stage_rc(int b, int& R, int& C) { const int st = b / 1024, sb = b % 1024, swz = sb ^ (((sb >> 9) & 1) << 5); R = (st >> 1) * 16 + swz / 64; C = (st & 1) * 32 + (swz % 64) / 2; }
__host__ __device__ __forceinline__ int perm32(int rho) { const int n = rho >> 4, i = rho & 15; return 8 * (i >> 2) + 4 * n + (i & 3); }

struct Unit { int pm, pn; };
struct Gemm { const bf16_t* A; const bf16_t* Bt; int M, N, K; };

struct StaticOrder {
    int nM, nN, nwg, G, c;
    __host__ __device__ void init(int M, int N, int G_, int c_) { nM = M / BM; nN = N / BM; nwg = nM * nN; G = G_; c = c_; }
    __host__ __device__ bool next(int i, Unit& u) const {
        const long L = (long)i * G + c; if (L >= nwg) return false;
        int wgid = (int)L; { const int q = nwg / NXCD, r = nwg % NXCD, xcd = wgid % NXCD, off = wgid / NXCD; wgid = (xcd < r ? xcd * (q + 1) : r * (q + 1) + (xcd - r) * q) + off; }
        const int nig = WGM * nN, gid = wgid / nig, fm = gid * WGM, gsz = (nM - fm) < WGM ? (nM - fm) : WGM;
        u.pm = fm + ((wgid % nig) % gsz); u.pn = (wgid % nig) / gsz; return true;
    }
    __device__ __forceinline__ void a_ready(const Unit&) const {}
    __device__ __forceinline__ void done(const Unit&) const {}
};

__device__ __forceinline__ unsigned cvt_pk_bf16(float lo, float hi) { unsigned r; asm volatile("v_cvt_pk_bf16_f32 %0, %1, %2" : "=v"(r) : "v"(lo), "v"(hi)); return r; }
typedef float f32x2 __attribute__((ext_vector_type(2)));
template <class Epi, class Sched, bool ALIGN_EPI = false, bool SP2 = false>
__device__ __forceinline__ void gemm_phase(PG8_LAS unsigned char* lds, const Gemm g, const Sched& S, const Epi& E) {
    const int tid = threadIdx.x, wid = __builtin_amdgcn_readfirstlane(tid >> 6), lane = tid & 63, wr = wid >> 2, wc = wid & 3, fr = lane & 15, fq = lane >> 4;
    const int K = g.K, nt = K / BK;
    unsigned voffA[2], voffB[2];
#pragma unroll
    for (int i = 0; i < 2; ++i) { int R, C; stage_rc(tid * 16 + i * 8192, R, C); const int Rb = Epi::PERM ? ((R & ~31) + perm32(R & 31)) : R;
        voffA[i] = (unsigned)(R * K + C) * 2u; voffB[i] = (unsigned)(Rb * K + C) * 2u; }
    const size_t kstep = (size_t)(BK * 2);
    const size_t hstep = (size_t)HALF * K * 2;
    const size_t tstep = 2 * hstep;
    const unsigned ldsw = (unsigned)wid * 1024u;
    const int aoff = lds_byte(wr * 64 + fr, fq * 8), boff = lds_byte(wc * 32 + fr, fq * 8);
#define PG8_SA(b, h) (((b) * 2 + (h)) * HTB)
#define PG8_SB(b, h) ((4 + (b) * 2 + (h)) * HTB)
#define PG8_STAGE(bufoff, gbase, voff) do { _Pragma("unroll") for (int _i = 0; _i < 2; ++_i) \
        __builtin_amdgcn_global_load_lds((const unsigned*)((const char*)(gbase) + (voff)[_i]), (PG8_LAS unsigned*)(lds + (bufoff) + ldsw + _i * 8192), 16, 0, 0); } while (0)
#define PG8_LDA(dst, b, h) do { _Pragma("unroll") for (int m = 0; m < 4; ++m) _Pragma("unroll") for (int k = 0; k < 2; ++k) dst[m][k] = *(const PG8_LAS bf16x8*)(lds + PG8_SA(b, h) + aoff + m * 2048 + k * 1024); } while (0)
#define PG8_LDB(dst, b, h) do { _Pragma("unroll") for (int n = 0; n < 2; ++n) _Pragma("unroll") for (int k = 0; k < 2; ++k) dst[n][k] = *(const PG8_LAS bf16x8*)(lds + PG8_SB(b, h) + boff + n * 2048 + k * 1024); } while (0)
#define PG8_MMA(ai, bj, At, Bt) do { __builtin_amdgcn_s_setprio(1); _Pragma("unroll") for (int m = 0; m < 4; ++m) _Pragma("unroll") for (int n = 0; n < 2; ++n) _Pragma("unroll") for (int k = 0; k < 2; ++k) \
        acc[ai][bj][m][n] = __builtin_amdgcn_mfma_f32_16x16x32_bf16(Bt[n][k], At[m][k], acc[ai][bj][m][n], 0, 0, 0); __builtin_amdgcn_s_setprio(0); } while (0)
#define PG8_WAIT_V(n) asm volatile("s_waitcnt vmcnt(" #n ")" ::: "memory")
#define PG8_WAIT_L(n) asm volatile("s_waitcnt lgkmcnt(" #n ")" ::: "memory")
#define PG8_BAR __builtin_amdgcn_s_barrier()
#define PG8_SCHED __builtin_amdgcn_sched_barrier(0)
    Unit cur, nxt; int ui = 0;
    if (!S.next(0, cur)) return;
    f32x4 acc[2][2][4][2];
#pragma unroll
    for (int a = 0; a < 2; ++a)
#pragma unroll
        for (int b = 0; b < 2; ++b)
#pragma unroll
            for (int m = 0; m < 4; ++m)
#pragma unroll
                for (int n = 0; n < 2; ++n) acc[a][b][m][n] = (f32x4){0.f, 0.f, 0.f, 0.f};
    bf16x8 At[4][2], B0[2][2], B1[2][2];
    const char* cA = (const char*)g.A + (size_t)cur.pm * tstep; const char* cB = (const char*)g.Bt + (size_t)cur.pn * tstep;
    S.a_ready(cur);
    if constexpr (SP2) {
        PG8_STAGE(PG8_SB(0, 0), cB, voffB); PG8_STAGE(PG8_SB(0, 1), cB + hstep, voffB); PG8_STAGE(PG8_SA(0, 0), cA, voffA); PG8_STAGE(PG8_SA(0, 1), cA + hstep, voffA);
        if (wr == 1) PG8_BAR;
        PG8_WAIT_V(2); PG8_BAR;
        PG8_STAGE(PG8_SB(1, 0), cB + kstep, voffB); PG8_STAGE(PG8_SA(1, 0), cA + kstep, voffA); PG8_STAGE(PG8_SB(1, 1), cB + hstep + kstep, voffB);
        PG8_WAIT_V(6); PG8_BAR;
    } else {
        PG8_STAGE(PG8_SB(0, 0), cB, voffB); PG8_STAGE(PG8_SA(0, 0), cA, voffA); PG8_STAGE(PG8_SB(0, 1), cB + hstep, voffB); PG8_STAGE(PG8_SA(0, 1), cA + hstep, voffA);
        if (wr == 1) PG8_BAR;
        PG8_WAIT_V(4); PG8_BAR;
        PG8_STAGE(PG8_SB(1, 0), cB + kstep, voffB); PG8_STAGE(PG8_SA(1, 0), cA + kstep, voffA); PG8_STAGE(PG8_SB(1, 1), cB + hstep + kstep, voffB);
        PG8_WAIT_V(6); PG8_BAR;
    }
    for (;;) {
        const bool has_next = S.next(ui + 1, nxt);
        const char* nA = has_next ? (const char*)g.A + (size_t)nxt.pm * tstep : cA; const char* nB = has_next ? (const char*)g.Bt + (size_t)nxt.pn * tstep : cB;
        for (int t = 0; t < nt; t += 2) {
            const bool last = (t == nt - 2);
            const char* a1 = cA + (size_t)(t + 1) * kstep;
            const char* a2 = last ? nA : cA + (size_t)(t + 2) * kstep; const char* b2 = last ? nB : cB + (size_t)(t + 2) * kstep;
            const char* a3 = a2 + kstep; const char* b3 = b2 + kstep;
            if (last && has_next) S.a_ready(nxt);
            if constexpr (SP2) {
            PG8_LDB(B0, 0, 0); PG8_LDB(B1, 0, 1); PG8_SCHED; PG8_LDA(At, 0, 0); PG8_STAGE(PG8_SA(1, 1), a1 + hstep, voffA);
            PG8_WAIT_V(8); PG8_WAIT_L(0); PG8_BAR; PG8_MMA(0, 0, At, B0); PG8_MMA(0, 1, At, B1); PG8_BAR; PG8_SCHED;
            PG8_LDA(At, 0, 1); PG8_STAGE(PG8_SB(0, 0), b2, voffB); PG8_STAGE(PG8_SB(0, 1), b2 + hstep, voffB); PG8_STAGE(PG8_SA(0, 0), a2, voffA);
            PG8_WAIT_V(8); PG8_WAIT_L(0); PG8_BAR; PG8_MMA(1, 0, At, B0); PG8_MMA(1, 1, At, B1); PG8_BAR; PG8_SCHED;
            PG8_LDB(B0, 1, 0); PG8_LDB(B1, 1, 1); PG8_SCHED; PG8_LDA(At, 1, 0); PG8_STAGE(PG8_SA(0, 1), a2 + hstep, voffA);
            PG8_WAIT_V(8); PG8_WAIT_L(0); PG8_BAR; PG8_MMA(0, 0, At, B0); PG8_MMA(0, 1, At, B1); PG8_BAR; PG8_SCHED;
            PG8_LDA(At, 1, 1); PG8_STAGE(PG8_SB(1, 0), b3, voffB); PG8_STAGE(PG8_SB(1, 1), b3 + hstep, voffB); PG8_STAGE(PG8_SA(1, 0), a3, voffA);
            PG8_WAIT_V(8); PG8_WAIT_L(0); PG8_BAR; PG8_MMA(1, 0, At, B0); PG8_MMA(1, 1, At, B1); PG8_BAR; PG8_SCHED;
            } else {
            PG8_LDB(B0, 0, 0); PG8_SCHED; PG8_LDA(At, 0, 0); PG8_STAGE(PG8_SA(1, 1), a1 + hstep, voffA);
            PG8_WAIT_L(8); PG8_BAR; PG8_WAIT_L(0); PG8_MMA(0, 0, At, B0); PG8_BAR; PG8_SCHED;
            PG8_LDB(B1, 0, 1); PG8_STAGE(PG8_SB(0, 0), b2, voffB);
            PG8_BAR; PG8_WAIT_L(0); PG8_MMA(0, 1, At, B1); PG8_BAR;
            PG8_LDA(At, 0, 1); PG8_STAGE(PG8_SA(0, 0), a2, voffA);
            PG8_BAR; PG8_WAIT_L(0); PG8_MMA(1, 0, At, B0); PG8_BAR; PG8_SCHED;
            PG8_STAGE(PG8_SB(0, 1), b2 + hstep, voffB);
            PG8_WAIT_V(6); PG8_BAR; PG8_MMA(1, 1, At, B1); PG8_BAR;
            PG8_LDB(B0, 1, 0); PG8_SCHED; PG8_LDA(At, 1, 0); PG8_STAGE(PG8_SA(0, 1), a2 + hstep, voffA);
            PG8_WAIT_L(8); PG8_BAR; PG8_WAIT_L(0); PG8_MMA(0, 0, At, B0); PG8_BAR; PG8_SCHED;
            PG8_LDB(B1, 1, 1); PG8_STAGE(PG8_SB(1, 0), b3, voffB);
            PG8_BAR; PG8_WAIT_L(0); PG8_MMA(0, 1, At, B1); PG8_BAR;
            PG8_LDA(At, 1, 1); PG8_STAGE(PG8_SA(1, 0), a3, voffA);
            PG8_BAR; PG8_WAIT_L(0); PG8_MMA(1, 0, At, B0); PG8_BAR; PG8_SCHED;
            PG8_STAGE(PG8_SB(1, 1), b3 + hstep, voffB);
            PG8_WAIT_V(6); PG8_BAR; PG8_MMA(1, 1, At, B1); PG8_BAR;
            }
        }
        if constexpr (ALIGN_EPI) { if (wr == 0) PG8_BAR; }
        if constexpr (!Epi::AFTER_DRAIN) { E(acc, cur, wr, wc, fr, fq); S.done(cur); }
        if (!has_next) break;
#pragma unroll
        for (int a = 0; a < 2; ++a)
#pragma unroll
            for (int b = 0; b < 2; ++b)
#pragma unroll
                for (int m = 0; m < 4; ++m)
#pragma unroll
                    for (int n = 0; n < 2; ++n) acc[a][b][m][n] = (f32x4){0.f, 0.f, 0.f, 0.f};
        cur = nxt; cA = nA; cB = nB; ++ui;
        if constexpr (ALIGN_EPI) { if (wr == 1) PG8_BAR; }
    }
    PG8_WAIT_V(0);
    if constexpr (!ALIGN_EPI) { if (wr == 0) PG8_BAR; }
    PG8_BAR;
    if constexpr (Epi::AFTER_DRAIN) { E.fused(acc, cur, wr, wc, fr, fq, lds, wid, lane); S.done(cur); }
#undef PG8_SA
#undef PG8_SB
#undef PG8_STAGE
#undef PG8_LDA
#undef PG8_LDB
#undef PG8_MMA
#undef PG8_WAIT_V
#undef PG8_WAIT_L
#undef PG8_BAR
#undef PG8_SCHED
}
}
constexpr int BATCH = 32, SEQ = 2048, DM = 1024, MTOK = BATCH * SEQ;
constexpr int IN_W = 4400, N_IN = 4608, DFF = 2752, N_UP = 5632, K_DN = 2816, UPW = 5504;
constexpr float EPS = 1e-6f, QSCALE = 0.125f * 1.4426950408889634f, NEGBIG = -1e30f;
constexpr size_t MiB = 1u << 20;
constexpr size_t WS_CTL = 0, CTL_ZERO_BYTES = 1 * MiB;
constexpr size_t WS_WIN = 2 * MiB, WS_WPB = 11 * MiB, WS_WAB = 12 * MiB, WS_WO = 14 * MiB, WS_WUP = 16 * MiB, WS_WDN = 27 * MiB, WS_W1T = 33 * MiB;
constexpr size_t WS_W2T = 34 * MiB, WS_B1 = 34 * MiB + 65536, WS_ROPE = 35 * MiB, WS_R1 = 36 * MiB, WS_SSQ = 37 * MiB, WS_CMP = 41 * MiB, WS_NG = 44 * MiB, WS_RAW = 56 * MiB;
constexpr size_t WS_XB = 144 * MiB, WS_UPOOL = 272 * MiB, WS_Q = 336 * MiB, WS_KV = 464 * MiB, WS_MG = 560 * MiB, WS_POOLED = 816 * MiB, WS_ATT = 880 * MiB, WS_END = 1008 * MiB;
constexpr size_t WS_PY = 272 * MiB, WS_MERGED = 400 * MiB, WS_X1B = 560 * MiB, WS_A = 144 * MiB;
constexpr int LDS_BYTES = 147456, NWAVES = 8;

#define GAS __attribute__((address_space(1)))
#define LAS __attribute__((address_space(3)))
typedef unsigned short bf16;
typedef unsigned v4u __attribute__((ext_vector_type(4)));
typedef unsigned v2u __attribute__((ext_vector_type(2)));
typedef float f32x4 __attribute__((ext_vector_type(4)));
typedef float f32x16 __attribute__((ext_vector_type(16)));
typedef short bf16x8 __attribute__((ext_vector_type(8)));
typedef short s16x4 __attribute__((ext_vector_type(4)));
#define LDS_WAIT() asm volatile("s_waitcnt lgkmcnt(0)" ::: "memory")
#define VM_WAIT() asm volatile("s_waitcnt vmcnt(0)" ::: "memory")
__device__ __forceinline__ unsigned pk2(float lo, float hi) { return pg8::cvt_pk_bf16(lo, hi); }
__device__ __forceinline__ float bflo(unsigned w) { return __uint_as_float(w << 16); }
__device__ __forceinline__ float bfhi(unsigned w) { return __uint_as_float(w & 0xffff0000u); }
__device__ __forceinline__ float sigmoidf_(float z) { return 1.0f / (1.0f + __expf(-z)); }
__device__ __forceinline__ float wave_sum(float v) {
#pragma unroll
    for (int o = 1; o < 64; o <<= 1) v += __shfl_xor(v, o);
    return v;
}

struct Args {
    const float* in[19];
    float* out; unsigned char* ws;
    int ph_lo, ph_hi;
};
enum { I_X = 0, I_ANW, I_WIN, I_POOLW, I_POOLS, I_QNW, I_KNW, I_CPOS, I_CW1, I_CB1, I_CW2, I_WPB, I_WAB, I_WO, I_FNW, I_WUP, I_CONVW, I_CONVB, I_WDN };

struct MapId { __device__ __forceinline__ int operator()(int s) const { return s; } };
struct MapIn { __device__ __forceinline__ int operator()(int s) const {
    if (s < 512) return s;
    if (s < 1536) { const int t = s - 512, hq = t >> 6, d = t & 63; return 256 * (2 + (hq >> 2)) + 128 * (d >> 5) + 32 * (hq & 3) + (d & 31); }
    if (s < 2304) { const int t = s - 1536, u = t >> 6, d = t & 63; return 256 * (6 + (u >> 2)) + 128 * (d >> 5) + 32 * (u & 3) + (d & 31); }
    if (s < 2352) return 256 * 17 + (s - 2304);
    return 256 * 9 + (s - 2352); } };
struct MapUp { __device__ __forceinline__ int operator()(int s) const { const int ch = s < DFF ? s : s - DFF; const int base = 256 * (ch >> 7) + (ch & 127); return s < DFF ? base : base + 128; } };

template <class RowMap>
__device__ __forceinline__ void transpose_item(const float* W, int N, bf16* WT, int ldk, const float* kscale, LAS float* scr, int item, int lane, RowMap rm) {
    const int nblk = (N + 31) / 32, kb = item / nblk, nb = item % nblk, k0 = 64 * kb, n0 = 32 * nb;
    const int nsrc = n0 + (lane & 31); const bool nok = nsrc < N;
#pragma unroll 8
    for (int i = 0; i < 32; ++i) { const int kk = 2 * i + (lane >> 5); float v = nok ? W[(size_t)(k0 + kk) * N + nsrc] : 0.f; if (kscale) v *= kscale[k0 + kk]; scr[kk * 33 + (lane & 31)] = v; }
    LDS_WAIT(); asm volatile("" ::: "memory");
    const int c = lane & 7;
#pragma unroll
    for (int j = 0; j < 4; ++j) { const int n = (lane >> 3) + 8 * j; const LAS float* s = scr + (8 * c) * 33 + n;
        v4u o; o.x = pk2(s[0 * 33], s[1 * 33]); o.y = pk2(s[2 * 33], s[3 * 33]); o.z = pk2(s[4 * 33], s[5 * 33]); o.w = pk2(s[6 * 33], s[7 * 33]);
        if (n0 + n < N) *(GAS v4u*)(WT + (size_t)rm(n0 + n) * ldk + k0 + 8 * c) = o; }
    LDS_WAIT(); asm volatile("" ::: "memory");
}

__device__ __forceinline__ void p0_prologue(const Args& a, LAS unsigned char* lds, int vcu, int G) {
    const int tid = threadIdx.x, lane = tid & 63, wave = __builtin_amdgcn_readfirstlane(tid >> 6);
    unsigned char* ws = a.ws;
    LAS float* scr = (LAS float*)(lds + wave * 16384);
    const int gw = vcu * NWAVES + wave, NGW = G * NWAVES;
    const long gt = (long)gw * 64 + lane, NGT = (long)NGW * 64;
    bf16* WIN = (bf16*)(ws + WS_WIN); bf16* WUP = (bf16*)(ws + WS_WUP); bf16* WDN = (bf16*)(ws + WS_WDN);
    constexpr int I_IN = 16 * 138, I_AB = 16 * 32, I_O = 16 * 32, I_UP = 16 * 172, I_DN = 43 * 32, I_C1 = 32 * 4;
    constexpr int NITEMS = I_IN + I_AB + I_O + I_UP + I_DN + 2 * I_C1;
    for (int it = gw; it < NITEMS; it += NGW) {
        int r = it;
        if (r < I_IN) { transpose_item(a.in[I_WIN], IN_W, WIN, DM, a.in[I_ANW], scr, r, lane, MapIn()); continue; } r -= I_IN;
        if (r < I_AB) { transpose_item(a.in[I_WAB], DM, (bf16*)(ws + WS_WAB), DM, nullptr, scr, r, lane, MapId()); continue; } r -= I_AB;
        if (r < I_O) { transpose_item(a.in[I_WO], DM, (bf16*)(ws + WS_WO), DM, nullptr, scr, r, lane, MapId()); continue; } r -= I_O;
        if (r < I_UP) { transpose_item(a.in[I_WUP], UPW, WUP, DM, a.in[I_FNW], scr, r, lane, MapUp()); continue; } r -= I_UP;
        if (r < I_DN) { transpose_item(a.in[I_WDN], DM, WDN, K_DN, nullptr, scr, r, lane, MapId()); continue; } r -= I_DN;
        if (r < I_C1) { transpose_item(a.in[I_CW1], 128, (bf16*)(ws + WS_W1T), 2048, nullptr, scr, r, lane, MapId()); continue; } r -= I_C1;
        transpose_item(a.in[I_CW1] + 2048 * 128, 128, (bf16*)(ws + WS_W1T) + 128 * 2048, 2048, nullptr, scr, r, lane, MapId());
    }
    for (long i = gt; i < 208L * DM / 8; i += NGT) *(GAS v4u*)(WIN + (size_t)(256 * 17 + 48) * DM + i * 8) = (v4u){0u, 0u, 0u, 0u};
    for (long i = gt; i < 128L * DM / 8; i += NGT) { const long e = i * 8; const int rr = (int)(e / DM), cc = (int)(e % DM); const int row = 256 * 21 + (rr < 64 ? 64 + rr : 192 + (rr - 64));
        *(GAS v4u*)(WUP + (size_t)row * DM + cc) = (v4u){0u, 0u, 0u, 0u}; }
    for (long i = gt; i < 1024L * 8; i += NGT) { const int row = (int)(i >> 3), c8 = (int)(i & 7); *(GAS v4u*)(WDN + (size_t)row * K_DN + DFF + c8 * 8) = (v4u){0u, 0u, 0u, 0u}; }
    for (long i = gt; i < 128L * 8; i += NGT) { const int t = (int)(i >> 3), c8 = (int)(i & 7); *(GAS v4u*)((bf16*)(ws + WS_CMP) + ((size_t)t * 128 + 127) * 64 + c8 * 8) = (v4u){0u, 0u, 0u, 0u}; }
    { const float* pw = a.in[I_POOLW]; const float* ps = a.in[I_POOLS]; const float* wb = a.in[I_WPB]; bf16* WPB = (bf16*)(ws + WS_WPB);
      for (long i = gt; i < 512L * 256; i += NGT) { const int n4 = (int)(i & 255) * 4, k = __builtin_amdgcn_readfirstlane((int)(i >> 8)), g = k >> 7; f32x4 s = (f32x4){0.f, 0.f, 0.f, 0.f};
          const float* pwr = pw + (size_t)k * 128; const float* psr = ps + g * 128; const float* wbr = wb + (size_t)(g * 128) * 1024 + n4;
#pragma unroll 8
          for (int d = 0; d < 128; ++d) s += (pwr[d] * psr[d]) * *(const f32x4*)(wbr + (size_t)d * 1024);
#pragma unroll
          for (int e = 0; e < 4; ++e) WPB[(size_t)(n4 + e) * 512 + k] = (bf16)(pk2(s[e], 0.f) & 0xffffu); } }
    for (int i = gw; i < 256; i += NGW) { const int kv = i >> 7, hc = i & 127; const float* w1 = a.in[I_CW1] + (size_t)kv * 2048 * 128; const float* pos = a.in[I_CPOS] + kv * 2048;
        float s = 0.f; for (int k = lane; k < 2048; k += 64) s += pos[k] * w1[(size_t)k * 128 + hc];
        s = wave_sum(s); if (lane == 0) ((float*)(ws + WS_B1))[i] = s + a.in[I_CB1][kv * 128 + hc]; }
    for (long i = gt; i < 2 * 64 * 128; i += NGT) { const int kv = (int)(i >> 13), d = (int)((i >> 7) & 63), h = (int)(i & 127);
        ((bf16*)(ws + WS_W2T))[i] = (bf16)(pk2(a.in[I_CW2][(size_t)kv * 128 * 64 + h * 64 + d], 0.f) & 0xffffu); }
    for (long i = gt; i < 2048L * 32; i += NGT) { const int p = (int)(i >> 5), j = (int)(i & 31); const float fr = (float)pow(10000.0, -(double)j / 32.0); const float ang = (float)p * fr;
        ((float*)(ws + WS_ROPE))[i] = (float)cos((double)ang); ((float*)(ws + WS_ROPE))[65536 + i] = (float)sin((double)ang); }
    { const float* x = a.in[I_X]; bf16* XB = (bf16*)(ws + WS_XB); float* R1 = (float*)(ws + WS_R1);
      for (int m4 = gw * 4; m4 < MTOK; m4 += NGW * 4) { f32x4 v[4][4]; float s[4];
#pragma unroll
          for (int r = 0; r < 4; ++r) { const GAS f32x4* xr = (const GAS f32x4*)(x + (size_t)(m4 + r) * DM) + lane;
#pragma unroll
              for (int j = 0; j < 4; ++j) v[r][j] = __builtin_nontemporal_load(xr + 64 * j); }
#pragma unroll
          for (int r = 0; r < 4; ++r) { s[r] = 0.f;
#pragma unroll
              for (int j = 0; j < 4; ++j) s[r] += (v[r][j].x * v[r][j].x + v[r][j].y * v[r][j].y) + (v[r][j].z * v[r][j].z + v[r][j].w * v[r][j].w); }
#pragma unroll
          for (int o = 1; o < 64; o <<= 1) {
#pragma unroll
              for (int r = 0; r < 4; ++r) s[r] += __shfl_xor(s[r], o); }
          if (lane < 4) R1[m4 + lane] = 1.0f / sqrtf((lane == 0 ? s[0] : lane == 1 ? s[1] : lane == 2 ? s[2] : s[3]) * (1.0f / DM) + EPS);
#pragma unroll
          for (int r = 0; r < 4; ++r) { GAS v2u* o8 = (GAS v2u*)(XB + (size_t)(m4 + r) * DM) + lane;
#pragma unroll
              for (int j = 0; j < 4; ++j) o8[64 * j] = (v2u){pk2(v[r][j].x, v[r][j].y), pk2(v[r][j].z, v[r][j].w)}; } } }
}

__device__ __forceinline__ void nt_store16(void* p, const v4u& v) { __builtin_nontemporal_store(v, (v4u*)p); }
__device__ __forceinline__ void nt_store4(void* p, unsigned v) { __builtin_nontemporal_store(v, (unsigned*)p); }
using pg8::Unit;
__device__ __forceinline__ v4u pack8(const f32x4& a, const f32x4& b) { v4u w; w.x = pk2(a[0], a[1]); w.y = pk2(a[2], a[3]); w.z = pk2(b[0], b[1]); w.w = pk2(b[2], b[3]); return w; }
__device__ __forceinline__ void unpack8(const v4u& w, f32x4& a, f32x4& b) { a = (f32x4){bflo(w.x), bfhi(w.x), bflo(w.y), bfhi(w.y)}; b = (f32x4){bflo(w.z), bfhi(w.z), bflo(w.w), bfhi(w.w)}; }

struct EpiIn {
    static constexpr bool PERM = true, AFTER_DRAIN = false;
    const float* r1; bf16* UPOOL; bf16* Q; bf16* KV; unsigned char* MG8; float* NG; const float* qnw; const float* knw; const float* rope;
    __device__ __forceinline__ void operator()(const f32x4 (&acc)[2][2][4][2], const Unit& u, int wr, int wc, int fr, int fq) const {
        const int row0 = u.pm * 256 + wr * 64 + fr, pn = u.pn;
        if (pn < 2) {
            const int col0 = 256 * pn + 32 * wc + 8 * fq;
#pragma unroll
            for (int ai = 0; ai < 2; ++ai)
#pragma unroll
                for (int m = 0; m < 4; ++m) { const int row = row0 + ai * 128 + m * 16; const float rs = r1[row];
#pragma unroll
                    for (int bj = 0; bj < 2; ++bj) *(v4u*)(UPOOL + (size_t)row * 512 + col0 + 128 * bj) = pack8(acc[ai][bj][m][0] * rs, acc[ai][bj][m][1] * rs); }
        } else if (pn >= 9 && pn < 17) {
            const int col0 = 256 * (pn - 9) + 32 * wc + 8 * fq;
#pragma unroll
            for (int ai = 0; ai < 2; ++ai)
#pragma unroll
                for (int m = 0; m < 4; ++m) { const int row = row0 + ai * 128 + m * 16; const float rs = r1[row];
#pragma unroll
                    for (int bj = 0; bj < 2; ++bj) { unsigned w[2];
#pragma unroll
                        for (int n = 0; n < 2; ++n) { const f32x4 v = acc[ai][bj][m][n] * rs; unsigned q[4];
#pragma unroll
                            for (int i = 0; i < 4; ++i) q[i] = (unsigned)(sigmoidf_(v[i]) * 255.0f + 0.5f);
                            w[n] = q[0] | (q[1] << 8) | (q[2] << 16) | (q[3] << 24); }
                        *(v2u*)(MG8 + (size_t)row * 2048 + col0 + 128 * bj) = (v2u){w[0], w[1]}; } }
        } else if (pn < 9) {
            const bool isq = pn < 6; const int br = pn - 6, kvsel = wc >> 1, g = wc & 1; const bool donorm = isq || kvsel == 0;
            const float* nw = isq ? qnw : knw + br * 64;
            f32x4 w[2][2];
#pragma unroll
            for (int bj = 0; bj < 2; ++bj)
#pragma unroll
                for (int n = 0; n < 2; ++n) w[bj][n] = *(const f32x4*)(nw + 32 * bj + 8 * fq + 4 * n);
            const float osc = isq ? QSCALE : 1.0f;
            bf16* base = isq ? Q + (4 * (pn - 2) + wc) * 64 : KV + (size_t)(br * 2 + kvsel) * MTOK * 128 + g * 64; const int ld = isq ? 1024 : 128;
#pragma unroll
            for (int ai = 0; ai < 2; ++ai)
#pragma unroll
                for (int m = 0; m < 4; ++m) { const int row = row0 + ai * 128 + m * 16; const float rs = r1[row]; const int pos = row & (SEQ - 1);
                    f32x4 z[2][2]; float ss = 0.f;
#pragma unroll
                    for (int bj = 0; bj < 2; ++bj)
#pragma unroll
                        for (int n = 0; n < 2; ++n) { z[bj][n] = acc[ai][bj][m][n] * rs; const f32x4 t = z[bj][n]; ss += (t[0] * t[0] + t[1] * t[1]) + (t[2] * t[2] + t[3] * t[3]); }
                    if (donorm) {
                        ss += __shfl_xor(ss, 16); ss += __shfl_xor(ss, 32);
                        const float rn = 1.0f / sqrtf(ss * (1.0f / 64.0f) + EPS);
#pragma unroll
                        for (int n = 0; n < 2; ++n) { const f32x4 cs = *(const f32x4*)(rope + pos * 32 + 8 * fq + 4 * n), sn = *(const f32x4*)(rope + 65536 + pos * 32 + 8 * fq + 4 * n);
                            const f32x4 y0 = z[0][n] * rn * w[0][n], y1 = z[1][n] * rn * w[1][n];
                            z[0][n] = (y0 * cs - y1 * sn) * osc; z[1][n] = (y1 * cs + y0 * sn) * osc; }
                    }
#pragma unroll
                    for (int bj = 0; bj < 2; ++bj) *(v4u*)(base + (size_t)row * ld + 32 * bj + 8 * fq) = pack8(z[bj][0], z[bj][1]); }
        } else {
            if (wc < 2) {
#pragma unroll
                for (int ai = 0; ai < 2; ++ai)
#pragma unroll
                    for (int m = 0; m < 4; ++m) { const int row = row0 + ai * 128 + m * 16; const float rs = r1[row];
#pragma unroll
                        for (int n = 0; n < 2; ++n) { const int col = 32 * wc + 8 * fq + 4 * n; if (col < 48) { f32x4 v = acc[ai][0][m][n] * rs;
#pragma unroll
                                for (int i = 0; i < 4; ++i) v[i] = sigmoidf_(v[i]);
                                *(f32x4*)(NG + (size_t)row * 48 + col) = v; } } }
            }
        }
    }
};

struct EpiGate {
    static constexpr bool PERM = true, AFTER_DRAIN = false;
    const unsigned char* MG8; bf16* PY; bf16* OUT; int first;
    __device__ __forceinline__ void operator()(const f32x4 (&acc)[2][2][4][2], const Unit& u, int wr, int wc, int fr, int fq) const {
        const int row0 = u.pm * 256 + wr * 64 + fr, col0 = 256 * u.pn + 32 * wc + 8 * fq;
#pragma unroll
        for (int ai = 0; ai < 2; ++ai)
#pragma unroll
            for (int m = 0; m < 4; ++m) { const int row = row0 + ai * 128 + m * 16;
#pragma unroll
                for (int bj = 0; bj < 2; ++bj) { const int col = col0 + 128 * bj; const v2u gw = *(const v2u*)(MG8 + (size_t)row * 2048 + (first ? 0 : 1024) + col);
                    const float k = 1.0f / 255.0f;
                    const f32x4 g0 = (f32x4){(float)(gw.x & 255u), (float)((gw.x >> 8) & 255u), (float)((gw.x >> 16) & 255u), (float)(gw.x >> 24)} * k;
                    const f32x4 g1 = (f32x4){(float)(gw.y & 255u), (float)((gw.y >> 8) & 255u), (float)((gw.y >> 16) & 255u), (float)(gw.y >> 24)} * k;
                    f32x4 v0 = acc[ai][bj][m][0] * g0, v1 = acc[ai][bj][m][1] * g1;
                    if (!first) { f32x4 p0, p1; unpack8(*(const v4u*)(PY + (size_t)row * 1024 + col), p0, p1); v0 += p0; v1 += p1; }
                    *(v4u*)((first ? PY : OUT) + (size_t)row * 1024 + col) = pack8(v0, v1); } }
    }
};

struct EpiWo {
    static constexpr bool PERM = true, AFTER_DRAIN = false;
    const bf16* XB; bf16* X1B; float* ssq;
    __device__ __forceinline__ void operator()(const f32x4 (&acc)[2][2][4][2], const Unit& u, int wr, int wc, int fr, int fq) const {
        const int row0 = u.pm * 256 + wr * 64 + fr, col0 = 256 * u.pn + 32 * wc + 8 * fq;
#pragma unroll
        for (int ai = 0; ai < 2; ++ai)
#pragma unroll
            for (int m = 0; m < 4; ++m) { const int row = row0 + ai * 128 + m * 16; float ss = 0.f;
#pragma unroll
                for (int bj = 0; bj < 2; ++bj) { const size_t off = (size_t)row * 1024 + col0 + 128 * bj; f32x4 x0, x1; unpack8(*(const v4u*)(XB + off), x0, x1);
                    const f32x4 v0 = x0 + acc[ai][bj][m][0], v1 = x1 + acc[ai][bj][m][1];
                    const v4u pk = pack8(v0, v1); *(v4u*)(X1B + off) = pk;
                    f32x4 r0, r1_; unpack8(pk, r0, r1_);
                    ss += (r0[0] * r0[0] + r0[1] * r0[1]) + (r0[2] * r0[2] + r0[3] * r0[3]) + (r1_[0] * r1_[0] + r1_[1] * r1_[1]) + (r1_[2] * r1_[2] + r1_[3] * r1_[3]); }
                ss += __shfl_xor(ss, 16); ss += __shfl_xor(ss, 32);
                if (fq == 0) ssq[(size_t)row * 16 + u.pn * 4 + wc] = ss; }
    }
};

struct EpiUp {
    static constexpr bool PERM = true, AFTER_DRAIN = false;
    const float* r2; const float* cw; const float* cb; bf16* A; float* RAW;
    __device__ __forceinline__ void operator()(const f32x4 (&acc)[2][2][4][2], const Unit& u, int wr, int wc, int fr, int fq) const {
        const int lane = fr + 16 * fq, row0 = u.pm * 256 + wr * 64 + fr;
        const int chb = 128 * u.pn + 32 * wc + 8 * fq; const bool chok = chb < DFF;
        float rs[2][4];
#pragma unroll
        for (int ai = 0; ai < 2; ++ai)
#pragma unroll
            for (int m = 0; m < 4; ++m) rs[ai][m] = r2[row0 + ai * 128 + m * 16];
        const int l1 = (lane - 1) & 63, l2 = (lane - 2) & 63, l15 = (lane + 15) & 63, l14 = (lane + 14) & 63;
#pragma unroll
        for (int ai = 0; ai < 2; ++ai) {
            if (fr >= 14) { const int row = row0 + ai * 128 + 48;
#pragma unroll
                for (int bj = 0; bj < 2; ++bj)
#pragma unroll
                    for (int n = 0; n < 2; ++n) *(f32x4*)(RAW + ((size_t)(row >> 6) * 4 + (fr - 14)) * N_UP + 256 * u.pn + 128 * bj + 32 * wc + 8 * fq + 4 * n) = acc[ai][bj][3][n] * rs[ai][3]; }
            if (fr < 2) { const int row = row0 + ai * 128;
#pragma unroll
                for (int bj = 0; bj < 2; ++bj)
#pragma unroll
                    for (int n = 0; n < 2; ++n) *(f32x4*)(RAW + ((size_t)(row >> 6) * 4 + 2 + fr) * N_UP + 256 * u.pn + 128 * bj + 32 * wc + 8 * fq + 4 * n) = acc[ai][bj][0][n] * rs[ai][0]; }
        }
#pragma unroll
        for (int n = 0; n < 2; ++n)
#pragma unroll
            for (int hp = 0; hp < 2; ++hp) {
                asm volatile("" ::: "memory");
                const int ch = chb + 4 * n + 2 * hp; const int cg_ = chok ? ch : 0;
                float wgt[2][3][2], bia[2][2];
#pragma unroll
                for (int bj = 0; bj < 2; ++bj) { const float2 bb = *(const float2*)(cb + bj * DFF + cg_); bia[bj][0] = bb.x; bia[bj][1] = bb.y;
#pragma unroll
                    for (int t = 0; t < 3; ++t) { const float2 ww = *(const float2*)(cw + t * UPW + bj * DFF + cg_); wgt[bj][t][0] = ww.x; wgt[bj][t][1] = ww.y; } }
#pragma unroll
                for (int ai = 0; ai < 2; ++ai) {
                    float pvv[2][2] = {{0.f, 0.f}, {0.f, 0.f}};
#pragma unroll
                    for (int m = 0; m < 4; ++m) { const int row = row0 + ai * 128 + m * 16; float c_[2][2];
#pragma unroll
                        for (int bj = 0; bj < 2; ++bj)
#pragma unroll
                            for (int e = 0; e < 2; ++e) { const float cur = acc[ai][bj][m][n][2 * hp + e] * rs[ai][m];
                                const float a1 = __shfl(cur, l1), b1 = __shfl(pvv[bj][e], l15), a2 = __shfl(cur, l2), b2 = __shfl(pvv[bj][e], l14);
                                const float p1 = fr >= 1 ? a1 : b1, p2 = fr >= 2 ? a2 : b2;
                                c_[bj][e] = bia[bj][e] + wgt[bj][0][e] * p2 + wgt[bj][1][e] * p1 + wgt[bj][2][e] * cur; pvv[bj][e] = cur; }
                        const float o0 = c_[0][0] * sigmoidf_(c_[0][0]) * c_[1][0], o1 = c_[0][1] * sigmoidf_(c_[0][1]) * c_[1][1];
                        if (!chok) *(unsigned*)(A + (size_t)row * K_DN + ch) = 0u;
                        else if (!(m == 0 && fr < 2)) *(unsigned*)(A + (size_t)row * K_DN + ch) = pk2(o0, o1); }
                }
            }
    }
};

struct EpiDown {
    static constexpr bool PERM = true, AFTER_DRAIN = false;
    const bf16* X1B; float* out;
    __device__ __forceinline__ void operator()(const f32x4 (&acc)[2][2][4][2], const Unit& u, int wr, int wc, int fr, int fq) const {
        const int row0 = u.pm * 256 + wr * 64 + fr, col0 = 256 * u.pn + 32 * wc + 8 * fq;
#pragma unroll
        for (int ai = 0; ai < 2; ++ai)
#pragma unroll
            for (int m = 0; m < 4; ++m) { const int row = row0 + ai * 128 + m * 16;
#pragma unroll
                for (int bj = 0; bj < 2; ++bj) { const size_t off = (size_t)row * 1024 + col0 + 128 * bj; f32x4 x0, x1; unpack8(*(const v4u*)(X1B + off), x0, x1);
                    *(f32x4*)(out + off) = x0 + acc[ai][bj][m][0]; *(f32x4*)(out + off + 4) = x1 + acc[ai][bj][m][1]; } }
    }
};

__device__ __forceinline__ float gelu_tanh(float x) { const float y = 0.7978845608028654f * (x + 0.044715f * x * x * x); const float e = __expf(2.0f * y); return 0.5f * x * (2.0f - 2.0f / (e + 1.0f)); }

__device__ __forceinline__ void p2_pool_compress(const Args& a, LAS unsigned char* lds, int vcu, int G) {
    const int tid = threadIdx.x, lane = tid & 63, wave = __builtin_amdgcn_readfirstlane(tid >> 6);
    unsigned char* ws = a.ws;
    const int gw = vcu * NWAVES + wave, NGW = G * NWAVES;
    {
        LAS unsigned char* wl = lds + wave * 4608;
        const bf16* W1T = (const bf16*)(ws + WS_W1T); const bf16* W2T = (const bf16*)(ws + WS_W2T); const float* B1 = (const float*)(ws + WS_B1);
        const int fr = lane & 15, fq = lane >> 4;
        for (int unit = wave * G + vcu; unit < 1024; unit += NGW) {
            const int kv = unit >> 9, rest = unit & 511, b = rest >> 4, g = (rest >> 3) & 1, n0 = 16 * (rest & 7);
            const int n = n0 + fr, nn = n < 126 ? n : 126;
            const bf16* arow = (const bf16*)(ws + WS_KV) + ((size_t)kv * MTOK + (size_t)b * SEQ + 16 * nn) * 128 + g * 64 + 8 * fq;
            const bf16* w1 = W1T + (size_t)kv * 128 * 2048 + (size_t)fr * 2048 + 8 * fq;
            f32x4 acc[8];
#pragma unroll
            for (int hb = 0; hb < 8; ++hb) acc[hb] = (f32x4){0.f, 0.f, 0.f, 0.f};
#pragma unroll 4
            for (int ks = 0; ks < 64; ++ks) {
                const bf16x8 bfrag = *(const bf16x8*)(arow + (ks >> 1) * 128 + (ks & 1) * 32);
#pragma unroll
                for (int hb = 0; hb < 8; ++hb) { const bf16x8 afrag = *(const bf16x8*)(w1 + (size_t)hb * 16 * 2048 + 32 * ks);
                    acc[hb] = __builtin_amdgcn_mfma_f32_16x16x32_bf16(afrag, bfrag, acc[hb], 0, 0, 0); }
            }
#pragma unroll
            for (int hb = 0; hb < 8; ++hb) { const f32x4 bv = *(const f32x4*)(B1 + kv * 128 + 16 * hb + 4 * fq); f32x4 h = acc[hb] + bv;
#pragma unroll
                for (int i = 0; i < 4; ++i) h[i] = gelu_tanh(h[i]);
                *(LAS v2u*)(wl + fr * 272 + (16 * hb + 4 * fq) * 2) = (v2u){pk2(h[0], h[1]), pk2(h[2], h[3])}; }
            LDS_WAIT(); asm volatile("" ::: "memory");
            f32x4 o[4];
#pragma unroll
            for (int db = 0; db < 4; ++db) o[db] = (f32x4){0.f, 0.f, 0.f, 0.f};
#pragma unroll
            for (int ks = 0; ks < 4; ++ks) { const bf16x8 bfrag = *(const LAS bf16x8*)(wl + fr * 272 + 64 * ks + 16 * fq);
#pragma unroll
                for (int db = 0; db < 4; ++db) { const bf16x8 afrag = *(const bf16x8*)(W2T + (size_t)kv * 64 * 128 + (16 * db + fr) * 128 + 32 * ks + 8 * fq);
                    o[db] = __builtin_amdgcn_mfma_f32_16x16x32_bf16(afrag, bfrag, o[db], 0, 0, 0); } }
            LDS_WAIT(); asm volatile("" ::: "memory");
            if (n < 127) { bf16* dst = (bf16*)(ws + WS_CMP) + (((size_t)kv * BATCH + b) * 2 + g) * 128 * 64 + (size_t)n * 64;
#pragma unroll
                for (int db = 0; db < 4; ++db) *(v2u*)(dst + 16 * db + 4 * fq) = (v2u){pk2(o[db][0], o[db][1]), pk2(o[db][2], o[db][3])}; }
        }
    }
    {
        const bf16* U = (const bf16*)(ws + WS_UPOOL); bf16* P = (bf16*)(ws + WS_POOLED);
        const long gt = (long)gw * 64 + lane, NGT = (long)NGW * 64;
#define POOL_GROUP(GI, W) \
        for (long it = gt; it < (long)MTOK * 16; it += NGT) { const int row = (int)(it >> 4), c8 = (GI) * 16 + (int)(it & 15), t = row & (SEQ - 1); const int cnt = (t + 1 < (W)) ? t + 1 : (W); \
            v4u raw[W]; \
            _Pragma("unroll") for (int p = 0; p < (W); ++p) raw[p] = *(const v4u*)(U + (size_t)(row - (p < cnt ? p : 0)) * 512 + c8 * 8); \
            f32x4 s0 = (f32x4){0.f, 0.f, 0.f, 0.f}, s1 = s0, u0, u1; unpack8(raw[0], u0, u1); \
            _Pragma("unroll") for (int p = 0; p < (W); ++p) { f32x4 x0, x1; unpack8(raw[p], x0, x1); const float m = p < cnt ? 1.f : 0.f; s0 += x0 * m; s1 += x1 * m; } \
            const float inv = 1.0f / (float)cnt; \
            *(v4u*)(P + (size_t)row * 512 + c8 * 8) = pack8(s0 * inv - u0, s1 * inv - u1); }
        POOL_GROUP(0, 2) POOL_GROUP(1, 4) POOL_GROUP(2, 8) POOL_GROUP(3, 16)
#undef POOL_GROUP
    }
}

__device__ __forceinline__ void p5b_r2(const Args& a, int vcu, int G) {
    const long gt = ((long)vcu * NWAVES * 64) + threadIdx.x, NGT = (long)G * NWAVES * 64;
    const float* ssq = (const float*)(a.ws + WS_SSQ); float* R2 = (float*)(a.ws + WS_R1);
    for (long row = gt; row < MTOK; row += NGT) { const f32x4* p = (const f32x4*)(ssq + (size_t)row * 16); const f32x4 s = (p[0] + p[1]) + (p[2] + p[3]);
        R2[row] = 1.0f / sqrtf(((s[0] + s[1]) + (s[2] + s[3])) * (1.0f / DM) + EPS); }
}
__device__ __forceinline__ void p7_fixup(const Args& a, int vcu, int G) {
    const long gt = ((long)vcu * NWAVES * 64) + threadIdx.x, NGT = (long)G * NWAVES * 64;
    const float* RAW = (const float*)(a.ws + WS_RAW); bf16* A = (bf16*)(a.ws + WS_A); const float* cw = a.in[I_CONVW]; const float* cb = a.in[I_CONVB];
    for (long it = gt; it < 2048L * (DFF / 4); it += NGT) { const int c4 = (int)(it % (DFF / 4)), rk = (int)(it / (DFF / 4)), s = rk >> 1, k = rk & 1, ch = 4 * c4;
        const bool first = (s & 31) == 0; f32x4 c_[2];
#pragma unroll
        for (int bj = 0; bj < 2; ++bj) { const int col = 256 * (ch >> 7) + (ch & 127) + 128 * bj; const f32x4 z = (f32x4){0.f, 0.f, 0.f, 0.f};
            const f32x4 cur = *(const f32x4*)(RAW + ((size_t)s * 4 + 2 + k) * N_UP + col);
            const f32x4 t1 = first ? z : *(const f32x4*)(RAW + ((size_t)(s - 1) * 4 + 1) * N_UP + col), t0 = first ? z : *(const f32x4*)(RAW + ((size_t)(s - 1) * 4 + 0) * N_UP + col);
            const f32x4 r0 = *(const f32x4*)(RAW + ((size_t)s * 4 + 2) * N_UP + col);
            const f32x4 p1 = k == 1 ? r0 : t1, p2 = k == 1 ? t1 : t0;
            c_[bj] = *(const f32x4*)(cb + bj * DFF + ch) + *(const f32x4*)(cw + 0 * UPW + bj * DFF + ch) * p2 + *(const f32x4*)(cw + 1 * UPW + bj * DFF + ch) * p1 + *(const f32x4*)(cw + 2 * UPW + bj * DFF + ch) * cur; }
        f32x4 o;
#pragma unroll
        for (int i = 0; i < 4; ++i) o[i] = c_[0][i] * sigmoidf_(c_[0][i]) * c_[1][i];
        *(v2u*)(A + (size_t)(64 * s + k) * K_DN + ch) = (v2u){pk2(o[0], o[1]), pk2(o[2], o[3])}; }
}
#define XB_TMO      128
#define XB_XCNT(j)  (256  + 64 * (j))
#define XB_XSUB(j)  (1280 + 64 * (j))
#define XB_XGEN(j)  (2304 + 64 * (j))
#define XB_TOP      3328
#define XB_TOPGEN   3392
#define XCD_BAR_WORDS 3456
#define XB_SPIN_CAP (1u << 18)

__device__ __forceinline__ unsigned xb_ld(unsigned* p)              { return __hip_atomic_load(p, __ATOMIC_RELAXED, __HIP_MEMORY_SCOPE_AGENT); }
__device__ __forceinline__ unsigned xb_add(unsigned* p, unsigned v) { return __hip_atomic_fetch_add(p, v, __ATOMIC_RELAXED, __HIP_MEMORY_SCOPE_AGENT); }
__device__ __forceinline__ unsigned xb_xcc_id() { return (unsigned)__builtin_amdgcn_s_getreg((3 << 11) | 20) & 0xFu; }
#define XB_SPIN(cond, bar) do { unsigned _sp = 0; while (cond) { __builtin_amdgcn_s_sleep(1); \
    if ((++_sp & 255u) == 0u) { if (xb_ld(&(bar)[XB_TMO])) break; if (_sp > XB_SPIN_CAP) { atomicAdd(&(bar)[XB_TMO], 1u); break; } } } } while (0)

struct XcdBarrier {
    unsigned* bar; unsigned x;
    volatile LAS unsigned* st;
};

__device__ __forceinline__ XcdBarrier xcd_barrier_post(unsigned* bar, volatile LAS unsigned* st) {
    XcdBarrier b; b.bar = bar; b.x = xb_xcc_id(); b.st = st;
    if (threadIdx.x == 0) (void)xb_add(&bar[XB_XCNT(b.x)], 1u);
    return b;
}
__device__ __forceinline__ void xcd_barrier_complete(unsigned* bar, unsigned x, unsigned& nloc, unsigned& nx) {
    const unsigned G = gridDim.x * gridDim.y * gridDim.z;
    unsigned sum, cnt, mine, sp = 0u;
    for (;;) {
        sum = 0u; cnt = 0u; mine = 0u;
#pragma unroll
        for (unsigned j = 0; j < 16; ++j) { const unsigned c = xb_ld(&bar[XB_XCNT(j)]); sum += c; cnt += (c > 0u) ? 1u : 0u; mine = (j == x) ? c : mine; }
        if (sum == G) break;
        __builtin_amdgcn_s_sleep(1);
        if ((++sp & 255u) == 0u) { if (xb_ld(&bar[XB_TMO])) break; if (sp > XB_SPIN_CAP) { atomicAdd(&bar[XB_TMO], 1u); break; } }
    }
    nloc = mine > 0u ? mine : 1u; nx = cnt > 0u ? cnt : 1u;
}

__device__ __forceinline__ void xcd_barrier(const XcdBarrier& b) {
    asm volatile("s_waitcnt vmcnt(0)" ::: "memory");
    __syncthreads();
    if (threadIdx.x == 0) {
        unsigned* bar = b.bar;
        __builtin_amdgcn_s_waitcnt(0);
        unsigned nloc = b.st[0], nx = b.st[1];
        if (nloc == 0u) { xcd_barrier_complete(bar, b.x, nloc, nx); b.st[0] = nloc; b.st[1] = nx; }
        const unsigned old = xb_add(&bar[XB_XSUB(b.x)], 1u);
        const unsigned gen = old / nloc;
        if (old + 1u == (gen + 1u) * nloc) {
            __builtin_amdgcn_fence(__ATOMIC_RELEASE, "agent");
            asm volatile("s_waitcnt vmcnt(0)" ::: "memory");
            const unsigned og = xb_add(&bar[XB_TOP], 1u);
            const unsigned tg = og / nx;
            if (og + 1u == (tg + 1u) * nx) xb_add(&bar[XB_TOPGEN], 1u);
            else XB_SPIN(xb_ld(&bar[XB_TOPGEN]) == tg, bar);
            __builtin_amdgcn_fence(__ATOMIC_ACQUIRE, "agent");
            xb_add(&bar[XB_XGEN(b.x)], 1u);
            asm volatile("s_waitcnt vmcnt(0)" ::: "memory");
        } else {
            XB_SPIN(xb_ld(&bar[XB_XGEN(b.x)]) == gen, bar);
            __builtin_amdgcn_fence(__ATOMIC_ACQUIRE, "agent");
            asm volatile("s_waitcnt vmcnt(0)" ::: "memory");
        }
    }
    __syncthreads();
}
#ifndef ATT_REP
#define ATT_REP 1
#endif
namespace att {
constexpr int SLOTB = 16384, VOFF = 8192, OSTG = 65536, SLAB = 65536, SLABW = 4352, IMP = 100352, WSF = 104704, SELM = 106752;
__device__ __forceinline__ int crow(int r, int hi) { return (r & 3) + 8 * (r >> 2) + 4 * hi; }
#define SBAR() __builtin_amdgcn_sched_barrier(0)
__device__ __forceinline__ void glds16(const void* gsrc, unsigned lds_dst) { unsigned keep;
    asm volatile("s_mov_b32 %0, m0\n\ts_mov_b32 m0, %2\n\ts_nop 0\n\tglobal_load_lds_dwordx4 %1, off\n\ts_mov_b32 m0, %0" : "=&s"(keep) : "v"(gsrc), "s"(lds_dst) : "memory"); }
typedef float f32x2_t __attribute__((ext_vector_type(2))); typedef __bf16 bf16x2_t __attribute__((ext_vector_type(2)));
__device__ __forceinline__ unsigned cvtpk_s(float lo, float hi) { f32x2_t v = {lo, hi}; bf16x2_t b = __builtin_convertvector(v, bf16x2_t); return __builtin_bit_cast(unsigned, b); }
__device__ __forceinline__ void qkt(f32x16& p0, f32x16& p1, const LAS unsigned char* Kslot, const bf16x8* qr, int r32, int hi) {
    const LAS unsigned char* kb = Kslot + hi * 1024 + r32 * 16;
#pragma unroll
    for (int d0 = 0; d0 < 4; ++d0) {
        const bf16x8 b0 = *(const LAS bf16x8*)(kb + d0 * 2048);
        const bf16x8 b1 = *(const LAS bf16x8*)(kb + d0 * 2048 + 512);
        if (d0 == 0) { __builtin_amdgcn_s_setprio(1); p0 = __builtin_amdgcn_mfma_f32_32x32x16_bf16(b0, qr[0], f32x16{}, 0, 0, 0); p1 = __builtin_amdgcn_mfma_f32_32x32x16_bf16(b1, qr[0], f32x16{}, 0, 0, 0); }
        else { p0 = __builtin_amdgcn_mfma_f32_32x32x16_bf16(b0, qr[d0], p0, 0, 0, 0); p1 = __builtin_amdgcn_mfma_f32_32x32x16_bf16(b1, qr[d0], p1, 0, 0, 0); } }
    __builtin_amdgcn_s_setprio(0);
}
__device__ __forceinline__ void pv(f32x16* o, int vb, bf16x8 pa0, bf16x8 pa1, bf16x8 pa2, bf16x8 pa3) {
#pragma unroll
    for (int d0 = 0; d0 < 2; ++d0) { s16x4 lo[4], hi[4];
#pragma unroll
        for (int ks = 0; ks < 4; ++ks) {
            asm volatile("ds_read_b64_tr_b16 %0,%1 offset:%c2" : "=&v"(lo[ks]) : "v"(vb), "i"(d0 * 4096 + ks * 1024) : "memory");
            asm volatile("ds_read_b64_tr_b16 %0,%1 offset:%c2" : "=&v"(hi[ks]) : "v"(vb), "i"(d0 * 4096 + ks * 1024 + 512) : "memory"); }
        asm volatile("s_waitcnt lgkmcnt(0)" ::: "memory"); SBAR();
#define PK(k) (bf16x8){lo[k][0], lo[k][1], lo[k][2], lo[k][3], hi[k][0], hi[k][1], hi[k][2], hi[k][3]}
        o[d0] = __builtin_amdgcn_mfma_f32_32x32x16_bf16(pa0, PK(0), o[d0], 0, 0, 0);
        o[d0] = __builtin_amdgcn_mfma_f32_32x32x16_bf16(pa1, PK(1), o[d0], 0, 0, 0);
        o[d0] = __builtin_amdgcn_mfma_f32_32x32x16_bf16(pa2, PK(2), o[d0], 0, 0, 0);
        o[d0] = __builtin_amdgcn_mfma_f32_32x32x16_bf16(pa3, PK(3), o[d0], 0, 0, 0);
#undef PK
    }
}
__device__ __forceinline__ float rowmax(const f32x16& p0, const f32x16& p1) {
    float a = fmaxf(p0[0], p1[0]);
#pragma unroll
    for (int r = 1; r < 16; ++r) a = fmaxf(a, fmaxf(p0[r], p1[r]));
    auto rr = __builtin_amdgcn_permlane32_swap(__float_as_uint(a), __float_as_uint(a), false, false);
    return fmaxf(__uint_as_float(rr[0]), __uint_as_float(rr[1]));
}
typedef __attribute__((address_space(3))) const char* lds_cptr;
typedef short v4i16_t __attribute__((ext_vector_type(4)));
__device__ __forceinline__ s16x4 vtr(lds_cptr p) { return __builtin_bit_cast(s16x4, __builtin_amdgcn_ds_read_tr16_b64_v4i16((__attribute__((address_space(3))) v4i16_t*)p)); }
struct VFrag { s16x4 lo[8], hi[8]; };
__device__ __forceinline__ void vload(VFrag& f, lds_cptr vp) {
#pragma unroll
    for (int i = 0; i < 8; ++i) { f.lo[i] = vtr(vp + ((i >> 2) * 4096 + (i & 3) * 1024)); f.hi[i] = vtr(vp + ((i >> 2) * 4096 + (i & 3) * 1024 + 512)); }
}
__device__ __forceinline__ void pv2(f32x16* o, const VFrag& f, bf16x8 pa0, bf16x8 pa1, bf16x8 pa2, bf16x8 pa3) {
#define VFR(i) (bf16x8){f.lo[i][0], f.lo[i][1], f.lo[i][2], f.lo[i][3], f.hi[i][0], f.hi[i][1], f.hi[i][2], f.hi[i][3]}
    __builtin_amdgcn_s_setprio(1);
    o[0] = __builtin_amdgcn_mfma_f32_32x32x16_bf16(pa0, VFR(0), o[0], 0, 0, 0); o[1] = __builtin_amdgcn_mfma_f32_32x32x16_bf16(pa0, VFR(4), o[1], 0, 0, 0);
    o[0] = __builtin_amdgcn_mfma_f32_32x32x16_bf16(pa1, VFR(1), o[0], 0, 0, 0); o[1] = __builtin_amdgcn_mfma_f32_32x32x16_bf16(pa1, VFR(5), o[1], 0, 0, 0);
    o[0] = __builtin_amdgcn_mfma_f32_32x32x16_bf16(pa2, VFR(2), o[0], 0, 0, 0); o[1] = __builtin_amdgcn_mfma_f32_32x32x16_bf16(pa2, VFR(6), o[1], 0, 0, 0);
    o[0] = __builtin_amdgcn_mfma_f32_32x32x16_bf16(pa3, VFR(3), o[0], 0, 0, 0); o[1] = __builtin_amdgcn_mfma_f32_32x32x16_bf16(pa3, VFR(7), o[1], 0, 0, 0);
    __builtin_amdgcn_s_setprio(0);
#undef VFR
}
__device__ __forceinline__ void pack_p(const f32x16& p0, const f32x16& p1, bf16x8& pa0, bf16x8& pa1, bf16x8& pa2, bf16x8& pa3) {
    v4u w0 = {cvtpk_s(p0[0], p0[1]), cvtpk_s(p0[2], p0[3]), cvtpk_s(p0[4], p0[5]), cvtpk_s(p0[6], p0[7])};
    v4u w1 = {cvtpk_s(p0[8], p0[9]), cvtpk_s(p0[10], p0[11]), cvtpk_s(p0[12], p0[13]), cvtpk_s(p0[14], p0[15])};
    v4u w2 = {cvtpk_s(p1[0], p1[1]), cvtpk_s(p1[2], p1[3]), cvtpk_s(p1[4], p1[5]), cvtpk_s(p1[6], p1[7])};
    v4u w3 = {cvtpk_s(p1[8], p1[9]), cvtpk_s(p1[10], p1[11]), cvtpk_s(p1[12], p1[13]), cvtpk_s(p1[14], p1[15])};
    pa0 = __builtin_bit_cast(bf16x8, w0); pa1 = __builtin_bit_cast(bf16x8, w1); pa2 = __builtin_bit_cast(bf16x8, w2); pa3 = __builtin_bit_cast(bf16x8, w3);
}
#define LBAR() do { asm volatile("s_waitcnt lgkmcnt(0)" ::: "memory"); __builtin_amdgcn_s_barrier(); asm volatile("" ::: "memory"); } while (0)

__device__ __forceinline__ void attn_unit(const Args& a, int b, int g, int c, LAS unsigned char* lds) {
    int tid = threadIdx.x; asm volatile("" : "+v"(tid));
    const int lane = tid & 63, r32 = lane & 31, hi = lane >> 5; const int wid = __builtin_amdgcn_readfirstlane(tid >> 6);
    unsigned char* ws = a.ws;
    const unsigned lds0 = (unsigned)(uintptr_t)lds;
    const int head = g * 8 + wid, q0 = 32 * c, cur = c >> 1, tq = q0 + r32; const size_t m0 = (size_t)b * SEQ + q0;
    const bf16* Q = (const bf16*)(ws + WS_Q); const float* NG = (const float*)(ws + WS_NG);
    LAS float* wsf = (LAS float*)(lds + WSF) + wid * 64;
    LAS float* slab = (LAS float*)(lds + SLAB + wid * SLABW);
    LAS float* imp = (LAS float*)(lds + IMP);
    LAS unsigned* selm = (LAS unsigned*)(lds + SELM);
    const int ncmp = (c >= 32) ? 2 : 1, nsel = cur + 1, nwin = (cur < 8 ? cur : 8) + 1, NS = ncmp + nsel + nwin;
    const unsigned cmp_e = (unsigned)(WS_CMP / 2) + (unsigned)((b * 2 + g) * 8192);
    const unsigned kv_e = (unsigned)(WS_KV / 2) + (unsigned)(b * SEQ * 128 + g * 64);
    const unsigned krow = lane, kcol = wid * 8, vrow = 16 * (wid & 3) + (lane >> 2), vcol = (wid >> 2) * 32 + (lane & 3) * 8;
    const unsigned kdst = lds0 + wid * 1024, vdst = lds0 + VOFF + wid * 1024;
    const bf16* wsb = (const bf16*)ws;
#define ISSUE(s_) do { const int s__ = (s_); unsigned ke_, ve_; \
        if (s__ < ncmp) { ke_ = cmp_e + (unsigned)(s__ * 4096) + krow * 64 + kcol; ve_ = cmp_e + (unsigned)(BATCH * 2 * 8192 + s__ * 4096) + vrow * 64 + vcol; } \
        else { const bool sl_ = s__ < ncmp + nsel; const int t_ = cur - (sl_ ? s__ - ncmp : s__ - ncmp - nsel); const unsigned be_ = kv_e + (unsigned)((sl_ ? 2 : 4) * (MTOK * 128)) + (unsigned)(t_ * 8192); \
               ke_ = be_ + krow * 128 + kcol; ve_ = be_ + (unsigned)(MTOK * 128) + vrow * 128 + vcol; } \
        glds16(wsb + ke_, (unsigned)__builtin_amdgcn_readfirstlane(kdst + (s__ & 3) * SLOTB)); glds16(wsb + ve_, (unsigned)__builtin_amdgcn_readfirstlane(vdst + (s__ & 3) * SLOTB)); } while (0)
#define STEP_SYNC(s_) do { if ((s_) + 1 < NS) asm volatile("s_waitcnt vmcnt(2) lgkmcnt(0)" ::: "memory"); else asm volatile("s_waitcnt vmcnt(0) lgkmcnt(0)" ::: "memory"); \
        __builtin_amdgcn_s_barrier(); asm volatile("" ::: "memory"); if ((s_) + 2 < NS) ISSUE((s_) + 2); } while (0)
    asm volatile("s_waitcnt vmcnt(0) lgkmcnt(0)" ::: "memory"); __builtin_amdgcn_s_barrier(); asm volatile("" ::: "memory");
    ISSUE(0); ISSUE(1);
    if (tid < 32) selm[tid] = 0u;
    bf16x8 qr[4];
#pragma unroll
    for (int d0 = 0; d0 < 4; ++d0) qr[d0] = *(const bf16x8*)(Q + (m0 + r32) * 1024 + head * 64 + d0 * 16 + hi * 8);
    const float g_c = NG[(m0 + r32) * 48 + head * 3 + 0], g_s = NG[(m0 + r32) * 48 + head * 3 + 1], g_w = NG[(m0 + r32) * 48 + head * 3 + 2];
    f32x16 ofin[2]; ofin[0] = f32x16{}; ofin[1] = f32x16{};
    const int vbo = VOFF + ((lane >> 4) & 1) * 32 + (lane & 3) * 8 + (4 * hi + ((lane & 15) >> 2)) * 64;
    const int vbl = (int)lds0 + vbo;
    unsigned selbits = 0u;
    STEP_SYNC(0);
    if (ncmp == 2) STEP_SYNC(1);
    {
            f32x16 sc[4];
            qkt(sc[0], sc[1], lds, qr, r32, hi);
            if (ncmp == 2) qkt(sc[2], sc[3], lds + SLOTB, qr, r32, hi);
            else {
#pragma unroll
                for (int r = 0; r < 16; ++r) { sc[2][r] = NEGBIG; sc[3][r] = NEGBIG; } }
            const int hiq = (tq - 31) >> 4;
#pragma unroll
            for (int k = 0; k < 4; ++k)
#pragma unroll
                for (int r = 0; r < 16; ++r) { const int n = 32 * k + crow(r, hi); if (n > hiq) sc[k][r] = NEGBIG; }
            const float mx = fmaxf(rowmax(sc[0], sc[1]), rowmax(sc[2], sc[3]));
            float sum = 0.f;
#pragma unroll
            for (int k = 0; k < 4; ++k)
#pragma unroll
                for (int r = 0; r < 16; ++r) { sc[k][r] = __builtin_amdgcn_exp2f(sc[k][r] - mx); sum += sc[k][r]; }
            sum += __shfl_xor(sum, 32);
            const float inv = (hiq >= 0) ? 1.0f / sum : 0.f;
            float prevrecv = 0.f;
#pragma unroll
            for (int k = 0; k < 4; ++k)
#pragma unroll
                for (int a4 = 0; a4 < 4; ++a4) { const int idx = 4 * k + a4;
#pragma unroll
                    for (int e = 0; e < 4; ++e) sc[k][4 * a4 + e] *= inv;
                    const float g4 = (sc[k][4 * a4] + sc[k][4 * a4 + 1]) + (sc[k][4 * a4 + 2] + sc[k][4 * a4 + 3]);
                    const float recv = __shfl_xor(sc[k][4 * a4 + 3], 32); const float add = hi ? recv : prevrecv; prevrecv = recv;
                    slab[r32 * 33 + 2 * idx + hi] = g4 + add; }
#pragma unroll
            for (int k = 0; k < 4; ++k)
#pragma unroll
                for (int r = 0; r < 16; ++r) sc[k][r] *= g_c;
            bf16x8 pa0, pa1, pa2, pa3;
            pack_p(sc[0], sc[1], pa0, pa1, pa2, pa3); pv(ofin, vbl, pa0, pa1, pa2, pa3);
            if (ncmp == 2) { pack_p(sc[2], sc[3], pa0, pa1, pa2, pa3); pv(ofin, vbl + SLOTB, pa0, pa1, pa2, pa3); }
            LBAR();
            { const int q = tid >> 4, jp = tid & 15;
#pragma unroll
              for (int e = 0; e < 2; ++e) { const int j = 2 * jp + e; float t = 0.f;
#pragma unroll
                  for (int w = 0; w < 8; ++w) t += ((LAS float*)(lds + SLAB + w * SLABW))[q * 33 + j];
                  imp[q * 33 + j] = t; } }
            LBAR();
            { const int q = tid >> 4, jp = tid & 15, j0 = 2 * jp, j1 = j0 + 1;
              const float NINF = -1e30f;
              const float s0 = j0 <= cur ? imp[q * 33 + j0] + ((j0 == 0 || j0 == cur || j0 == cur - 1) ? 1000.f : 0.f) : NINF;
              const float s1 = j1 <= cur ? imp[q * 33 + j1] + ((j1 == 0 || j1 == cur || j1 == cur - 1) ? 1000.f : 0.f) : NINF;
              int rk0 = 0, rk1 = 0;
              for (int jj = 0; jj < 32; ++jj) { const float sj = jj <= cur ? imp[q * 33 + jj] + ((jj == 0 || jj == cur || jj == cur - 1) ? 1000.f : 0.f) : NINF;
                  rk0 += (sj > s0 || (sj == s0 && jj < j0)) ? 1 : 0; rk1 += (sj > s1 || (sj == s1 && jj < j1)) ? 1 : 0; }
              const unsigned bits = (rk0 < 8 ? (1u << j0) : 0u) | (rk1 < 8 ? (1u << j1) : 0u);
              if (bits) atomicOr((unsigned*)(selm + q), bits); }
            LBAR();
            selbits = selm[r32];
    }
    float mref = NEGBIG, lsum = 0.f; f32x16 o[2]; o[0] = f32x16{}; o[1] = f32x16{};
#pragma unroll 1
    for (int s = ncmp; s < NS; ++s) {
        STEP_SYNC(s);
        const int slot = (s & 3) * SLOTB;
        const bool issel = s < ncmp + nsel;
        const int j = issel ? s - ncmp : s - ncmp - nsel, t = cur - j;
        const bool lastt = issel ? (j == nsel - 1) : (j == nwin - 1);
        f32x16 p0, p1;
        VFrag vf; vload(vf, (lds_cptr)lds + vbo + slot);
        qkt(p0, p1, lds + slot, qr, r32, hi);
        if (issel) { const bool sel = (selbits >> t) & 1u;
#pragma unroll
            for (int r = 0; r < 16; ++r) { p0[r] = sel ? p0[r] : NEGBIG; p1[r] = sel ? p1[r] : NEGBIG; } }
        if (t == cur || (!issel && t == cur - 8)) {
            const int kb = 64 * t + 4 * hi, lo_ = issel ? -(1 << 30) : tq - 511;
#pragma unroll
            for (int r = 0; r < 16; ++r) { const int kp = kb + (r & 3) + 8 * (r >> 2); if (kp > tq || kp < lo_) p0[r] = NEGBIG; if (kp + 32 > tq || kp + 32 < lo_) p1[r] = NEGBIG; }
        }
        const float rm = rowmax(p0, p1);
        if (__any(rm > mref + 8.0f)) {
            const float mn = fmaxf(mref, rm), alpha = __builtin_amdgcn_exp2f(mref - mn);
            lsum *= alpha; mref = mn;
            if (hi == 0) wsf[r32] = alpha;
            LDS_WAIT(); asm volatile("" ::: "memory");
#pragma unroll
            for (int r = 0; r < 16; ++r) { const float f = wsf[crow(r, hi)]; o[0][r] *= f; o[1][r] *= f; }
            LDS_WAIT(); asm volatile("" ::: "memory");
        }
        float sm = 0.f;
#pragma unroll
        for (int r = 0; r < 16; ++r) { p0[r] = __builtin_amdgcn_exp2f(p0[r] - mref); p1[r] = __builtin_amdgcn_exp2f(p1[r] - mref); sm += p0[r] + p1[r]; }
        lsum += sm;
        { bf16x8 pa0, pa1, pa2, pa3; pack_p(p0, p1, pa0, pa1, pa2, pa3); pv2(o, vf, pa0, pa1, pa2, pa3); }
        if (lastt) {
            const float lt = lsum + __shfl_xor(lsum, 32);
            if (hi == 0) wsf[r32] = (issel ? g_s : g_w) / lt;
            LDS_WAIT(); asm volatile("" ::: "memory");
#pragma unroll
            for (int r = 0; r < 16; ++r) { const float f = wsf[crow(r, hi)]; ofin[0][r] += o[0][r] * f; ofin[1][r] += o[1][r] * f; }
            LDS_WAIT(); asm volatile("" ::: "memory");
            mref = NEGBIG; lsum = 0.f; o[0] = f32x16{}; o[1] = f32x16{};
        }
    }
#undef ISSUE
#undef STEP_SYNC
    { LAS bf16* stg = (LAS bf16*)(lds + OSTG) + wid * 2048;
#pragma unroll
      for (int r = 0; r < 16; ++r) { const int orow = crow(r, hi);
#pragma unroll
          for (int d0 = 0; d0 < 2; ++d0) stg[orow * 64 + d0 * 32 + r32] = (bf16)(cvtpk_s(ofin[d0][r], 0.f) & 0xffffu); }
      LDS_WAIT(); asm volatile("" ::: "memory");
      bf16* Ow = (bf16*)(ws + WS_ATT) + m0 * 1024 + head * 64;
#pragma unroll
      for (int i = 0; i < 4; ++i) { const int row = i * 8 + (lane >> 3), ch = lane & 7; const v4u v = *(const LAS v4u*)(stg + row * 64 + ch * 8); *(v4u*)(Ow + (size_t)row * 1024 + ch * 8) = v; }
      LDS_WAIT(); asm volatile("" ::: "memory"); }
}

__device__ __forceinline__ void attn_phase(const Args& a, LAS unsigned char* lds, int vcu) {
    const int bg = vcu >> 2, qd = vcu & 3;
    for (int uu = 0; uu < 16 * ATT_REP; ++uu) { const int u = uu & 15; const int i = qd + 4 * (u >> 2), k = u & 3; const int c = (k == 0) ? i : (k == 1) ? 31 - i : (k == 2) ? 32 + i : 63 - i;
        attn_unit(a, bg >> 1, bg & 1, c, lds); }
}
#undef SBAR
#undef LBAR
}
#ifndef MK_COOP
#define MK_COOP 1
#endif
constexpr int N_PHASES = 10;
#ifndef GREP1
#define GREP1 1
#define GREP4 1
#define GREP5 1
#define GREP7 1
#endif
template <int REPS> struct RepOrder { pg8::StaticOrder b; int per;
    __device__ __forceinline__ void init(int M, int N, int G, int c) { b.init(M, N, G, c); per = b.nwg / G; }
    __device__ __forceinline__ bool next(int i, pg8::Unit& u) const { if constexpr (REPS == 1) return b.next(i, u); else { if (i >= per * REPS) return false; return b.next(i % per, u); } }
    __device__ __forceinline__ void a_ready(const pg8::Unit&) const {}
    __device__ __forceinline__ void done(const pg8::Unit&) const {} };
__global__ void __launch_bounds__(NWAVES * 64, 2) fwd_megakernel(Args args) {
    extern __shared__ __attribute__((aligned(16))) unsigned char lds_raw[];
    LAS unsigned char* lds = (LAS unsigned char*)lds_raw;
    const int G = gridDim.x; const int bx = blockIdx.x; const int vcu = (G % 8 == 0) ? (bx % 8) * (G / 8) + bx / 8 : bx;
    unsigned char* ws = args.ws;
    const int lo = args.ph_lo, hi = args.ph_hi;
#ifndef PH_MASK
#define PH_MASK 0x3ff
#endif
#ifndef DUP_MASK
#define DUP_MASK 0
#endif
#define REP(k) _Pragma("nounroll") for (int rep_ = 0; rep_ < 1 + (((DUP_MASK) >> (k)) & 1); ++rep_)
#define PHON(k) (((PH_MASK) >> (k)) & 1)
#define IN(k) (PHON(k) && lo <= (k) && (k) < hi)
    cg::grid_group grid = cg::this_grid();
    volatile LAS unsigned* MISC = (volatile LAS unsigned*)(lds + 131072 + 320);
    for (int u = threadIdx.x; u < (LDS_BYTES - 131072) / 4; u += NWAVES * 64) ((LAS unsigned*)(lds + 131072))[u] = 0u;
    __syncthreads();
    XcdBarrier bar = xcd_barrier_post((unsigned*)(ws + WS_CTL) + 4096, MISC + 8);
#define GRID_BAR(k) do { if (IN(k) && IN((k) + 1)) { if ((k) == 0) grid.sync(); else xcd_barrier(bar); } } while (0)
    REP(0) if (IN(0)) { p0_prologue(args, lds, vcu, G); }
    GRID_BAR(0);
    REP(1) if (IN(1)) {
        pg8::Gemm g{(const bf16*)(ws + WS_XB), (const bf16*)(ws + WS_WIN), MTOK, N_IN, DM}; RepOrder<GREP1> S; S.init(MTOK, N_IN, G, bx);
        EpiIn E{(const float*)(ws + WS_R1), (bf16*)(ws + WS_UPOOL), (bf16*)(ws + WS_Q), (bf16*)(ws + WS_KV), (unsigned char*)(ws + WS_MG), (float*)(ws + WS_NG), args.in[I_QNW], args.in[I_KNW], (const float*)(ws + WS_ROPE)};
        pg8::gemm_phase<EpiIn, RepOrder<GREP1>, true, true>(lds, g, S, E);
    }
    GRID_BAR(1);
    REP(2) if (IN(2)) { p2_pool_compress(args, lds, vcu, G); }
    GRID_BAR(2);
    REP(3) if (IN(3)) { __syncthreads(); att::attn_phase(args, lds, vcu); }
    GRID_BAR(3);
    REP(4) if (IN(4)) {
        { pg8::Gemm g{(const bf16*)(ws + WS_POOLED), (const bf16*)(ws + WS_WPB), MTOK, DM, 512}; RepOrder<GREP4> S; S.init(MTOK, DM, G, bx);
          EpiGate E{(const unsigned char*)(ws + WS_MG), (bf16*)(ws + WS_PY), (bf16*)(ws + WS_MERGED), 1};
          pg8::gemm_phase<EpiGate, RepOrder<GREP4>, true, true>(lds, g, S, E); }
        { pg8::Gemm g{(const bf16*)(ws + WS_ATT), (const bf16*)(ws + WS_WAB), MTOK, DM, DM}; RepOrder<GREP4> S; S.init(MTOK, DM, G, bx);
          EpiGate E{(const unsigned char*)(ws + WS_MG), (bf16*)(ws + WS_PY), (bf16*)(ws + WS_MERGED), 0};
          pg8::gemm_phase<EpiGate, RepOrder<GREP4>, true, true>(lds, g, S, E); }
    }
    GRID_BAR(4);
    REP(5) if (IN(5)) {
        pg8::Gemm g{(const bf16*)(ws + WS_MERGED), (const bf16*)(ws + WS_WO), MTOK, DM, DM}; RepOrder<GREP5> S; S.init(MTOK, DM, G, bx);
        EpiWo E{(const bf16*)(ws + WS_XB), (bf16*)(ws + WS_X1B), (float*)(ws + WS_SSQ)};
        pg8::gemm_phase<EpiWo, RepOrder<GREP5>, true, true>(lds, g, S, E);
    }
    GRID_BAR(5);
    REP(6) if (IN(6)) { p5b_r2(args, vcu, G); }
    GRID_BAR(6);
    REP(7) if (IN(7)) {
        pg8::Gemm g{(const bf16*)(ws + WS_X1B), (const bf16*)(ws + WS_WUP), MTOK, N_UP, DM}; RepOrder<GREP7> S; S.init(MTOK, N_UP, G, bx);
        EpiUp E{(const float*)(ws + WS_R1), args.in[I_CONVW], args.in[I_CONVB], (bf16*)(ws + WS_A), (float*)(ws + WS_RAW)};
        pg8::gemm_phase<EpiUp, RepOrder<GREP7>, true, true>(lds, g, S, E);
    }
    GRID_BAR(7);
    REP(8) if (IN(8)) { p7_fixup(args, vcu, G); }
    GRID_BAR(8);
    REP(9) if (IN(9)) {
        pg8::Gemm g{(const bf16*)(ws + WS_A), (const bf16*)(ws + WS_WDN), MTOK, DM, K_DN}; pg8::StaticOrder S; S.init(MTOK, DM, G, bx);
        EpiDown E{(const bf16*)(ws + WS_X1B), args.out};
        pg8::gemm_phase<EpiDown, pg8::StaticOrder, true, true>(lds, g, S, E);
    }
#undef IN
#undef GRID_BAR
}

extern "C" void kernel_launch(void* const* d_in, const int* in_sizes, int n_in, void* d_out, int out_size, void* d_ws, size_t ws_size, hipStream_t stream) {
    static int grid = 0;
    if (grid == 0) {
        if (n_in != 19 || in_sizes[0] != MTOK * DM || out_size != MTOK * DM || ws_size < WS_END) {
            fprintf(stderr, "kernel_launch: unexpected shapes: n_in %d in0 %d out %d ws %zu (need %zu)\n", n_in, n_in > 0 ? in_sizes[0] : -1, out_size, ws_size, (size_t)WS_END); grid = -1; return; }
        int dev = 0, cus = 0, per_cu = 0;
        hipGetDevice(&dev); hipDeviceGetAttribute(&cus, hipDeviceAttributeMultiprocessorCount, dev);
        if (hipFuncSetAttribute((const void*)fwd_megakernel, hipFuncAttributeMaxDynamicSharedMemorySize, LDS_BYTES) != hipSuccess) { fprintf(stderr, "kernel_launch: hipFuncSetAttribute failed\n"); grid = -1; return; }
        if (hipOccupancyMaxActiveBlocksPerMultiprocessor(&per_cu, (const void*)fwd_megakernel, NWAVES * 64, LDS_BYTES) != hipSuccess || per_cu < 1) { fprintf(stderr, "kernel_launch: occupancy query says %d\n", per_cu); per_cu = 1; }
        (void)hipGetLastError();
        grid = cus;
        if (grid != 256) fprintf(stderr, "kernel_launch: note: %d CUs (built for 256)\n", grid);
    }
    if (grid < 0) return;
    Args a{};
    for (int i = 0; i < 19; ++i) a.in[i] = (const float*)d_in[i];
    a.out = (float*)d_out; a.ws = (unsigned char*)d_ws;
#if MK_COOP
    a.ph_lo = 0; a.ph_hi = N_PHASES;
    if (hipMemsetAsync((char*)d_ws + WS_CTL, 0, CTL_ZERO_BYTES, stream) != hipSuccess) { fprintf(stderr, "kernel_launch: hipMemsetAsync failed\n"); return; }
    void* kargs[] = {&a};
    hipError_t e = hipLaunchCooperativeKernel((const void*)fwd_megakernel, dim3(grid), dim3(NWAVES * 64), kargs, LDS_BYTES, stream);
    if (e != hipSuccess) fprintf(stderr, "kernel_launch: cooperative launch failed: %s (grid %d)\n", hipGetErrorString(e), grid);
#else
    for (int p = 0; p < N_PHASES; ++p) { a.ph_lo = p; a.ph_hi = p + 1; hipLaunchKernelGGL(fwd_megakernel, dim3(grid), dim3(NWAVES * 64), LDS_BYTES, stream, a); }
#endif
}
```

```cpp
#include <hip/hip_runtime.h>
#include <hip/hip_cooperative_groups.h>
#include <cstdio>
#include <cstdint>
namespace cg = cooperative_groups;
namespace pg8 {
#define PG8_LAS __attribute__((address_space(3)))
typedef unsigned short bf16_t;
typedef short bf16x8 __attribute__((ext_vector_type(8)));
typedef float f32x4 __attribute__((ext_vector_type(4)));
typedef unsigned u32x4 __attribute__((ext_vector_type(4)));
constexpr int BM = 256, BK = 64, HALF = 128, HTB = HALF * BK * 2  , STAGE_BYTES = 8 * HTB, NXCD = 8, WGM = 8;

__host__ __device__ __forceinline__ int lds_byte(int r, int c) { const int st = (r >> 4) * 2 + (c >> 5), rr = r & 15, cc = c & 31, ob = rr * 64 + cc * 2; return st * 1024 + (ob ^ (((ob >> 9) & 1) << 5)); }
__host__ __device__ __forceinline__ void stage_rc(int b, int& R, int& C) { const int st = b / 1024, sb = b % 1024, swz = sb ^ (((sb >> 9) & 1) << 5); R = (st >> 1) * 16 + swz / 64; C = (st & 1) * 32 + (swz % 64) / 2; }
__host__ __device__ __forceinline__ int perm32(int rho) { const int n = rho >> 4, i = rho & 15; return 8 * (i >> 2) + 4 * n + (i & 3); }

struct Unit { int pm, pn; };
struct Gemm { const bf16_t* A; const bf16_t* Bt; int M, N, K; int erep = 1; };

struct StaticOrder {
    int nM, nN, nwg, G, c;
    __host__ __device__ void init(int M, int N, int G_, int c_) { nM = M / BM; nN = N / BM; nwg = nM * nN; G = G_; c = c_; }
    __host__ __device__ bool next(int i, Unit& u) const {
        const long L = (long)i * G + c; if (L >= nwg) return false;
        int wgid = (int)L; { const int q = nwg / NXCD, r = nwg % NXCD, xcd = wgid % NXCD, off = wgid / NXCD; wgid = (xcd < r ? xcd * (q + 1) : r * (q + 1) + (xcd - r) * q) + off; }
        const int nig = WGM * nN, gid = wgid / nig, fm = gid * WGM, gsz = (nM - fm) < WGM ? (nM - fm) : WGM;
        u.pm = fm + ((wgid % nig) % gsz); u.pn = (wgid % nig) / gsz; return true;
    }
    __device__ __forceinline__ void a_ready(const Unit&) const {}
    __device__ __forceinline__ void done(const Unit&) const {}
};

__device__ __forceinline__ unsigned cvt_pk_bf16(float lo, float hi) { unsigned r; asm volatile("v_cvt_pk_bf16_f32 %0, %1, %2" : "=v"(r) : "v"(lo), "v"(hi)); return r; }
typedef float f32x2 __attribute__((ext_vector_type(2)));
#ifndef KLOOP_REP
#define KLOOP_REP 1
#endif
#ifndef GEMM_PROF
#define GEMM_PROF 0
#endif
#if GEMM_PROF
#define GSTAMP(var) unsigned long long var; do { __builtin_amdgcn_sched_barrier(0); var = __builtin_amdgcn_s_memtime(); __builtin_amdgcn_s_waitcnt(0xC07F); __builtin_amdgcn_sched_barrier(0); } while (0)
#define GADD(k, a_, b_) do { if (threadIdx.x == 0 && g.erep == 3) atomicAdd((unsigned*)((PG8_LAS unsigned*)(lds + 147392) + (k)), (unsigned)((b_) - (a_))); } while (0)
#else
#define GSTAMP(var) do { } while (0)
#define GADD(k, a_, b_) do { } while (0)
#endif
#ifndef EPI_REP
#define EPI_REP 1
#endif
template <class Epi, class Sched, bool ALIGN_EPI = false, bool SP2 = false>
__device__ __forceinline__ void gemm_phase(PG8_LAS unsigned char* lds, const Gemm g, const Sched& S, const Epi& E) {
    int tid_ = threadIdx.x; asm volatile("" : "+v"(tid_));
    const int tid = tid_, wid = __builtin_amdgcn_readfirstlane(tid >> 6), lane = tid & 63, wr = wid >> 2, wc = wid & 3, fr = lane & 15, fq = lane >> 4;
    const int K = g.K, nt = K / BK;
    unsigned voffA[2], voffB[2];
#pragma unroll
    for (int i = 0; i < 2; ++i) { int R, C; stage_rc(tid * 16 + i * 8192, R, C); const int Rb = Epi::PERM ? ((R & ~31) + perm32(R & 31)) : R;
        const int Ra = Epi::APERM ? ((R & ~63) + 4 * (R & 15) + ((R >> 4) & 3)) : R;
        voffA[i] = (unsigned)(Ra * K + C) * 2u; voffB[i] = (unsigned)(Rb * K + C) * 2u; }
    const size_t kstep = (size_t)(BK * 2);
    const size_t hstep = (size_t)HALF * K * 2;
    const size_t tstep = 2 * hstep;
    const unsigned ldsw = (unsigned)wid * 1024u;
    const int aoff = lds_byte(wr * 64 + fr, fq * 8), boff = lds_byte(wc * 32 + fr, fq * 8);
#define PG8_SA(b, h) (((b) * 2 + (h)) * HTB)
#define PG8_SB(b, h) ((4 + (b) * 2 + (h)) * HTB)
#define PG8_STAGE(bufoff, gbase, voff) do { _Pragma("unroll") for (int _i = 0; _i < 2; ++_i) \
        __builtin_amdgcn_global_load_lds((const unsigned*)((const char*)(gbase) + (voff)[_i]), (PG8_LAS unsigned*)(lds + (bufoff) + ldsw + _i * 8192), 16, 0, 0); } while (0)
#define PG8_LDA(dst, b, h) do { _Pragma("unroll") for (int m = 0; m < 4; ++m) _Pragma("unroll") for (int k = 0; k < 2; ++k) dst[m][k] = *(const PG8_LAS bf16x8*)(lds + PG8_SA(b, h) + aoff + m * 2048 + k * 1024); } while (0)
#define PG8_LDB(dst, b, h) do { _Pragma("unroll") for (int n = 0; n < 2; ++n) _Pragma("unroll") for (int k = 0; k < 2; ++k) dst[n][k] = *(const PG8_LAS bf16x8*)(lds + PG8_SB(b, h) + boff + n * 2048 + k * 1024); } while (0)
#define PG8_MMA(ai, bj, At, Bt) do { __builtin_amdgcn_s_setprio(1); _Pragma("unroll") for (int m = 0; m < 4; ++m) _Pragma("unroll") for (int n = 0; n < 2; ++n) _Pragma("unroll") for (int k = 0; k < 2; ++k) \
        acc[ai][bj][m][n] = __builtin_amdgcn_mfma_f32_16x16x32_bf16(Bt[n][k], At[m][k], acc[ai][bj][m][n], 0, 0, 0); __builtin_amdgcn_s_setprio(0); } while (0)
#define PG8_WAIT_V(n) asm volatile("s_waitcnt vmcnt(" #n ")" ::: "memory")
#define PG8_WAIT_L(n) asm volatile("s_waitcnt lgkmcnt(" #n ")" ::: "memory")
#define PG8_BAR __builtin_amdgcn_s_barrier()
#define PG8_SCHED __builtin_amdgcn_sched_barrier(0)
    GSTAMP(G0_);
    Unit cur, nxt; int ui = 0;
    if (!S.next(0, cur)) return;
    f32x4 acc[2][2][4][2];
#pragma unroll
    for (int a = 0; a < 2; ++a)
#pragma unroll
        for (int b = 0; b < 2; ++b)
#pragma unroll
            for (int m = 0; m < 4; ++m)
#pragma unroll
                for (int n = 0; n < 2; ++n) acc[a][b][m][n] = (f32x4){0.f, 0.f, 0.f, 0.f};
    bf16x8 At[4][2], B0[2][2], B1[2][2];
    const char* cA = (const char*)g.A + (size_t)cur.pm * tstep; const char* cB = (const char*)g.Bt + (size_t)cur.pn * tstep;
    S.a_ready(cur);
    if constexpr (SP2) {
        PG8_STAGE(PG8_SB(0, 0), cB, voffB); PG8_STAGE(PG8_SB(0, 1), cB + hstep, voffB); PG8_STAGE(PG8_SA(0, 0), cA, voffA); PG8_STAGE(PG8_SA(0, 1), cA + hstep, voffA);
        if (wr == 1) PG8_BAR;
        PG8_WAIT_V(2); PG8_BAR;
        PG8_STAGE(PG8_SB(1, 0), cB + kstep, voffB); PG8_STAGE(PG8_SA(1, 0), cA + kstep, voffA); PG8_STAGE(PG8_SB(1, 1), cB + hstep + kstep, voffB);
        PG8_WAIT_V(6); PG8_BAR;
    } else {
        PG8_STAGE(PG8_SB(0, 0), cB, voffB); PG8_STAGE(PG8_SA(0, 0), cA, voffA); PG8_STAGE(PG8_SB(0, 1), cB + hstep, voffB); PG8_STAGE(PG8_SA(0, 1), cA + hstep, voffA);
        if (wr == 1) PG8_BAR;
        PG8_WAIT_V(4); PG8_BAR;
        PG8_STAGE(PG8_SB(1, 0), cB + kstep, voffB); PG8_STAGE(PG8_SA(1, 0), cA + kstep, voffA); PG8_STAGE(PG8_SB(1, 1), cB + hstep + kstep, voffB);
        PG8_WAIT_V(6); PG8_BAR;
    }
    for (;;) {
        const bool has_next = S.next(ui + 1, nxt);
        const char* nA = has_next ? (const char*)g.A + (size_t)nxt.pm * tstep : cA; const char* nB = has_next ? (const char*)g.Bt + (size_t)nxt.pn * tstep : cB;
#if KLOOP_REP == 1
        for (int t = 0; t < nt; t += 2) {
            const bool last = (t == nt - 2);
            const char* a1 = cA + (size_t)(t + 1) * kstep;
            const char* a2 = last ? nA : cA + (size_t)(t + 2) * kstep; const char* b2 = last ? nB : cB + (size_t)(t + 2) * kstep;
#else
        for (int t2_ = 0, t = 0; t2_ < nt * g.erep; t2_ += 2, t = (t + 2 == nt) ? 0 : t + 2) {
            const bool last = (t2_ == nt * g.erep - 2); const int tn_ = (t + 2 == nt) ? 0 : t + 2;
            const char* a1 = cA + (size_t)(t + 1) * kstep;
            const char* a2 = last ? nA : cA + (size_t)tn_ * kstep; const char* b2 = last ? nB : cB + (size_t)tn_ * kstep;
#endif
            const char* a3 = a2 + kstep; const char* b3 = b2 + kstep;
            if (last && has_next) S.a_ready(nxt);
            if constexpr (SP2) {
            PG8_LDB(B0, 0, 0); PG8_LDB(B1, 0, 1); PG8_SCHED; PG8_LDA(At, 0, 0); PG8_STAGE(PG8_SA(1, 1), a1 + hstep, voffA);
            PG8_WAIT_V(8); PG8_WAIT_L(0); PG8_BAR; PG8_MMA(0, 0, At, B0); PG8_MMA(0, 1, At, B1); PG8_BAR; PG8_SCHED;
            PG8_LDA(At, 0, 1); PG8_STAGE(PG8_SB(0, 0), b2, voffB); PG8_STAGE(PG8_SB(0, 1), b2 + hstep, voffB); PG8_STAGE(PG8_SA(0, 0), a2, voffA);
            PG8_WAIT_V(8); PG8_WAIT_L(0); PG8_BAR; PG8_MMA(1, 0, At, B0); PG8_MMA(1, 1, At, B1); PG8_BAR; PG8_SCHED;
            PG8_LDB(B0, 1, 0); PG8_LDB(B1, 1, 1); PG8_SCHED; PG8_LDA(At, 1, 0); PG8_STAGE(PG8_SA(0, 1), a2 + hstep, voffA);
            PG8_WAIT_V(8); PG8_WAIT_L(0); PG8_BAR; PG8_MMA(0, 0, At, B0); PG8_MMA(0, 1, At, B1); PG8_BAR; PG8_SCHED;
            PG8_LDA(At, 1, 1); PG8_STAGE(PG8_SB(1, 0), b3, voffB); PG8_STAGE(PG8_SB(1, 1), b3 + hstep, voffB); PG8_STAGE(PG8_SA(1, 0), a3, voffA);
            PG8_WAIT_V(8); PG8_WAIT_L(0); PG8_BAR; PG8_MMA(1, 0, At, B0); PG8_MMA(1, 1, At, B1); PG8_BAR; PG8_SCHED;
            } else {
            PG8_LDB(B0, 0, 0); PG8_SCHED; PG8_LDA(At, 0, 0); PG8_STAGE(PG8_SA(1, 1), a1 + hstep, voffA);
            PG8_WAIT_L(8); PG8_BAR; PG8_WAIT_L(0); PG8_MMA(0, 0, At, B0); PG8_BAR; PG8_SCHED;
            PG8_LDB(B1, 0, 1); PG8_STAGE(PG8_SB(0, 0), b2, voffB);
            PG8_BAR; PG8_WAIT_L(0); PG8_MMA(0, 1, At, B1); PG8_BAR;
            PG8_LDA(At, 0, 1); PG8_STAGE(PG8_SA(0, 0), a2, voffA);
            PG8_BAR; PG8_WAIT_L(0); PG8_MMA(1, 0, At, B0); PG8_BAR; PG8_SCHED;
            PG8_STAGE(PG8_SB(0, 1), b2 + hstep, voffB);
            PG8_WAIT_V(6); PG8_BAR; PG8_MMA(1, 1, At, B1); PG8_BAR;
            PG8_LDB(B0, 1, 0); PG8_SCHED; PG8_LDA(At, 1, 0); PG8_STAGE(PG8_SA(0, 1), a2 + hstep, voffA);
            PG8_WAIT_L(8); PG8_BAR; PG8_WAIT_L(0); PG8_MMA(0, 0, At, B0); PG8_BAR; PG8_SCHED;
            PG8_LDB(B1, 1, 1); PG8_STAGE(PG8_SB(1, 0), b3, voffB);
            PG8_BAR; PG8_WAIT_L(0); PG8_MMA(0, 1, At, B1); PG8_BAR;
            PG8_LDA(At, 1, 1); PG8_STAGE(PG8_SA(1, 0), a3, voffA);
            PG8_BAR; PG8_WAIT_L(0); PG8_MMA(1, 0, At, B0); PG8_BAR; PG8_SCHED;
            PG8_STAGE(PG8_SB(1, 1), b3 + hstep, voffB);
            PG8_WAIT_V(6); PG8_BAR; PG8_MMA(1, 1, At, B1); PG8_BAR;
            }
            if constexpr (Epi::MIDHOOK) { if (t == Epi::HOOK_T) E.mid(acc, cur, wr, wc, fr, fq); }
        }
#if KLOOP_REP != 1
        _Pragma("unroll") for (int a_ = 0; a_ < 2; ++a_) _Pragma("unroll") for (int b_ = 0; b_ < 2; ++b_) _Pragma("unroll") for (int m_ = 0; m_ < 4; ++m_) _Pragma("unroll") for (int n_ = 0; n_ < 2; ++n_) acc[a_][b_][m_][n_] *= (g.erep == 2 ? 0.5f : 1.0f);
#endif
        GSTAMP(E0_);
        if constexpr (ALIGN_EPI) { if (wr == 0) PG8_BAR; }
        if constexpr (!Epi::AFTER_DRAIN) { if (EPI_REP > 1) { _Pragma("nounroll") for (int rep_ = 0; rep_ < g.erep; ++rep_) { asm volatile("" ::: "memory"); E(acc, cur, wr, wc, fr, fq); } } else E(acc, cur, wr, wc, fr, fq); S.done(cur); }
        GSTAMP(E1_); GADD(13 - 8, E0_, E1_);
        if (!has_next) break;
#pragma unroll
        for (int a = 0; a < 2; ++a)
#pragma unroll
            for (int b = 0; b < 2; ++b)
#pragma unroll
                for (int m = 0; m < 4; ++m)
#pragma unroll
                    for (int n = 0; n < 2; ++n) acc[a][b][m][n] = (f32x4){0.f, 0.f, 0.f, 0.f};
        cur = nxt; cA = nA; cB = nB; ++ui;
        if constexpr (ALIGN_EPI) { if (wr == 1) PG8_BAR; }                        GSTAMP(E2_); GADD(14 - 8, E1_, E2_);
    }
    PG8_WAIT_V(0);
    if constexpr (!ALIGN_EPI) { if (wr == 0) PG8_BAR; }
    PG8_BAR;
    if constexpr (Epi::AFTER_DRAIN) { E.fused(acc, cur, wr, wc, fr, fq, lds, wid, lane); S.done(cur); }
    GSTAMP(G1_); GADD(12 - 8, G0_, G1_);
#undef PG8_SA
#undef PG8_SB
#undef PG8_STAGE
#undef PG8_LDA
#undef PG8_LDB
#undef PG8_MMA
#undef PG8_WAIT_V
#undef PG8_WAIT_L
#undef PG8_BAR
#undef PG8_SCHED
}
}
constexpr int BATCH = 32, SEQ = 2048, DM = 1024, MTOK = BATCH * SEQ;
constexpr int KCAT = 1536, IN_W = 4400, N_IN = 4608, DFF = 2752, N_UP = 5632, K_DN = 2816, UPW = 5504;
constexpr float EPS = 1e-6f, QSCALE = 0.125f * 1.4426950408889634f, NEGBIG = -1e30f;
constexpr size_t MiB = 1u << 20;
constexpr size_t WS_CTL = 0, CTL_ZERO_BYTES = 1 * MiB;
constexpr size_t WS_WIN = 2 * MiB, WS_WCAT = 11 * MiB  , WS_WO = 14 * MiB, WS_WUP = 16 * MiB, WS_WDN = 27 * MiB, WS_W1T = 33 * MiB;
constexpr size_t WS_W2T = 34 * MiB, WS_B1 = 34 * MiB + 65536, WS_ROPE = 35 * MiB, WS_R1 = 36 * MiB, WS_SSQ = 37 * MiB, WS_CMP = 41 * MiB, WS_NG = 44 * MiB, WS_RAW = 56 * MiB;
constexpr size_t WS_XB = 144 * MiB, WS_UPOOL = 272 * MiB, WS_Q = 336 * MiB, WS_KV = 464 * MiB, WS_MG = 560 * MiB, WS_PA = 816 * MiB, WS_END = 1008 * MiB;
constexpr size_t WS_PY = 272 * MiB, WS_MERGED = 400 * MiB, WS_X1B = 560 * MiB, WS_A = 144 * MiB;
constexpr int LDS_BYTES = 147456, NWAVES = 8;

#define GAS __attribute__((address_space(1)))
#define LAS __attribute__((address_space(3)))
typedef unsigned short bf16;
typedef unsigned v4u __attribute__((ext_vector_type(4)));
typedef unsigned v2u __attribute__((ext_vector_type(2)));
typedef float f32x4 __attribute__((ext_vector_type(4)));
typedef float f32x16 __attribute__((ext_vector_type(16)));
typedef short bf16x8 __attribute__((ext_vector_type(8)));
typedef short s16x4 __attribute__((ext_vector_type(4)));
#define LDS_WAIT() asm volatile("s_waitcnt lgkmcnt(0)" ::: "memory")
#define VM_WAIT() asm volatile("s_waitcnt vmcnt(0)" ::: "memory")
__device__ __forceinline__ unsigned pk2(float lo, float hi) { return pg8::cvt_pk_bf16(lo, hi); }
__device__ __forceinline__ float bflo(unsigned w) { return __uint_as_float(w << 16); }
__device__ __forceinline__ float bfhi(unsigned w) { return __uint_as_float(w & 0xffff0000u); }
__device__ __forceinline__ float sigmoidf_(float z) { return __builtin_amdgcn_rcpf(1.0f + __builtin_amdgcn_exp2f(-1.4426950408889634f * z)); }
__device__ __forceinline__ float wave_sum(float v) {
#pragma unroll
    for (int o = 1; o < 64; o <<= 1) v += __shfl_xor(v, o);
    return v;
}

struct Args {
    const float* in[19];
    float* out; unsigned char* ws;
    int ph_lo, ph_hi; int erep[6];
};
enum { I_X = 0, I_ANW, I_WIN, I_POOLW, I_POOLS, I_QNW, I_KNW, I_CPOS, I_CW1, I_CB1, I_CW2, I_WPB, I_WAB, I_WO, I_FNW, I_WUP, I_CONVW, I_CONVB, I_WDN };

struct MapId { __device__ __forceinline__ int operator()(int s) const { return s; } };
struct MapIn { __device__ __forceinline__ int operator()(int s) const {
    if (s < 512) return s;
    if (s < 1536) { const int t = s - 512, hq = t >> 6, d = t & 63; return 256 * (2 + (hq >> 2)) + 128 * (d >> 5) + 32 * (hq & 3) + (d & 31); }
    if (s < 2304) { const int t = s - 1536, u = t >> 6, d = t & 63; return 256 * (6 + (u >> 2)) + 128 * (d >> 5) + 32 * (u & 3) + (d & 31); }
    if (s < 2352) return 256 * 17 + (s - 2304);
    return 256 * 9 + (s - 2352); } };
struct MapUp { __device__ __forceinline__ int operator()(int s) const { const int ch = s < DFF ? s : s - DFF; const int base = 256 * (ch >> 7) + (ch & 127); return s < DFF ? base : base + 128; } };

template <class RowMap>
__device__ __forceinline__ void transpose_item(const float* W, int N, bf16* WT, int ldk, const float* kscale, LAS float* scr, int item, int lane, RowMap rm) {
    const int nblk = (N + 31) / 32, kb = item / nblk, nb = item % nblk, k0 = 64 * kb, n0 = 32 * nb;
    const int nsrc = n0 + (lane & 31); const bool nok = nsrc < N;
#pragma unroll 8
    for (int i = 0; i < 32; ++i) { const int kk = 2 * i + (lane >> 5); float v = nok ? W[(size_t)(k0 + kk) * N + nsrc] : 0.f; if (kscale) v *= kscale[k0 + kk]; scr[kk * 33 + (lane & 31)] = v; }
    LDS_WAIT(); asm volatile("" ::: "memory");
    const int c = lane & 7;
#pragma unroll
    for (int j = 0; j < 4; ++j) { const int n = (lane >> 3) + 8 * j; const LAS float* s = scr + (8 * c) * 33 + n;
        v4u o; o.x = pk2(s[0 * 33], s[1 * 33]); o.y = pk2(s[2 * 33], s[3 * 33]); o.z = pk2(s[4 * 33], s[5 * 33]); o.w = pk2(s[6 * 33], s[7 * 33]);
        if (n0 + n < N) *(GAS v4u*)(WT + (size_t)rm(n0 + n) * ldk + k0 + 8 * c) = o; }
    LDS_WAIT(); asm volatile("" ::: "memory");
}

__device__ __forceinline__ void p0_prologue(const Args& a, LAS unsigned char* lds, int vcu, int G) {
    const int tid = threadIdx.x, lane = tid & 63, wave = __builtin_amdgcn_readfirstlane(tid >> 6);
    unsigned char* ws = a.ws;
    LAS float* scr = (LAS float*)(lds + wave * 16384);
    const int gw = vcu * NWAVES + wave, NGW = G * NWAVES;
    const long gt = (long)gw * 64 + lane, NGT = (long)NGW * 64;
    bf16* WIN = (bf16*)(ws + WS_WIN); bf16* WUP = (bf16*)(ws + WS_WUP); bf16* WDN = (bf16*)(ws + WS_WDN);
    constexpr int I_IN = 16 * 138, I_AB = 16 * 32, I_O = 16 * 32, I_UP = 16 * 172, I_DN = 43 * 32, I_C1 = 32 * 4;
    constexpr int NITEMS = I_IN + I_AB + I_O + I_UP + I_DN + 2 * I_C1;
    for (int it = gw; it < NITEMS; it += NGW) {
        int r = it;
        if (r < I_IN) { transpose_item(a.in[I_WIN], IN_W, WIN, DM, a.in[I_ANW], scr, r, lane, MapIn()); continue; } r -= I_IN;
        if (r < I_AB) { transpose_item(a.in[I_WAB], DM, (bf16*)(ws + WS_WCAT) + 512, KCAT, nullptr, scr, r, lane, MapId()); continue; } r -= I_AB;
        if (r < I_O) { transpose_item(a.in[I_WO], DM, (bf16*)(ws + WS_WO), DM, nullptr, scr, r, lane, MapId()); continue; } r -= I_O;
        if (r < I_UP) { transpose_item(a.in[I_WUP], UPW, WUP, DM, a.in[I_FNW], scr, r, lane, MapUp()); continue; } r -= I_UP;
        if (r < I_DN) { transpose_item(a.in[I_WDN], DM, WDN, K_DN, nullptr, scr, r, lane, MapId()); continue; } r -= I_DN;
        if (r < I_C1) { transpose_item(a.in[I_CW1], 128, (bf16*)(ws + WS_W1T), 2048, nullptr, scr, r, lane, MapId()); continue; } r -= I_C1;
        transpose_item(a.in[I_CW1] + 2048 * 128, 128, (bf16*)(ws + WS_W1T) + 128 * 2048, 2048, nullptr, scr, r, lane, MapId());
    }
    for (long i = gt; i < 208L * DM / 8; i += NGT) *(GAS v4u*)(WIN + (size_t)(256 * 17 + 48) * DM + i * 8) = (v4u){0u, 0u, 0u, 0u};
    for (long i = gt; i < 128L * DM / 8; i += NGT) { const long e = i * 8; const int rr = (int)(e / DM), cc = (int)(e % DM); const int row = 256 * 21 + (rr < 64 ? 64 + rr : 192 + (rr - 64));
        *(GAS v4u*)(WUP + (size_t)row * DM + cc) = (v4u){0u, 0u, 0u, 0u}; }
    for (long i = gt; i < 1024L * 8; i += NGT) { const int row = (int)(i >> 3), c8 = (int)(i & 7); *(GAS v4u*)(WDN + (size_t)row * K_DN + DFF + c8 * 8) = (v4u){0u, 0u, 0u, 0u}; }
    for (long i = gt; i < 128L * 8; i += NGT) { const int t = (int)(i >> 3), c8 = (int)(i & 7); *(GAS v4u*)((bf16*)(ws + WS_CMP) + ((size_t)t * 128 + 127) * 64 + c8 * 8) = (v4u){0u, 0u, 0u, 0u}; }
    { const float* pw = a.in[I_POOLW]; const float* ps = a.in[I_POOLS]; const float* wb = a.in[I_WPB]; bf16* WPB = (bf16*)(ws + WS_WCAT);
      for (long i = gt; i < 512L * 256; i += NGT) { const int n4 = (int)(i & 255) * 4, k = __builtin_amdgcn_readfirstlane((int)(i >> 8)), g = k >> 7; f32x4 s = (f32x4){0.f, 0.f, 0.f, 0.f};
          const float* pwr = pw + (size_t)k * 128; const float* psr = ps + g * 128; const float* wbr = wb + (size_t)(g * 128) * 1024 + n4;
#pragma unroll 8
          for (int d = 0; d < 128; ++d) s += (pwr[d] * psr[d]) * *(const f32x4*)(wbr + (size_t)d * 1024);
#pragma unroll
          for (int e = 0; e < 4; ++e) WPB[(size_t)(n4 + e) * KCAT + k] = (bf16)(pk2(s[e], 0.f) & 0xffffu); } }
    for (int i = gw; i < 256; i += NGW) { const int kv = i >> 7, hc = i & 127; const float* w1 = a.in[I_CW1] + (size_t)kv * 2048 * 128; const float* pos = a.in[I_CPOS] + kv * 2048;
        float s = 0.f; for (int k = lane; k < 2048; k += 64) s += pos[k] * w1[(size_t)k * 128 + hc];
        s = wave_sum(s); if (lane == 0) ((float*)(ws + WS_B1))[i] = s + a.in[I_CB1][kv * 128 + hc]; }
    for (long i = gt; i < 2 * 64 * 128; i += NGT) { const int kv = (int)(i >> 13), d = (int)((i >> 7) & 63), h = (int)(i & 127);
        ((bf16*)(ws + WS_W2T))[i] = (bf16)(pk2(a.in[I_CW2][(size_t)kv * 128 * 64 + h * 64 + d], 0.f) & 0xffffu); }
    for (long i = gt; i < 2048L * 32; i += NGT) { const int p = (int)(i >> 5), j = (int)(i & 31); const float fr = (float)pow(10000.0, -(double)j / 32.0); const float ang = (float)p * fr;
        ((float*)(ws + WS_ROPE))[i] = (float)cos((double)ang); ((float*)(ws + WS_ROPE))[65536 + i] = (float)sin((double)ang); }
    { const float* x = a.in[I_X]; bf16* XB = (bf16*)(ws + WS_XB); float* R1 = (float*)(ws + WS_R1);
      for (int m4 = gw * 4; m4 < MTOK; m4 += NGW * 4) { f32x4 v[4][4]; float s[4];
#pragma unroll
          for (int r = 0; r < 4; ++r) { const GAS f32x4* xr = (const GAS f32x4*)(x + (size_t)(m4 + r) * DM) + lane;
#pragma unroll
              for (int j = 0; j < 4; ++j) v[r][j] = __builtin_nontemporal_load(xr + 64 * j); }
#pragma unroll
          for (int r = 0; r < 4; ++r) { s[r] = 0.f;
#pragma unroll
              for (int j = 0; j < 4; ++j) s[r] += (v[r][j].x * v[r][j].x + v[r][j].y * v[r][j].y) + (v[r][j].z * v[r][j].z + v[r][j].w * v[r][j].w); }
#pragma unroll
          for (int o = 1; o < 64; o <<= 1) {
#pragma unroll
              for (int r = 0; r < 4; ++r) s[r] += __shfl_xor(s[r], o); }
          if (lane < 4) R1[m4 + lane] = 1.0f / sqrtf((lane == 0 ? s[0] : lane == 1 ? s[1] : lane == 2 ? s[2] : s[3]) * (1.0f / DM) + EPS);
#pragma unroll
          for (int r = 0; r < 4; ++r) { GAS v2u* o8 = (GAS v2u*)(XB + (size_t)(m4 + r) * DM) + lane;
#pragma unroll
              for (int j = 0; j < 4; ++j) o8[64 * j] = (v2u){pk2(v[r][j].x, v[r][j].y), pk2(v[r][j].z, v[r][j].w)}; } } }
}

__device__ __forceinline__ void nt_store16(void* p, const v4u& v) { __builtin_nontemporal_store(v, (v4u*)p); }
__device__ __forceinline__ void nt_store4(void* p, unsigned v) { __builtin_nontemporal_store(v, (unsigned*)p); }
using pg8::Unit;
__device__ __forceinline__ v4u pack8(const f32x4& a, const f32x4& b) { v4u w; w.x = pk2(a[0], a[1]); w.y = pk2(a[2], a[3]); w.z = pk2(b[0], b[1]); w.w = pk2(b[2], b[3]); return w; }
__device__ __forceinline__ void unpack8(const v4u& w, f32x4& a, f32x4& b) { a = (f32x4){bflo(w.x), bfhi(w.x), bflo(w.y), bfhi(w.y)}; b = (f32x4){bflo(w.z), bfhi(w.z), bflo(w.w), bfhi(w.w)}; }

typedef f32x4 AccT[2][2][4][2];
struct EpiIn {
    static constexpr bool PERM = true, AFTER_DRAIN = false, APERM = false, MIDHOOK = false;
    const float* r1; bf16* UPOOL; bf16* Q; bf16* KV; unsigned char* MG8; float* NG; const float* qnw; const float* knw; const float* rope;
    __device__ __forceinline__ void operator()(const f32x4 (&acc_)[2][2][4][2], const Unit& u, int wr, int wc, int fr_, int fq_) const {
        AccT& acc = const_cast<AccT&>(acc_);
        int fr = fr_, fq = fq_; asm volatile("" : "+v"(fr), "+v"(fq));
        const int row0 = u.pm * 256 + wr * 64 + fr, pn = u.pn;
        float rs[2][4];
#pragma unroll
        for (int ai = 0; ai < 2; ++ai)
#pragma unroll
            for (int m = 0; m < 4; ++m) rs[ai][m] = r1[row0 + ai * 128 + m * 16];
        if (pn < 2) {
            const int col0 = 256 * pn + 32 * wc + 8 * fq;
#pragma unroll
            for (int ai = 0; ai < 2; ++ai)
#pragma unroll
                for (int m = 0; m < 4; ++m) { const int row = row0 + ai * 128 + m * 16;
#pragma unroll
                    for (int bj = 0; bj < 2; ++bj) *(v4u*)(UPOOL + (size_t)row * 512 + col0 + 128 * bj) = pack8(acc[ai][bj][m][0] * rs[ai][m], acc[ai][bj][m][1] * rs[ai][m]); }
        } else if (pn >= 9 && pn < 17) {
            const int col0 = 256 * (pn - 9) + 32 * wc + 8 * fq;
#pragma unroll
            for (int ai = 0; ai < 2; ++ai)
#pragma unroll
                for (int m = 0; m < 4; ++m) { const int row = row0 + ai * 128 + m * 16;
#pragma unroll
                    for (int bj = 0; bj < 2; ++bj) { unsigned w[2]; const float ns = -1.4426950408889634f * rs[ai][m];
#pragma unroll
                        for (int n = 0; n < 2; ++n) { const f32x4 v = acc[ai][bj][m][n] * ns; unsigned pkd = 0u;
#pragma unroll
                            for (int i = 0; i < 4; ++i) pkd = __builtin_amdgcn_cvt_pk_u8_f32(255.0f * __builtin_amdgcn_rcpf(1.0f + __builtin_amdgcn_exp2f(v[i])), i, pkd);
                            w[n] = pkd; }
                        *(v2u*)(MG8 + (size_t)row * 2048 + col0 + 128 * bj) = (v2u){w[0], w[1]}; } }
        } else if (pn < 9) {
            const bool isq = pn < 6; const int br = pn - 6, kvsel = wc >> 1, g = wc & 1; const bool donorm = isq || kvsel == 0;
            const float* nw = isq ? qnw : knw + br * 64;
            f32x4 w[2][2];
#pragma unroll
            for (int bj = 0; bj < 2; ++bj)
#pragma unroll
                for (int n = 0; n < 2; ++n) w[bj][n] = *(const f32x4*)(nw + 32 * bj + 8 * fq + 4 * n);
            const float osc = isq ? QSCALE : 1.0f;
            bf16* base = isq ? Q + (4 * (pn - 2) + wc) * 64 : KV + (size_t)(br * 2 + kvsel) * MTOK * 128 + g * 64; const int ld = isq ? 1024 : 128;
            if (!donorm) {
#pragma unroll
                for (int ai = 0; ai < 2; ++ai)
#pragma unroll
                    for (int m = 0; m < 4; ++m) { const int row = row0 + ai * 128 + m * 16;
#pragma unroll
                        for (int bj = 0; bj < 2; ++bj) *(v4u*)(base + (size_t)row * ld + 32 * bj + 8 * fq) = pack8(acc[ai][bj][m][0] * rs[ai][m], acc[ai][bj][m][1] * rs[ai][m]); }
            } else {
                f32x4 cs[2], sn[2]; v4u res[2];
#define ROPE_LOAD(ai_, m_) do { const int pos = (row0 + (ai_) * 128 + (m_) * 16) & (SEQ - 1); \
                _Pragma("unroll") for (int n = 0; n < 2; ++n) { cs[n] = *(const f32x4*)(rope + pos * 32 + 8 * fq + 4 * n); sn[n] = *(const f32x4*)(rope + 65536 + pos * 32 + 8 * fq + 4 * n); } } while (0)
#define HEAD_MATH(ai_, m_) do { float ss = 0.f; f32x4 z[2][2]; \
                _Pragma("unroll") for (int bj = 0; bj < 2; ++bj) _Pragma("unroll") for (int n = 0; n < 2; ++n) { z[bj][n] = acc[ai_][bj][m_][n] * rs[ai_][m_]; const f32x4 t = z[bj][n]; ss += (t[0] * t[0] + t[1] * t[1]) + (t[2] * t[2] + t[3] * t[3]); } \
                ss += __shfl_xor(ss, 16); ss += __shfl_xor(ss, 32); const float rn = __builtin_amdgcn_rsqf(ss * (1.0f / 64.0f) + EPS); \
                _Pragma("unroll") for (int n = 0; n < 2; ++n) { const f32x4 y0 = z[0][n] * rn * w[0][n], y1 = z[1][n] * rn * w[1][n]; \
                    z[0][n] = (y0 * cs[n] - y1 * sn[n]) * osc; z[1][n] = (y1 * cs[n] + y0 * sn[n]) * osc; } \
                res[0] = pack8(z[0][0], z[0][1]); res[1] = pack8(z[1][0], z[1][1]); } while (0)
#define HEAD_STORE(ai_, m_) do { const int row = row0 + (ai_) * 128 + (m_) * 16; \
                _Pragma("unroll") for (int bj = 0; bj < 2; ++bj) *(v4u*)(base + (size_t)row * ld + 32 * bj + 8 * fq) = res[bj]; } while (0)
#define CFENCE() asm volatile("" ::: "memory")
                ROPE_LOAD(0, 0);
#pragma unroll
                for (int g8 = 0; g8 < 8; ++g8) { const int ai = g8 >> 2, m = g8 & 3;
                    HEAD_MATH(ai, m); CFENCE();
                    if (g8 < 7) ROPE_LOAD((g8 + 1) >> 2, (g8 + 1) & 3);
                    CFENCE(); HEAD_STORE(ai, m); }
#undef ROPE_LOAD
#undef HEAD_MATH
#undef HEAD_STORE
#undef CFENCE
            }
        } else {
            if (wc < 2) {
#pragma unroll
                for (int ai = 0; ai < 2; ++ai)
#pragma unroll
                    for (int m = 0; m < 4; ++m)
#pragma unroll
                        for (int n = 0; n < 2; ++n) { f32x4 v = acc[ai][0][m][n] * rs[ai][m];
#pragma unroll
                            for (int i = 0; i < 4; ++i) v[i] = sigmoidf_(v[i]);
                            acc[ai][0][m][n] = v; }
#pragma unroll
                for (int ai = 0; ai < 2; ++ai)
#pragma unroll
                    for (int m = 0; m < 4; ++m) { const int row = row0 + ai * 128 + m * 16;
#pragma unroll
                        for (int n = 0; n < 2; ++n) { const int col = 32 * wc + 8 * fq + 4 * n; if (col < 48) *(f32x4*)(NG + (size_t)row * 48 + col) = acc[ai][0][m][n]; } }
            }
        }
    }
};

struct EpiMerge {
    static constexpr bool PERM = true, AFTER_DRAIN = false, APERM = false, MIDHOOK = true; static constexpr int HOOK_T = 6;
    const unsigned char* MG8; bf16* OUT;
    __device__ __forceinline__ void gates(v2u (&gw)[2][4][2], int row0, int col0, size_t goff) const {
#pragma unroll
        for (int ai = 0; ai < 2; ++ai)
#pragma unroll
            for (int m = 0; m < 4; ++m)
#pragma unroll
                for (int bj = 0; bj < 2; ++bj) gw[ai][m][bj] = *(const v2u*)(MG8 + (size_t)(row0 + ai * 128 + m * 16) * 2048 + goff + col0 + 128 * bj);
    }
    __device__ __forceinline__ void mid(f32x4 (&acc)[2][2][4][2], const Unit& u, int wr, int wc, int fr_, int fq_) const {
        int fr = fr_, fq = fq_; asm volatile("" : "+v"(fr), "+v"(fq));
        const int row0 = u.pm * 256 + wr * 64 + fr, col0 = 256 * u.pn + 32 * wc + 8 * fq;
        v2u g0w[2][4][2], g1w[2][4][2]; gates(g0w, row0, col0, 0); gates(g1w, row0, col0, 1024);
        asm volatile("" ::: "memory");
#pragma unroll
        for (int ai = 0; ai < 2; ++ai)
#pragma unroll
            for (int m = 0; m < 4; ++m)
#pragma unroll
                for (int bj = 0; bj < 2; ++bj)
#pragma unroll
                    for (int n = 0; n < 2; ++n) { const unsigned a0 = n ? g0w[ai][m][bj].y : g0w[ai][m][bj].x, a1 = n ? g1w[ai][m][bj].y : g1w[ai][m][bj].x; f32x4 r;
#pragma unroll
                        for (int i = 0; i < 4; ++i) { const float q0 = (float)((a0 >> (8 * i)) & 255u), q1 = fmaxf((float)((a1 >> (8 * i)) & 255u), 1.0f); r[i] = q0 * __builtin_amdgcn_rcpf(q1); }
                        acc[ai][bj][m][n] *= r; }
    }
    __device__ __forceinline__ void operator()(const f32x4 (&acc_)[2][2][4][2], const Unit& u, int wr, int wc, int fr_, int fq_) const {
        AccT& acc = const_cast<AccT&>(acc_);
        int fr = fr_, fq = fq_; asm volatile("" : "+v"(fr), "+v"(fq));
        const int row0 = u.pm * 256 + wr * 64 + fr, col0 = 256 * u.pn + 32 * wc + 8 * fq;
        v2u g1w[2][4][2]; gates(g1w, row0, col0, 1024);
        asm volatile("" ::: "memory");
#pragma unroll
        for (int ai = 0; ai < 2; ++ai)
#pragma unroll
            for (int m = 0; m < 4; ++m)
#pragma unroll
                for (int bj = 0; bj < 2; ++bj)
#pragma unroll
                    for (int n = 0; n < 2; ++n) { const unsigned a1 = n ? g1w[ai][m][bj].y : g1w[ai][m][bj].x; f32x4 g;
#pragma unroll
                        for (int i = 0; i < 4; ++i) g[i] = fmaxf((float)((a1 >> (8 * i)) & 255u), 1.0f) * (1.0f / 255.0f);
                        acc[ai][bj][m][n] *= g; }
        asm volatile("" ::: "memory");
#pragma unroll
        for (int ai = 0; ai < 2; ++ai)
#pragma unroll
            for (int m = 0; m < 4; ++m) { const int row = row0 + ai * 128 + m * 16;
#pragma unroll
                for (int bj = 0; bj < 2; ++bj) *(v4u*)(OUT + (size_t)row * 1024 + col0 + 128 * bj) = pack8(acc[ai][bj][m][0], acc[ai][bj][m][1]); }
    }
};

struct EpiWo {
    static constexpr bool PERM = true, AFTER_DRAIN = false, APERM = false, MIDHOOK = false;
    const bf16* XB; bf16* X1B; float* ssq;
    __device__ __forceinline__ void operator()(const f32x4 (&acc_)[2][2][4][2], const Unit& u, int wr, int wc, int fr_, int fq_) const {
        AccT& acc = const_cast<AccT&>(acc_);
        int fr = fr_, fq = fq_; asm volatile("" : "+v"(fr), "+v"(fq));
        const int row0 = u.pm * 256 + wr * 64 + fr, col0 = 256 * u.pn + 32 * wc + 8 * fq;
        float ssr[2][4];
        v4u xr[2][4][2];
#pragma unroll
        for (int ai = 0; ai < 2; ++ai)
#pragma unroll
            for (int m = 0; m < 4; ++m)
#pragma unroll
                for (int bj = 0; bj < 2; ++bj) xr[ai][m][bj] = *(const v4u*)(XB + (size_t)(row0 + ai * 128 + m * 16) * 1024 + col0 + 128 * bj);
        asm volatile("" ::: "memory");
#pragma unroll
        for (int ai = 0; ai < 2; ++ai)
#pragma unroll
            for (int m = 0; m < 4; ++m) { float ss = 0.f;
#pragma unroll
                for (int bj = 0; bj < 2; ++bj) { f32x4 x0, x1; unpack8(xr[ai][m][bj], x0, x1);
                    const v4u pk = pack8(x0 + acc[ai][bj][m][0], x1 + acc[ai][bj][m][1]);
                    f32x4 r0, r1_; unpack8(pk, r0, r1_);
                    acc[ai][bj][m][0] = r0; acc[ai][bj][m][1] = r1_;
                    ss += (r0[0] * r0[0] + r0[1] * r0[1]) + (r0[2] * r0[2] + r0[3] * r0[3]) + (r1_[0] * r1_[0] + r1_[1] * r1_[1]) + (r1_[2] * r1_[2] + r1_[3] * r1_[3]); }
                ssr[ai][m] = ss; }
#pragma unroll
        for (int ai = 0; ai < 2; ++ai)
#pragma unroll
            for (int m = 0; m < 4; ++m) { ssr[ai][m] += __shfl_xor(ssr[ai][m], 16); }
#pragma unroll
        for (int ai = 0; ai < 2; ++ai)
#pragma unroll
            for (int m = 0; m < 4; ++m) { ssr[ai][m] += __shfl_xor(ssr[ai][m], 32); }
        asm volatile("" ::: "memory");
#pragma unroll
        for (int ai = 0; ai < 2; ++ai)
#pragma unroll
            for (int m = 0; m < 4; ++m) { const int row = row0 + ai * 128 + m * 16;
#pragma unroll
                for (int bj = 0; bj < 2; ++bj) *(v4u*)(X1B + (size_t)row * 1024 + col0 + 128 * bj) = pack8(acc[ai][bj][m][0], acc[ai][bj][m][1]);
                if (fq == 0) ssq[(size_t)row * 16 + u.pn * 4 + wc] = ssr[ai][m]; }
    }
};

struct EpiUp {
    static constexpr bool PERM = true, AFTER_DRAIN = false, APERM = true, MIDHOOK = false;
    const float* r2; const float* cw; const float* cb; bf16* A; float* RAW;
    __device__ __forceinline__ void operator()(const f32x4 (&acc_)[2][2][4][2], const Unit& u, int wr, int wc, int fr_, int fq_) const {
        AccT& acc = const_cast<AccT&>(acc_);
        int fr = fr_, fq = fq_; asm volatile("" : "+v"(fr), "+v"(fq));
        const int slab0 = u.pm * 256 + wr * 64;
        const int chb = 128 * u.pn + 32 * wc + 8 * fq; const bool chok = chb < DFF; const int cg0 = chok ? chb : 0;
        f32x4 rs[2];
#pragma unroll
        for (int ai = 0; ai < 2; ++ai) rs[ai] = *(const f32x4*)(r2 + slab0 + ai * 128 + 4 * fr);
        typedef float f2 __attribute__((ext_vector_type(2)));
        f2 wgt[2][3], bia[2];
#define LOADW(cc_) do { _Pragma("unroll") for (int bj = 0; bj < 2; ++bj) { bia[bj] = *(const f2*)(cb + bj * DFF + (cc_)); \
            _Pragma("unroll") for (int t = 0; t < 3; ++t) wgt[bj][t] = *(const f2*)(cw + t * UPW + bj * DFF + (cc_)); } } while (0)
        LOADW(cg0);
#pragma unroll
        for (int ai = 0; ai < 2; ++ai) {
            const int slabi = (slab0 + ai * 128) >> 6;
            if (fr == 15 || fr == 0) { const int kb = fr == 15 ? 0 : 2;
#pragma unroll
                for (int k = 0; k < 2; ++k)
#pragma unroll
                    for (int bj = 0; bj < 2; ++bj)
#pragma unroll
                        for (int n = 0; n < 2; ++n) { const f32x4 v = fr == 15 ? acc[ai][bj][2 + k][n] * rs[ai][2 + k] : acc[ai][bj][k][n] * rs[ai][k];
                            *(f32x4*)(RAW + ((size_t)slabi * 4 + kb + k) * N_UP + 256 * u.pn + 128 * bj + 32 * wc + 8 * fq + 4 * n) = v; } }
        }
#pragma unroll
        for (int n = 0; n < 2; ++n)
#pragma unroll
            for (int hp = 0; hp < 2; ++hp) {
                f2 wg_[2][3], bi_[2];
#pragma unroll
                for (int bj = 0; bj < 2; ++bj) { bi_[bj] = bia[bj];
#pragma unroll
                    for (int t = 0; t < 3; ++t) wg_[bj][t] = wgt[bj][t]; }
                if (n * 2 + hp < 3) { const int nn = (n * 2 + hp + 1) >> 1, hh = (n * 2 + hp + 1) & 1; LOADW(cg0 + (chok ? 4 * nn + 2 * hh : 0)); }
#pragma unroll
                for (int ai = 0; ai < 2; ++ai) {
                    f2 c_[2][4];
#pragma unroll
                    for (int bj = 0; bj < 2; ++bj) { f2 uu[4];
#pragma unroll
                        for (int m = 0; m < 4; ++m) uu[m] = (f2){acc[ai][bj][m][n][2 * hp], acc[ai][bj][m][n][2 * hp + 1]} * rs[ai][m];
                        f2 s3, s2;
#pragma unroll
                        for (int e = 0; e < 2; ++e) { float x3 = uu[3][e], x2 = uu[2][e]; asm volatile("" : "+v"(x3), "+v"(x2));
                            s3[e] = __builtin_bit_cast(float, __builtin_amdgcn_update_dpp(0, __builtin_bit_cast(int, x3), 0x111, 0xf, 0xf, true));
                            s2[e] = __builtin_bit_cast(float, __builtin_amdgcn_update_dpp(0, __builtin_bit_cast(int, x2), 0x111, 0xf, 0xf, true)); }
                        c_[bj][0] = bi_[bj] + wg_[bj][0] * s2 + wg_[bj][1] * s3 + wg_[bj][2] * uu[0];
                        c_[bj][1] = bi_[bj] + wg_[bj][0] * s3 + wg_[bj][1] * uu[0] + wg_[bj][2] * uu[1];
                        c_[bj][2] = bi_[bj] + wg_[bj][0] * uu[0] + wg_[bj][1] * uu[1] + wg_[bj][2] * uu[2];
                        c_[bj][3] = bi_[bj] + wg_[bj][0] * uu[1] + wg_[bj][1] * uu[2] + wg_[bj][2] * uu[3]; }
#pragma unroll
                    for (int m = 0; m < 4; ++m) { const float o0 = c_[0][m][0] * sigmoidf_(c_[0][m][0]) * c_[1][m][0], o1 = c_[0][m][1] * sigmoidf_(c_[0][m][1]) * c_[1][m][1];
                        acc[ai][0][m][n][2 * hp] = __uint_as_float(chok ? pk2(o0, o1) : 0u); }
                }
            }
#undef LOADW
#pragma unroll
        for (int ai = 0; ai < 2; ++ai)
#pragma unroll
            for (int m = 0; m < 4; ++m) { const int row = slab0 + ai * 128 + 4 * fr + m;
                if (!chok || !(fr == 0 && m < 2)) *(v4u*)(A + (size_t)row * K_DN + chb) = (v4u){__float_as_uint(acc[ai][0][m][0][0]), __float_as_uint(acc[ai][0][m][0][2]), __float_as_uint(acc[ai][0][m][1][0]), __float_as_uint(acc[ai][0][m][1][2])}; }
    }
};

struct EpiDown {
    static constexpr bool PERM = true, AFTER_DRAIN = false, APERM = false, MIDHOOK = false;
    const bf16* X1B; float* out;
    __device__ __forceinline__ void operator()(const f32x4 (&acc_)[2][2][4][2], const Unit& u, int wr, int wc, int fr_, int fq_) const {
        AccT& acc = const_cast<AccT&>(acc_);
        int fr = fr_, fq = fq_; asm volatile("" : "+v"(fr), "+v"(fq));
        const int row0 = u.pm * 256 + wr * 64 + fr, col0 = 256 * u.pn + 32 * wc + 8 * fq;
#pragma unroll
        for (int ai = 0; ai < 2; ++ai) {
            v4u xr[4][2];
#pragma unroll
            for (int m = 0; m < 4; ++m)
#pragma unroll
                for (int bj = 0; bj < 2; ++bj) xr[m][bj] = *(const v4u*)(X1B + (size_t)(row0 + ai * 128 + m * 16) * 1024 + col0 + 128 * bj);
            asm volatile("" ::: "memory");
#pragma unroll
            for (int m = 0; m < 4; ++m)
#pragma unroll
                for (int bj = 0; bj < 2; ++bj) { f32x4 x0, x1; unpack8(xr[m][bj], x0, x1); acc[ai][bj][m][0] += x0; acc[ai][bj][m][1] += x1; }
            asm volatile("" ::: "memory");
        }
#pragma unroll
        for (int ai = 0; ai < 2; ++ai)
#pragma unroll
            for (int m = 0; m < 4; ++m) { const int row = row0 + ai * 128 + m * 16;
#pragma unroll
                for (int bj = 0; bj < 2; ++bj) { const size_t off = (size_t)row * 1024 + col0 + 128 * bj; *(f32x4*)(out + off) = acc[ai][bj][m][0]; *(f32x4*)(out + off + 4) = acc[ai][bj][m][1]; } }
    }
};

__device__ __forceinline__ float gelu_tanh(float x) { const float y = 0.7978845608028654f * (x + 0.044715f * x * x * x); const float e = __expf(2.0f * y); return 0.5f * x * (2.0f - 2.0f / (e + 1.0f)); }

__device__ __forceinline__ void p2_pool_compress(const Args& a, LAS unsigned char* lds, int vcu, int G) {
    const int tid = threadIdx.x, lane = tid & 63, wave = __builtin_amdgcn_readfirstlane(tid >> 6);
    unsigned char* ws = a.ws;
    if (vcu < 128) {
        const bf16* W1T = (const bf16*)(ws + WS_W1T); const bf16* W2T = (const bf16*)(ws + WS_W2T); const float* B1 = (const float*)(ws + WS_B1);
        const int fr = lane & 15, fq = lane >> 4;
        const int unit = vcu, kv = unit >> 6, b = (unit >> 1) & 31, g = unit & 1, n0 = 16 * wave;
        const int n = n0 + fr, nn = n < 126 ? n : 126;
        LAS unsigned char* wl = lds + 32768 + wave * 4608;
        const bf16* arow = (const bf16*)(ws + WS_KV) + ((size_t)kv * MTOK + (size_t)b * SEQ + 16 * nn) * 128 + g * 64 + 8 * fq;
        const bf16* wsrc = W1T + (size_t)kv * 128 * 2048 + (size_t)(tid >> 2) * 2048 + 8 * (tid & 3);
        LAS unsigned char* wdst = lds + (tid >> 2) * 80 + (tid & 3) * 16;
        f32x4 acc[8];
#pragma unroll
        for (int hb = 0; hb < 8; ++hb) acc[hb] = (f32x4){0.f, 0.f, 0.f, 0.f};
        v4u wreg[4]; bf16x8 breg[4];
#pragma unroll
        for (int p = 0; p < 4; ++p) { wreg[p] = *(const v4u*)(wsrc + 32 * p); breg[p] = *(const bf16x8*)(arow + (p >> 1) * 128 + (p & 1) * 32); }
        *(LAS v4u*)(wdst) = wreg[0];
        LDS_WAIT(); __builtin_amdgcn_s_barrier(); asm volatile("" ::: "memory");
#pragma unroll 4
        for (int ks = 0; ks < 64; ++ks) {
            const int cb = (ks & 1) * 10240, nb = 10240 - cb;
            const bf16x8 bfrag = breg[ks & 3];
            const v4u wnext = wreg[(ks + 1) & 3];
            if (ks + 4 < 64) { wreg[ks & 3] = *(const v4u*)(wsrc + 32 * (ks + 4)); breg[ks & 3] = *(const bf16x8*)(arow + ((ks + 4) >> 1) * 128 + ((ks + 4) & 1) * 32); }
#pragma unroll
            for (int hb = 0; hb < 8; ++hb) { const bf16x8 afrag = *(const LAS bf16x8*)(lds + cb + (16 * hb + fr) * 80 + fq * 16);
                acc[hb] = __builtin_amdgcn_mfma_f32_16x16x32_bf16(afrag, bfrag, acc[hb], 0, 0, 0); }
            if (ks + 1 < 64) *(LAS v4u*)(wdst + nb) = wnext;
            LDS_WAIT(); __builtin_amdgcn_s_barrier(); asm volatile("" ::: "memory");
        }
#pragma unroll
        for (int hb = 0; hb < 8; ++hb) { const f32x4 bv = *(const f32x4*)(B1 + kv * 128 + 16 * hb + 4 * fq); f32x4 h = acc[hb] + bv;
#pragma unroll
            for (int i = 0; i < 4; ++i) h[i] = gelu_tanh(h[i]);
            *(LAS v2u*)(wl + fr * 272 + (16 * hb + 4 * fq) * 2) = (v2u){pk2(h[0], h[1]), pk2(h[2], h[3])}; }
        LDS_WAIT(); asm volatile("" ::: "memory");
        f32x4 o[4];
#pragma unroll
        for (int db = 0; db < 4; ++db) o[db] = (f32x4){0.f, 0.f, 0.f, 0.f};
#pragma unroll
        for (int ks = 0; ks < 4; ++ks) { const bf16x8 bfrag = *(const LAS bf16x8*)(wl + fr * 272 + 64 * ks + 16 * fq);
#pragma unroll
            for (int db = 0; db < 4; ++db) { const bf16x8 afrag = *(const bf16x8*)(W2T + (size_t)kv * 64 * 128 + (16 * db + fr) * 128 + 32 * ks + 8 * fq);
                o[db] = __builtin_amdgcn_mfma_f32_16x16x32_bf16(afrag, bfrag, o[db], 0, 0, 0); } }
        LDS_WAIT(); asm volatile("" ::: "memory");
        if (n < 127) { bf16* dst = (bf16*)(ws + WS_CMP) + (((size_t)kv * BATCH + b) * 2 + g) * 128 * 64 + (size_t)n * 64;
#pragma unroll
            for (int db = 0; db < 4; ++db) *(v2u*)(dst + 16 * db + 4 * fq) = (v2u){pk2(o[db][0], o[db][1]), pk2(o[db][2], o[db][3])}; }
    }
    {
        const bf16* U = (const bf16*)(ws + WS_UPOOL); bf16* P = (bf16*)(ws + WS_PA);
        const long ITEMS = (long)MTOK * 16, SPLIT = ITEMS / 4;
        const bool cw = vcu < 128; const int v2 = cw ? vcu : vcu - 128;
        const long gt = (cw ? 0 : SPLIT) + ((long)v2 * NWAVES + wave) * 64 + lane, NGT = 128L * NWAVES * 64, gend = cw ? SPLIT : ITEMS;
#define POOL_GROUP(GI, W) \
        for (long it = gt; it < gend; it += NGT) { const int row = (int)(it >> 4), c8 = (GI) * 16 + (int)(it & 15), t = row & (SEQ - 1); const int cnt = (t + 1 < (W)) ? t + 1 : (W); \
            v4u raw[W]; \
            _Pragma("unroll") for (int p = 0; p < (W); ++p) raw[p] = *(const v4u*)(U + (size_t)(row - (p < cnt ? p : 0)) * 512 + c8 * 8); \
            f32x4 s0 = (f32x4){0.f, 0.f, 0.f, 0.f}, s1 = s0, u0, u1; unpack8(raw[0], u0, u1); \
            _Pragma("unroll") for (int p = 0; p < (W); ++p) { f32x4 x0, x1; unpack8(raw[p], x0, x1); const float m = p < cnt ? 1.f : 0.f; s0 += x0 * m; s1 += x1 * m; } \
            const float inv = 1.0f / (float)cnt; \
            *(v4u*)(P + (size_t)row * KCAT + c8 * 8) = pack8(s0 * inv - u0, s1 * inv - u1); }
        POOL_GROUP(0, 2) POOL_GROUP(1, 4) POOL_GROUP(2, 8) POOL_GROUP(3, 16)
#undef POOL_GROUP
    }
}

__device__ __forceinline__ void p5b_r2(const Args& a, int vcu, int G) {
    const long gt = ((long)vcu * NWAVES * 64) + threadIdx.x, NGT = (long)G * NWAVES * 64;
    const float* ssq = (const float*)(a.ws + WS_SSQ); float* R2 = (float*)(a.ws + WS_R1);
    for (long row = gt; row < MTOK; row += NGT) { const f32x4* p = (const f32x4*)(ssq + (size_t)row * 16); const f32x4 s = (p[0] + p[1]) + (p[2] + p[3]);
        R2[row] = 1.0f / sqrtf(((s[0] + s[1]) + (s[2] + s[3])) * (1.0f / DM) + EPS); }
}
__device__ __forceinline__ void p7_fixup(const Args& a, int vcu, int G) {
    const long gt = ((long)vcu * NWAVES * 64) + threadIdx.x, NGT = (long)G * NWAVES * 64;
    const float* RAW = (const float*)(a.ws + WS_RAW); bf16* A = (bf16*)(a.ws + WS_A); const float* cw = a.in[I_CONVW]; const float* cb = a.in[I_CONVB];
    for (long it = gt; it < 2048L * (DFF / 4); it += NGT) { const int c4 = (int)(it % (DFF / 4)), rk = (int)(it / (DFF / 4)), s = rk >> 1, k = rk & 1, ch = 4 * c4;
        const bool first = (s & 31) == 0; f32x4 c_[2];
#pragma unroll
        for (int bj = 0; bj < 2; ++bj) { const int col = 256 * (ch >> 7) + (ch & 127) + 128 * bj; const f32x4 z = (f32x4){0.f, 0.f, 0.f, 0.f};
            const f32x4 cur = *(const f32x4*)(RAW + ((size_t)s * 4 + 2 + k) * N_UP + col);
            const f32x4 t1 = first ? z : *(const f32x4*)(RAW + ((size_t)(s - 1) * 4 + 1) * N_UP + col), t0 = first ? z : *(const f32x4*)(RAW + ((size_t)(s - 1) * 4 + 0) * N_UP + col);
            const f32x4 r0 = *(const f32x4*)(RAW + ((size_t)s * 4 + 2) * N_UP + col);
            const f32x4 p1 = k == 1 ? r0 : t1, p2 = k == 1 ? t1 : t0;
            c_[bj] = *(const f32x4*)(cb + bj * DFF + ch) + *(const f32x4*)(cw + 0 * UPW + bj * DFF + ch) * p2 + *(const f32x4*)(cw + 1 * UPW + bj * DFF + ch) * p1 + *(const f32x4*)(cw + 2 * UPW + bj * DFF + ch) * cur; }
        f32x4 o;
#pragma unroll
        for (int i = 0; i < 4; ++i) o[i] = c_[0][i] * sigmoidf_(c_[0][i]) * c_[1][i];
        *(v2u*)(A + (size_t)(64 * s + k) * K_DN + ch) = (v2u){pk2(o[0], o[1]), pk2(o[2], o[3])}; }
}
#define XB_TMO      128
#define XB_XCNT(j)  (256  + 64 * (j))
#define XB_XSUB(j)  (1280 + 64 * (j))
#define XB_XGEN(j)  (2304 + 64 * (j))
#define XB_TOP      3328
#define XB_TOPGEN   3392
#define XCD_BAR_WORDS 3456
#define XB_SPIN_CAP (1u << 18)

__device__ __forceinline__ unsigned xb_ld(unsigned* p)              { return __hip_atomic_load(p, __ATOMIC_RELAXED, __HIP_MEMORY_SCOPE_AGENT); }
__device__ __forceinline__ unsigned xb_add(unsigned* p, unsigned v) { return __hip_atomic_fetch_add(p, v, __ATOMIC_RELAXED, __HIP_MEMORY_SCOPE_AGENT); }
__device__ __forceinline__ unsigned xb_xcc_id() { return (unsigned)__builtin_amdgcn_s_getreg((3 << 11) | 20) & 0xFu; }
#define XB_SPIN(cond, bar) do { unsigned _sp = 0; while (cond) { __builtin_amdgcn_s_sleep(1); \
    if ((++_sp & 255u) == 0u) { if (xb_ld(&(bar)[XB_TMO])) break; if (_sp > XB_SPIN_CAP) { atomicAdd(&(bar)[XB_TMO], 1u); break; } } } } while (0)

struct XcdBarrier {
    unsigned* bar; unsigned x;
    volatile LAS unsigned* st;
};

__device__ __forceinline__ XcdBarrier xcd_barrier_post(unsigned* bar, volatile LAS unsigned* st) {
    XcdBarrier b; b.bar = bar; b.x = xb_xcc_id(); b.st = st;
    if (threadIdx.x == 0) (void)xb_add(&bar[XB_XCNT(b.x)], 1u);
    return b;
}
__device__ __forceinline__ void xcd_barrier_complete(unsigned* bar, unsigned x, unsigned& nloc, unsigned& nx) {
    const unsigned G = gridDim.x * gridDim.y * gridDim.z;
    unsigned sum, cnt, mine, sp = 0u;
    for (;;) {
        sum = 0u; cnt = 0u; mine = 0u;
#pragma unroll
        for (unsigned j = 0; j < 16; ++j) { const unsigned c = xb_ld(&bar[XB_XCNT(j)]); sum += c; cnt += (c > 0u) ? 1u : 0u; mine = (j == x) ? c : mine; }
        if (sum == G) break;
        __builtin_amdgcn_s_sleep(1);
        if ((++sp & 255u) == 0u) { if (xb_ld(&bar[XB_TMO])) break; if (sp > XB_SPIN_CAP) { atomicAdd(&bar[XB_TMO], 1u); break; } }
    }
    nloc = mine > 0u ? mine : 1u; nx = cnt > 0u ? cnt : 1u;
}

__device__ __forceinline__ void xcd_barrier(const XcdBarrier& b) {
    asm volatile("s_waitcnt vmcnt(0)" ::: "memory");
    __syncthreads();
    if (threadIdx.x == 0) {
        unsigned* bar = b.bar;
        __builtin_amdgcn_s_waitcnt(0);
        unsigned nloc = b.st[0], nx = b.st[1];
        if (nloc == 0u) { xcd_barrier_complete(bar, b.x, nloc, nx); b.st[0] = nloc; b.st[1] = nx; }
        const unsigned old = xb_add(&bar[XB_XSUB(b.x)], 1u);
        const unsigned gen = old / nloc;
        if (old + 1u == (gen + 1u) * nloc) {
            __builtin_amdgcn_fence(__ATOMIC_RELEASE, "agent");
            asm volatile("s_waitcnt vmcnt(0)" ::: "memory");
            const unsigned og = xb_add(&bar[XB_TOP], 1u);
            const unsigned tg = og / nx;
            if (og + 1u == (tg + 1u) * nx) xb_add(&bar[XB_TOPGEN], 1u);
            else XB_SPIN(xb_ld(&bar[XB_TOPGEN]) == tg, bar);
            __builtin_amdgcn_fence(__ATOMIC_ACQUIRE, "agent");
            xb_add(&bar[XB_XGEN(b.x)], 1u);
            asm volatile("s_waitcnt vmcnt(0)" ::: "memory");
        } else {
            XB_SPIN(xb_ld(&bar[XB_XGEN(b.x)]) == gen, bar);
            __builtin_amdgcn_fence(__ATOMIC_ACQUIRE, "agent");
            asm volatile("s_waitcnt vmcnt(0)" ::: "memory");
        }
    }
    __syncthreads();
}
#ifndef ATT_REP
#define ATT_REP 1
#endif
#ifndef ATT_MFMA2
#define ATT_MFMA2 0
#endif
#ifndef ATT_LDS2
#define ATT_LDS2 0
#endif
#ifndef ATT_EXP2
#define ATT_EXP2 0
#endif
#ifndef ATT_PROF
#define ATT_PROF 0
#endif
namespace att {
#if ATT_PROF
#define PSTAMP(var) unsigned long long var; do { __builtin_amdgcn_sched_barrier(0); var = __builtin_amdgcn_s_memtime(); __builtin_amdgcn_s_waitcnt(0xC07F); __builtin_amdgcn_sched_barrier(0); } while (0)
#define PADD(k, a_, b_) do { if (threadIdx.x == 0) atomicAdd((unsigned*)((LAS unsigned*)(lds + LDS_BYTES - 64) + (k)), (unsigned)((b_) - (a_))); } while (0)
#else
#define PSTAMP(var) do { } while (0)
#define PADD(k, a_, b_) do { } while (0)
#endif
constexpr int SLOTB = 16384, VOFF = 8192, CMPT = 65536, OSTG = 98304, SLAB = 98304, SLABW = 4352, IMP = 133120, WSF = 137856, SELM = 139904;
__device__ __forceinline__ int crow(int r, int hi) { return (r & 3) + 8 * (r >> 2) + 4 * hi; }
#define SBAR() __builtin_amdgcn_sched_barrier(0)
__device__ __forceinline__ void glds16(const void* gsrc, unsigned lds_dst) { unsigned keep;
    asm volatile("s_mov_b32 %0, m0\n\ts_mov_b32 m0, %2\n\ts_nop 0\n\tglobal_load_lds_dwordx4 %1, off\n\ts_mov_b32 m0, %0" : "=&s"(keep) : "v"(gsrc), "s"(lds_dst) : "memory"); }
typedef float f32x2_t __attribute__((ext_vector_type(2))); typedef __bf16 bf16x2_t __attribute__((ext_vector_type(2)));
__device__ __forceinline__ unsigned cvtpk_s(float lo, float hi) { f32x2_t v = {lo, hi}; bf16x2_t b = __builtin_convertvector(v, bf16x2_t); return __builtin_bit_cast(unsigned, b); }
__device__ __forceinline__ void qkt(f32x16& p0, f32x16& p1, const LAS unsigned char* Kslot, const bf16x8* qr, int r32, int hi) {
    const LAS unsigned char* kb = Kslot + hi * 1024 + r32 * 16;
#pragma unroll
    for (int d0 = 0; d0 < 4; ++d0) {
#if ATT_LDS2
        bf16x8 b0 = *(const LAS bf16x8*)(kb + d0 * 2048);
        bf16x8 b1 = *(const LAS bf16x8*)(kb + d0 * 2048 + 512);
        asm volatile("" : "+v"(b0), "+v"(b1) :: "memory");
        b0 = *(const volatile LAS bf16x8*)(kb + d0 * 2048); b1 = *(const volatile LAS bf16x8*)(kb + d0 * 2048 + 512);
#else
        const bf16x8 b0 = *(const LAS bf16x8*)(kb + d0 * 2048);
        const bf16x8 b1 = *(const LAS bf16x8*)(kb + d0 * 2048 + 512);
#endif
        if (d0 == 0) { __builtin_amdgcn_s_setprio(1); p0 = __builtin_amdgcn_mfma_f32_32x32x16_bf16(b0, qr[0], f32x16{}, 0, 0, 0); p1 = __builtin_amdgcn_mfma_f32_32x32x16_bf16(b1, qr[0], f32x16{}, 0, 0, 0); }
        else { p0 = __builtin_amdgcn_mfma_f32_32x32x16_bf16(b0, qr[d0], p0, 0, 0, 0); p1 = __builtin_amdgcn_mfma_f32_32x32x16_bf16(b1, qr[d0], p1, 0, 0, 0); }
#if ATT_MFMA2
        p0 = __builtin_amdgcn_mfma_f32_32x32x16_bf16(b0, qr[d0], p0, 0, 0, 0); p1 = __builtin_amdgcn_mfma_f32_32x32x16_bf16(b1, qr[d0], p1, 0, 0, 0);
#endif
    }
    __builtin_amdgcn_s_setprio(0);
}
__device__ __forceinline__ void pv(f32x16* o, int vb, bf16x8 pa0, bf16x8 pa1, bf16x8 pa2, bf16x8 pa3) {
#pragma unroll
    for (int d0 = 0; d0 < 2; ++d0) { s16x4 lo[4], hi[4];
#pragma unroll
        for (int ks = 0; ks < 4; ++ks) {
            asm volatile("ds_read_b64_tr_b16 %0,%1 offset:%c2" : "=&v"(lo[ks]) : "v"(vb), "i"(d0 * 4096 + ks * 1024) : "memory");
            asm volatile("ds_read_b64_tr_b16 %0,%1 offset:%c2" : "=&v"(hi[ks]) : "v"(vb), "i"(d0 * 4096 + ks * 1024 + 512) : "memory"); }
        asm volatile("s_waitcnt lgkmcnt(0)" ::: "memory"); SBAR();
#define PK(k) (bf16x8){lo[k][0], lo[k][1], lo[k][2], lo[k][3], hi[k][0], hi[k][1], hi[k][2], hi[k][3]}
        o[d0] = __builtin_amdgcn_mfma_f32_32x32x16_bf16(pa0, PK(0), o[d0], 0, 0, 0);
        o[d0] = __builtin_amdgcn_mfma_f32_32x32x16_bf16(pa1, PK(1), o[d0], 0, 0, 0);
        o[d0] = __builtin_amdgcn_mfma_f32_32x32x16_bf16(pa2, PK(2), o[d0], 0, 0, 0);
        o[d0] = __builtin_amdgcn_mfma_f32_32x32x16_bf16(pa3, PK(3), o[d0], 0, 0, 0);
#undef PK
    }
}
__device__ __forceinline__ float max3f(float a, float b, float c) { float r; asm("v_max3_f32 %0, %1, %2, %3" : "=v"(r) : "v"(a), "v"(b), "v"(c)); return r; }
__device__ __forceinline__ float max2f(float a, float b) { float r; asm("v_max_f32_e32 %0, %1, %2" : "=v"(r) : "v"(a), "v"(b)); return r; }
__device__ __forceinline__ float rowmax(const f32x16& p0, const f32x16& p1) {
    float a = max3f(p0[0], p0[1], p1[0]), b = max3f(p0[2], p0[3], p1[1]); a = max3f(a, p1[2], p1[3]);
#pragma unroll
    for (int r = 4; r < 16; r += 4) { a = max3f(a, p0[r], p0[r + 1]); b = max3f(b, p0[r + 2], p0[r + 3]); a = max3f(a, p1[r], p1[r + 1]); b = max3f(b, p1[r + 2], p1[r + 3]); }
    const float m = max2f(a, b);
    auto rr = __builtin_amdgcn_permlane32_swap(__float_as_uint(m), __float_as_uint(m), false, false);
    return max2f(__uint_as_float(rr[0]), __uint_as_float(rr[1]));
}
typedef __attribute__((address_space(3))) const char* lds_cptr;
typedef short v4i16_t __attribute__((ext_vector_type(4)));
__device__ __forceinline__ s16x4 vtr(lds_cptr p) { return __builtin_bit_cast(s16x4, __builtin_amdgcn_ds_read_tr16_b64_v4i16((__attribute__((address_space(3))) v4i16_t*)p)); }
struct VFrag { s16x4 lo[8], hi[8]; };
__device__ __forceinline__ void vload(VFrag& f, lds_cptr vp) {
#pragma unroll
    for (int i = 0; i < 8; ++i) { f.lo[i] = vtr(vp + ((i >> 2) * 4096 + (i & 3) * 1024)); f.hi[i] = vtr(vp + ((i >> 2) * 4096 + (i & 3) * 1024 + 512)); }
#if ATT_LDS2
#pragma unroll
    for (int i = 0; i < 8; ++i) { asm volatile("" : "+v"(f.lo[i]), "+v"(f.hi[i]) :: "memory"); f.lo[i] = vtr(vp + ((i >> 2) * 4096 + (i & 3) * 1024)); f.hi[i] = vtr(vp + ((i >> 2) * 4096 + (i & 3) * 1024 + 512)); }
#endif
}
__device__ __forceinline__ void pv2(f32x16* o, const VFrag& f, bf16x8 pa0, bf16x8 pa1, bf16x8 pa2, bf16x8 pa3) {
#define VFR(i) (bf16x8){f.lo[i][0], f.lo[i][1], f.lo[i][2], f.lo[i][3], f.hi[i][0], f.hi[i][1], f.hi[i][2], f.hi[i][3]}
    __builtin_amdgcn_s_setprio(1);
    o[0] = __builtin_amdgcn_mfma_f32_32x32x16_bf16(pa0, VFR(0), o[0], 0, 0, 0); o[1] = __builtin_amdgcn_mfma_f32_32x32x16_bf16(pa0, VFR(4), o[1], 0, 0, 0);
    o[0] = __builtin_amdgcn_mfma_f32_32x32x16_bf16(pa1, VFR(1), o[0], 0, 0, 0); o[1] = __builtin_amdgcn_mfma_f32_32x32x16_bf16(pa1, VFR(5), o[1], 0, 0, 0);
    o[0] = __builtin_amdgcn_mfma_f32_32x32x16_bf16(pa2, VFR(2), o[0], 0, 0, 0); o[1] = __builtin_amdgcn_mfma_f32_32x32x16_bf16(pa2, VFR(6), o[1], 0, 0, 0);
    o[0] = __builtin_amdgcn_mfma_f32_32x32x16_bf16(pa3, VFR(3), o[0], 0, 0, 0); o[1] = __builtin_amdgcn_mfma_f32_32x32x16_bf16(pa3, VFR(7), o[1], 0, 0, 0);
#if ATT_MFMA2
    o[0] = __builtin_amdgcn_mfma_f32_32x32x16_bf16(pa0, VFR(0), o[0], 0, 0, 0); o[1] = __builtin_amdgcn_mfma_f32_32x32x16_bf16(pa0, VFR(4), o[1], 0, 0, 0);
    o[0] = __builtin_amdgcn_mfma_f32_32x32x16_bf16(pa1, VFR(1), o[0], 0, 0, 0); o[1] = __builtin_amdgcn_mfma_f32_32x32x16_bf16(pa1, VFR(5), o[1], 0, 0, 0);
    o[0] = __builtin_amdgcn_mfma_f32_32x32x16_bf16(pa2, VFR(2), o[0], 0, 0, 0); o[1] = __builtin_amdgcn_mfma_f32_32x32x16_bf16(pa2, VFR(6), o[1], 0, 0, 0);
    o[0] = __builtin_amdgcn_mfma_f32_32x32x16_bf16(pa3, VFR(3), o[0], 0, 0, 0); o[1] = __builtin_amdgcn_mfma_f32_32x32x16_bf16(pa3, VFR(7), o[1], 0, 0, 0);
#endif
    __builtin_amdgcn_s_setprio(0);
#undef VFR
}
__device__ __forceinline__ void pack_p(const f32x16& p0, const f32x16& p1, bf16x8& pa0, bf16x8& pa1, bf16x8& pa2, bf16x8& pa3) {
    v4u w0 = {cvtpk_s(p0[0], p0[1]), cvtpk_s(p0[2], p0[3]), cvtpk_s(p0[4], p0[5]), cvtpk_s(p0[6], p0[7])};
    v4u w1 = {cvtpk_s(p0[8], p0[9]), cvtpk_s(p0[10], p0[11]), cvtpk_s(p0[12], p0[13]), cvtpk_s(p0[14], p0[15])};
    v4u w2 = {cvtpk_s(p1[0], p1[1]), cvtpk_s(p1[2], p1[3]), cvtpk_s(p1[4], p1[5]), cvtpk_s(p1[6], p1[7])};
    v4u w3 = {cvtpk_s(p1[8], p1[9]), cvtpk_s(p1[10], p1[11]), cvtpk_s(p1[12], p1[13]), cvtpk_s(p1[14], p1[15])};
    pa0 = __builtin_bit_cast(bf16x8, w0); pa1 = __builtin_bit_cast(bf16x8, w1); pa2 = __builtin_bit_cast(bf16x8, w2); pa3 = __builtin_bit_cast(bf16x8, w3);
}
#define LBAR() do { asm volatile("s_waitcnt lgkmcnt(0)" ::: "memory"); __builtin_amdgcn_s_barrier(); asm volatile("" ::: "memory"); } while (0)

#define ISSUE_CMP(t_) do { const int t__ = (t_); \
        glds16(wsb + (cmp_e + (unsigned)(t__ * 4096) + krow * 64 + kcol), (unsigned)__builtin_amdgcn_readfirstlane(kdst + CMPT + t__ * SLOTB)); \
        glds16(wsb + (cmp_e + (unsigned)(BATCH * 2 * 8192 + t__ * 4096) + vrow * 64 + vcol), (unsigned)__builtin_amdgcn_readfirstlane(vdst + CMPT + t__ * SLOTB)); } while (0)
#define ISSUE_T(s_, cur_, nsel_) do { const int s__ = (s_); const bool sl_ = s__ < (nsel_); const int t_ = (cur_) - (sl_ ? s__ : s__ - (nsel_)); const unsigned be_ = kv_e + (unsigned)((sl_ ? 2 : 4) * (MTOK * 128)) + (unsigned)(t_ * 8192); \
        glds16(wsb + (be_ + koff), (unsigned)__builtin_amdgcn_readfirstlane(kdst + (s__ % 6) * SLOTB)); \
        glds16(wsb + (be_ + (unsigned)(MTOK * 128) + voff), (unsigned)__builtin_amdgcn_readfirstlane(vdst + (s__ % 6) * SLOTB)); } while (0)
#define UNIT_ISSUE(cc_) do { const int cc__ = (cc_), cur__ = cc__ >> 1, nsel__ = cur__ + 1, ns2__ = nsel__ + (cur__ < 8 ? cur__ : 8) + 1; \
        ISSUE_CMP(0); if (cc__ >= 32) ISSUE_CMP(1); \
        ISSUE_T(0, cur__, nsel__); ISSUE_T(1, cur__, nsel__); if (ns2__ > 2) ISSUE_T(2, cur__, nsel__); if (ns2__ > 3) ISSUE_T(3, cur__, nsel__); } while (0)
#if ATT_MFMA2
#define LOAD_Q(cc_) do { _Pragma("unroll") for (int d0 = 0; d0 < 4; ++d0) { qr[d0] = *(const bf16x8*)(Q + ((size_t)b * SEQ + 32 * (cc_) + r32) * 1024 + head * 64 + d0 * 16 + hi * 8); \
        _Pragma("unroll") for (int e_ = 0; e_ < 8; ++e_) { const unsigned short v_ = (unsigned short)qr[d0][e_]; qr[d0][e_] = (short)((v_ & 0x7f80u) > 0x0080u ? v_ - 0x0080u : 0u); } } } while (0)
#else
#define LOAD_Q(cc_) do { _Pragma("unroll") for (int d0 = 0; d0 < 4; ++d0) qr[d0] = *(const bf16x8*)(Q + ((size_t)b * SEQ + 32 * (cc_) + r32) * 1024 + head * 64 + d0 * 16 + hi * 8); } while (0)
#endif

__device__ __forceinline__ void attn_unit(const Args& a, int b, int g, int c, int c_next, bool first, bf16x8 (&qr)[4], LAS unsigned char* lds) {
    int tid = threadIdx.x; asm volatile("" : "+v"(tid));
    const int lane = tid & 63, r32 = lane & 31, hi = lane >> 5; const int wid = __builtin_amdgcn_readfirstlane(tid >> 6);
    unsigned char* ws = a.ws;
    const unsigned lds0 = (unsigned)(uintptr_t)lds;
    const int head = g * 8 + wid, q0 = 32 * c, cur = c >> 1, tq = q0 + r32; const size_t m0 = (size_t)b * SEQ + q0;
    const bf16* Q = (const bf16*)(ws + WS_Q); const float* NG = (const float*)(ws + WS_NG);
    LAS float* wsf = (LAS float*)(lds + WSF) + wid * 64;
    LAS float* slab = (LAS float*)(lds + SLAB + wid * SLABW);
    LAS float* imp = (LAS float*)(lds + IMP);
    LAS unsigned* selm = (LAS unsigned*)(lds + SELM);
    const int ncmp = (c >= 32) ? 2 : 1, nsel = cur + 1, nwin = (cur < 8 ? cur : 8) + 1;
    const unsigned cmp_e = (unsigned)(WS_CMP / 2) + (unsigned)((b * 2 + g) * 8192);
    const unsigned kv_e = (unsigned)(WS_KV / 2) + (unsigned)(b * SEQ * 128 + g * 64);
    const unsigned krow = lane, kcol = wid * 8, vrow = 16 * (wid & 3) + (lane >> 2), vcol = (wid >> 2) * 32 + (lane & 3) * 8;
    const unsigned kdst = lds0 + wid * 1024, vdst = lds0 + VOFF + wid * 1024;
    const unsigned koff = krow * 128 + kcol, voff = vrow * 128 + vcol;
    const bf16* wsb = (const bf16*)ws;
    const int NS2 = nsel + nwin;
#define ISSUE(s_) ISSUE_T(s_, cur, nsel)
    if (first) { asm volatile("s_waitcnt vmcnt(0) lgkmcnt(0)" ::: "memory"); __builtin_amdgcn_s_barrier(); asm volatile("" ::: "memory"); UNIT_ISSUE(c); LOAD_Q(c); }
    if (tid < 32) selm[tid] = 0u;
    const float g_c = NG[(m0 + r32) * 48 + head * 3 + 0];
    f32x16 ofin[2]; ofin[0] = f32x16{}; ofin[1] = f32x16{};
    const int vbo = VOFF + ((lane >> 4) & 1) * 32 + (lane & 3) * 8 + (4 * hi + ((lane & 15) >> 2)) * 64;
    const int vbl = (int)lds0 + vbo;
    unsigned selbits = 0u;
    if (NS2 > 3) asm volatile("s_waitcnt vmcnt(8) lgkmcnt(0)" ::: "memory"); else if (NS2 > 2) asm volatile("s_waitcnt vmcnt(6) lgkmcnt(0)" ::: "memory"); else asm volatile("s_waitcnt vmcnt(4) lgkmcnt(0)" ::: "memory");
    __builtin_amdgcn_s_barrier(); asm volatile("" ::: "memory");
    PSTAMP(U1_); PADD(6, U0_, U1_);
    {
            f32x16 sc[4];
            qkt(sc[0], sc[1], lds + CMPT, qr, r32, hi);
            if (ncmp == 2) qkt(sc[2], sc[3], lds + CMPT + SLOTB, qr, r32, hi);
            else {
#pragma unroll
                for (int r = 0; r < 16; ++r) { sc[2][r] = NEGBIG; sc[3][r] = NEGBIG; } }
            const int hiq = (tq - 31) >> 4;
#pragma unroll
            for (int k = 0; k < 4; ++k)
#pragma unroll
                for (int r = 0; r < 16; ++r) { const int n = 32 * k + crow(r, hi); if (n > hiq) sc[k][r] = NEGBIG; }
            const float mx = fmaxf(rowmax(sc[0], sc[1]), rowmax(sc[2], sc[3]));
            float sum = 0.f;
#pragma unroll
            for (int k = 0; k < 4; ++k)
#pragma unroll
                for (int r = 0; r < 16; ++r) { sc[k][r] = __builtin_amdgcn_exp2f(sc[k][r] - mx); sum += sc[k][r]; }
            sum += __shfl_xor(sum, 32);
            const float inv = (hiq >= 0) ? 1.0f / sum : 0.f;
            float prevrecv = 0.f;
#pragma unroll
            for (int k = 0; k < 4; ++k)
#pragma unroll
                for (int a4 = 0; a4 < 4; ++a4) { const int idx = 4 * k + a4;
#pragma unroll
                    for (int e = 0; e < 4; ++e) sc[k][4 * a4 + e] *= inv;
                    const float g4 = (sc[k][4 * a4] + sc[k][4 * a4 + 1]) + (sc[k][4 * a4 + 2] + sc[k][4 * a4 + 3]);
                    const float recv = __shfl_xor(sc[k][4 * a4 + 3], 32); const float add = hi ? recv : prevrecv; prevrecv = recv;
                    slab[r32 * 33 + 2 * idx + hi] = g4 + add; }
#pragma unroll
            for (int k = 0; k < 4; ++k)
#pragma unroll
                for (int r = 0; r < 16; ++r) sc[k][r] *= g_c;
            bf16x8 pa0, pa1, pa2, pa3;
            pack_p(sc[0], sc[1], pa0, pa1, pa2, pa3); pv(ofin, vbl + CMPT, pa0, pa1, pa2, pa3);
            if (ncmp == 2) { pack_p(sc[2], sc[3], pa0, pa1, pa2, pa3); pv(ofin, vbl + CMPT + SLOTB, pa0, pa1, pa2, pa3); }
            PSTAMP(U2_); PADD(7, U1_, U2_);
            LBAR();
            { const int q = tid >> 4, jp = tid & 15;
#pragma unroll
              for (int e = 0; e < 2; ++e) { const int j = 2 * jp + e; float t = 0.f;
#pragma unroll
                  for (int w = 0; w < 8; ++w) t += ((LAS float*)(lds + SLAB + w * SLABW))[q * 33 + j];
                  imp[q * 36 + j] = j <= cur ? t + ((j == 0 || j == cur || j == cur - 1) ? 1000.f : 0.f) : -1e30f; } }
            LBAR();
            { const int q = tid >> 4, jp = tid & 15, j0 = 2 * jp, j1 = j0 + 1;
              const float s0 = imp[q * 36 + j0], s1 = imp[q * 36 + j1];
              int rk0 = 0, rk1 = 0;
#pragma unroll
              for (int v = 0; v < 8; ++v) { const f32x4 sv = *(const LAS f32x4*)(imp + q * 36 + 4 * v);
#pragma unroll
                  for (int e = 0; e < 4; ++e) { const int jj = 4 * v + e; const float sj = sv[e];
                      rk0 += (sj > s0 || (sj == s0 && jj < j0)) ? 1 : 0; rk1 += (sj > s1 || (sj == s1 && jj < j1)) ? 1 : 0; } }
              const unsigned bits = (rk0 < 8 ? (1u << j0) : 0u) | (rk1 < 8 ? (1u << j1) : 0u);
              if (bits) atomicOr((unsigned*)(selm + q), bits); }
            LBAR();
            selbits = selm[r32];
            PSTAMP(U3_); PADD(8, U2_, U3_);
    }
    float mref = NEGBIG, lsum = 0.f; f32x16 o[2]; o[0] = f32x16{}; o[1] = f32x16{};
#pragma unroll 1
    for (int d = 0; 2 * d < NS2; ++d) {
        { const int later = NS2 - (2 * d + 2);
          if (later >= 2) asm volatile("s_waitcnt vmcnt(4) lgkmcnt(0)" ::: "memory"); else if (later == 1) asm volatile("s_waitcnt vmcnt(2) lgkmcnt(0)" ::: "memory"); else asm volatile("s_waitcnt vmcnt(0) lgkmcnt(0)" ::: "memory");
          __builtin_amdgcn_s_barrier(); asm volatile("" ::: "memory");
          if (2 * d + 4 < NS2) ISSUE(2 * d + 4);
          if (2 * d + 5 < NS2) ISSUE(2 * d + 5); }
#pragma unroll 1
      for (int sub = 0; sub < 2; ++sub) { const int s = 2 * d + sub; if (s >= NS2) break;
        const int slot = (s % 6) * SLOTB;
        const bool issel = s < nsel; const int j = issel ? s : s - nsel, t = cur - j;
        const bool lastt = issel ? (j == nsel - 1) : (j == nwin - 1);
        VFrag vf; vload(vf, (lds_cptr)lds + vbo + slot);
        f32x16 C0, C1;
        qkt(C0, C1, lds + slot, qr, r32, hi);
        const bool rowon = !issel || ((selbits >> t) & 1u);
        if (t == cur || (!issel && t == cur - 8)) {
            const int kb = 64 * t + 4 * hi, lo_ = issel ? -(1 << 30) : tq - 511;
#pragma unroll
            for (int r = 0; r < 16; ++r) { const int kp = kb + (r & 3) + 8 * (r >> 2); if (kp > tq || kp < lo_) C0[r] = NEGBIG; if (kp + 32 > tq || kp + 32 < lo_) C1[r] = NEGBIG; } }
        const float rmx_ = rowmax(C0, C1); const float rm = rowon ? rmx_ : NEGBIG;
        if (__any(rm > mref + 8.0f)) {
            const float mn = fmaxf(mref, rm), alpha = __builtin_amdgcn_exp2f(mref - mn);
            lsum *= alpha; mref = mn;
            if (hi == 0) wsf[r32] = alpha;
            LDS_WAIT(); asm volatile("" ::: "memory");
#pragma unroll
            for (int r = 0; r < 16; ++r) { const float f = wsf[crow(r, hi)]; o[0][r] *= f; o[1][r] *= f; }
            LDS_WAIT(); asm volatile("" ::: "memory"); }
        float sm = 0.f;
        const float meff = rowon ? mref : 1e30f;
#if ATT_EXP2
        { float dmy = 0.f;
#pragma unroll
          for (int r = 0; r < 16; ++r) { dmy += __builtin_amdgcn_exp2f(C0[r] - meff * 1.0001f) + __builtin_amdgcn_exp2f(C1[r] - meff * 1.0001f); }
          asm volatile("" :: "v"(dmy)); }
#endif
#pragma unroll
        for (int r = 0; r < 16; ++r) { C0[r] = __builtin_amdgcn_exp2f(C0[r] - meff); C1[r] = __builtin_amdgcn_exp2f(C1[r] - meff); sm += C0[r] + C1[r]; }
        lsum += sm;
        bf16x8 pa0, pa1, pa2, pa3; pack_p(C0, C1, pa0, pa1, pa2, pa3);
        pv2(o, vf, pa0, pa1, pa2, pa3);
        if (lastt) {
            const float lt = lsum + __shfl_xor(lsum, 32);
            if (hi == 0) wsf[r32] = (ATT_MFMA2 ? 0.5f : 1.0f) * NG[(m0 + r32) * 48 + head * 3 + (issel ? 1 : 2)] / lt;
            LDS_WAIT(); asm volatile("" ::: "memory");
#pragma unroll
            for (int r = 0; r < 16; ++r) { const float f = wsf[crow(r, hi)]; ofin[0][r] += o[0][r] * f; ofin[1][r] += o[1][r] * f; }
            LDS_WAIT(); asm volatile("" ::: "memory");
            mref = NEGBIG; lsum = 0.f; o[0] = f32x16{}; o[1] = f32x16{}; }
      }
    }
    PSTAMP(U5_);
    asm volatile("s_waitcnt lgkmcnt(0)" ::: "memory"); __builtin_amdgcn_s_barrier(); asm volatile("" ::: "memory");
    if (c_next >= 0) { UNIT_ISSUE(c_next); LOAD_Q(c_next); }
#undef ISSUE
    { LAS bf16* stg = (LAS bf16*)(lds + OSTG) + wid * 2048;
#pragma unroll
      for (int r = 0; r < 16; ++r) { const int orow = crow(r, hi);
#pragma unroll
          for (int d0 = 0; d0 < 2; ++d0) stg[orow * 64 + d0 * 32 + r32] = (bf16)(cvtpk_s(ofin[d0][r], 0.f) & 0xffffu); }
      LDS_WAIT(); asm volatile("" ::: "memory");
      bf16* Ow = (bf16*)(ws + WS_PA) + m0 * KCAT + 512 + head * 64;
#pragma unroll
      for (int i = 0; i < 4; ++i) { const int row = i * 8 + (lane >> 3), ch = lane & 7; const v4u v = *(const LAS v4u*)(stg + row * 64 + ch * 8); *(v4u*)(Ow + (size_t)row * KCAT + ch * 8) = v; }
      LDS_WAIT(); asm volatile("" ::: "memory"); }
    PSTAMP(U6_); PADD(10, U5_, U6_);
}

__device__ __forceinline__ int chunk_of(int qd, int uu) { const int u = uu & 15; const int i = qd + 4 * (u >> 2), k = u & 3; return (k == 0) ? i : (k == 1) ? 31 - i : (k == 2) ? 32 + i : 63 - i; }
__device__ __forceinline__ void attn_phase(const Args& a, LAS unsigned char* lds, int vcu) {
    const int bg = vcu >> 2, qd = vcu & 3;
    PSTAMP(TP0_);
    bf16x8 qr[4];
    for (int uu = 0; uu < 16 * ATT_REP; ++uu) {
        const int c = chunk_of(qd, uu), cn = (uu + 1 < 16 * ATT_REP) ? chunk_of(qd, uu + 1) : -1;
        attn_unit(a, bg >> 1, bg & 1, c, cn, uu == 0, qr, lds); }
    PSTAMP(TP1_); PADD(5, TP0_, TP1_);
#if ATT_PROF
    __syncthreads();
    if (blockIdx.x == 0 && threadIdx.x < 16) ((unsigned*)(a.ws + WS_CTL + 524288))[threadIdx.x] = ((LAS unsigned*)(lds + LDS_BYTES - 64))[threadIdx.x];
#endif
}
#undef SBAR
#undef LBAR
}
#ifndef MK_COOP
#define MK_COOP 1
#endif
constexpr int N_PHASES = 10;
#ifndef EREPS
#define EREPS 1, 1, 1, 1, 1, 1
#endif
#ifndef GREP1
#define GREP1 1
#define GREP4 1
#define GREP5 1
#define GREP7 1
#endif
template <int REPS> struct RepOrder { pg8::StaticOrder b; int per;
    __device__ __forceinline__ void init(int M, int N, int G, int c) { b.init(M, N, G, c); per = b.nwg / G; }
    __device__ __forceinline__ bool next(int i, pg8::Unit& u) const { if constexpr (REPS == 1) return b.next(i, u); else { if (i >= per * REPS) return false; return b.next(i % per, u); } }
    __device__ __forceinline__ void a_ready(const pg8::Unit&) const {}
    __device__ __forceinline__ void done(const pg8::Unit&) const {} };
__global__ void __launch_bounds__(NWAVES * 64, 2) fwd_megakernel(Args args) {
    extern __shared__ __attribute__((aligned(16))) unsigned char lds_raw[];
    LAS unsigned char* lds = (LAS unsigned char*)lds_raw;
    const int G = gridDim.x; const int bx = blockIdx.x; const int vcu = (G % 8 == 0) ? (bx % 8) * (G / 8) + bx / 8 : bx;
    unsigned char* ws = args.ws;
    const int lo = args.ph_lo, hi = args.ph_hi;
#ifndef PH_MASK
#define PH_MASK 0x3ff
#endif
#ifndef DUP_MASK
#define DUP_MASK 0
#endif
#define REP(k) _Pragma("nounroll") for (int rep_ = 0; rep_ < 1 + (((DUP_MASK) >> (k)) & 1); ++rep_)
#define PHON(k) (((PH_MASK) >> (k)) & 1)
#define IN(k) (PHON(k) && lo <= (k) && (k) < hi)
    volatile LAS unsigned* MISC = (volatile LAS unsigned*)(lds + LDS_BYTES - 128);
    if (threadIdx.x < 32) ((LAS unsigned*)(lds + LDS_BYTES - 128))[threadIdx.x] = 0u;
    __syncthreads();
    XcdBarrier bar = xcd_barrier_post((unsigned*)(ws + WS_CTL) + 4096, MISC + 8);
#define GRID_BAR(k) do { if (IN(k) && IN((k) + 1)) { xcd_barrier(bar); } } while (0)
    REP(0) if (IN(0)) { p0_prologue(args, lds, vcu, G); }
    GRID_BAR(0);
    REP(1) if (IN(1)) {
        pg8::Gemm g{(const bf16*)(ws + WS_XB), (const bf16*)(ws + WS_WIN), MTOK, N_IN, DM, args.erep[0]}; RepOrder<GREP1> S; S.init(MTOK, N_IN, G, bx);
        EpiIn E{(const float*)(ws + WS_R1), (bf16*)(ws + WS_UPOOL), (bf16*)(ws + WS_Q), (bf16*)(ws + WS_KV), (unsigned char*)(ws + WS_MG), (float*)(ws + WS_NG), args.in[I_QNW], args.in[I_KNW], (const float*)(ws + WS_ROPE)};
        pg8::gemm_phase<EpiIn, RepOrder<GREP1>, true, true>(lds, g, S, E);
    }
    GRID_BAR(1);
    REP(2) if (IN(2)) { p2_pool_compress(args, lds, vcu, G); }
    GRID_BAR(2);
    REP(3) if (IN(3)) { __syncthreads(); att::attn_phase(args, lds, vcu); }
    GRID_BAR(3);
    REP(4) if (IN(4)) {
        pg8::Gemm g{(const bf16*)(ws + WS_PA), (const bf16*)(ws + WS_WCAT), MTOK, DM, KCAT, args.erep[3]}; RepOrder<GREP4> S; S.init(MTOK, DM, G, bx);
        EpiMerge E{(const unsigned char*)(ws + WS_MG), (bf16*)(ws + WS_MERGED)};
        pg8::gemm_phase<EpiMerge, RepOrder<GREP4>, true, true>(lds, g, S, E);
    }
    GRID_BAR(4);
    REP(5) if (IN(5)) {
        pg8::Gemm g{(const bf16*)(ws + WS_MERGED), (const bf16*)(ws + WS_WO), MTOK, DM, DM, args.erep[4]}; RepOrder<GREP5> S; S.init(MTOK, DM, G, bx);
        EpiWo E{(const bf16*)(ws + WS_XB), (bf16*)(ws + WS_X1B), (float*)(ws + WS_SSQ)};
        pg8::gemm_phase<EpiWo, RepOrder<GREP5>, true, true>(lds, g, S, E);
    }
    GRID_BAR(5);
    REP(6) if (IN(6)) { p5b_r2(args, vcu, G); }
    GRID_BAR(6);
    REP(7) if (IN(7)) {
        pg8::Gemm g{(const bf16*)(ws + WS_X1B), (const bf16*)(ws + WS_WUP), MTOK, N_UP, DM, args.erep[1]}; RepOrder<GREP7> S; S.init(MTOK, N_UP, G, bx);
        EpiUp E{(const float*)(ws + WS_R1), args.in[I_CONVW], args.in[I_CONVB], (bf16*)(ws + WS_A), (float*)(ws + WS_RAW)};
        pg8::gemm_phase<EpiUp, RepOrder<GREP7>, true, true>(lds, g, S, E);
    }
    GRID_BAR(7);
    REP(8) if (IN(8)) { p7_fixup(args, vcu, G); }
    GRID_BAR(8);
    REP(9) if (IN(9)) {
        pg8::Gemm g{(const bf16*)(ws + WS_A), (const bf16*)(ws + WS_WDN), MTOK, DM, K_DN, args.erep[5]}; pg8::StaticOrder S; S.init(MTOK, DM, G, bx);
        EpiDown E{(const bf16*)(ws + WS_X1B), args.out};
        pg8::gemm_phase<EpiDown, pg8::StaticOrder, true, true>(lds, g, S, E);
    }
#if GEMM_PROF
    xcd_barrier(bar);
    if (blockIdx.x == 0 && threadIdx.x == 0) { const LAS unsigned* pr = (const LAS unsigned*)(lds + 147392); args.out[0] = 100.0f * (float)pr[GEMM_PROF] / (float)pr[4]; }
#endif
#if ATT_PROF
    xcd_barrier(bar);
    if (blockIdx.x == 0 && threadIdx.x == 0) { const unsigned* pr = (const unsigned*)(ws + WS_CTL + 524288); args.out[0] = 100.0f * (float)pr[ATT_PROF - 1] / (float)pr[5]; }
#endif
#undef IN
#undef GRID_BAR
}

extern "C" void kernel_launch(void* const* d_in, const int* in_sizes, int n_in, void* d_out, int out_size, void* d_ws, size_t ws_size, hipStream_t stream) {
    static int grid = 0;
    if (grid == 0) {
        if (n_in != 19 || in_sizes[0] != MTOK * DM || out_size != MTOK * DM || ws_size < WS_END) {
            fprintf(stderr, "kernel_launch: unexpected shapes: n_in %d in0 %d out %d ws %zu (need %zu)\n", n_in, n_in > 0 ? in_sizes[0] : -1, out_size, ws_size, (size_t)WS_END); grid = -1; return; }
        int dev = 0, cus = 0, per_cu = 0;
        hipGetDevice(&dev); hipDeviceGetAttribute(&cus, hipDeviceAttributeMultiprocessorCount, dev);
        if (hipFuncSetAttribute((const void*)fwd_megakernel, hipFuncAttributeMaxDynamicSharedMemorySize, LDS_BYTES) != hipSuccess) { fprintf(stderr, "kernel_launch: hipFuncSetAttribute failed\n"); grid = -1; return; }
        if (hipOccupancyMaxActiveBlocksPerMultiprocessor(&per_cu, (const void*)fwd_megakernel, NWAVES * 64, LDS_BYTES) != hipSuccess || per_cu < 1) { fprintf(stderr, "kernel_launch: occupancy query says %d\n", per_cu); per_cu = 1; }
        (void)hipGetLastError();
        grid = cus;
        if (grid != 256) fprintf(stderr, "kernel_launch: note: %d CUs (built for 256)\n", grid);
    }
    if (grid < 0) return;
    Args a{};
    for (int i = 0; i < 19; ++i) a.in[i] = (const float*)d_in[i];
    a.out = (float*)d_out; a.ws = (unsigned char*)d_ws; { const int er_[6] = {EREPS}; for (int i = 0; i < 6; ++i) a.erep[i] = er_[i]; }
#if MK_COOP
    a.ph_lo = 0; a.ph_hi = N_PHASES;
    if (hipMemsetAsync((char*)d_ws + WS_CTL, 0, CTL_ZERO_BYTES, stream) != hipSuccess) { fprintf(stderr, "kernel_launch: hipMemsetAsync failed\n"); return; }
    void* kargs[] = {&a};
    hipError_t e = hipLaunchCooperativeKernel((const void*)fwd_megakernel, dim3(grid), dim3(NWAVES * 64), kargs, LDS_BYTES, stream);
    if (e != hipSuccess) fprintf(stderr, "kernel_launch: cooperative launch failed: %s (grid %d)\n", hipGetErrorString(e), grid);
#else
    for (int p = 0; p < N_PHASES; ++p) { a.ph_lo = p; a.ph_hi = p + 1; hipLaunchKernelGGL(fwd_megakernel, dim3(grid), dim3(NWAVES * 64), LDS_BYTES, stream, a); }
#endif
}
```

```cpp
#include <hip/hip_runtime.h>
#include <hip/hip_cooperative_groups.h>
#include <cstdio>
#include <cstdint>
namespace cg = cooperative_groups;
namespace pg8 {
#define PG8_LAS __attribute__((address_space(3)))
typedef unsigned short bf16_t;
typedef short bf16x8 __attribute__((ext_vector_type(8)));
typedef float f32x4 __attribute__((ext_vector_type(4)));
typedef unsigned u32x4 __attribute__((ext_vector_type(4)));
constexpr int BM = 256, BK = 64, HALF = 128, HTB = HALF * BK * 2  , STAGE_BYTES = 8 * HTB, NXCD = 8, WGM = 8;

__host__ __device__ __forceinline__ int lds_byte(int r, int c) { const int st = (r >> 4) * 2 + (c >> 5), rr = r & 15, cc = c & 31, ob = rr * 64 + cc * 2; return st * 1024 + (ob ^ (((ob >> 9) & 1) << 5)); }
__host__ __device__ __forceinline__ void stage_rc(int b, int& R, int& C) { const int st = b / 1024, sb = b % 1024, swz = sb ^ (((sb >> 9) & 1) << 5); R = (st >> 1) * 16 + swz / 64; C = (st & 1) * 32 + (swz % 64) / 2; }
__host__ __device__ __forceinline__ int perm32(int rho) { const int n = rho >> 4, i = rho & 15; return 8 * (i >> 2) + 4 * n + (i & 3); }

struct Unit { int pm, pn; };
struct Gemm { const bf16_t* A; const bf16_t* Bt; int M, N, K; int erep = 1; };

struct StaticOrder {
    int nM, nN, nwg, G, c;
    __host__ __device__ void init(int M, int N, int G_, int c_) { nM = M / BM; nN = N / BM; nwg = nM * nN; G = G_; c = c_; }
    __host__ __device__ bool next(int i, Unit& u) const {
        const long L = (long)i * G + c; if (L >= nwg) return false;
        int wgid = (int)L; { const int q = nwg / NXCD, r = nwg % NXCD, xcd = wgid % NXCD, off = wgid / NXCD; wgid = (xcd < r ? xcd * (q + 1) : r * (q + 1) + (xcd - r) * q) + off; }
        const int nig = WGM * nN, gid = wgid / nig, fm = gid * WGM, gsz = (nM - fm) < WGM ? (nM - fm) : WGM;
        u.pm = fm + ((wgid % nig) % gsz); u.pn = (wgid % nig) / gsz; return true;
    }
    __device__ __forceinline__ void a_ready(const Unit&) const {}
    __device__ __forceinline__ void done(const Unit&) const {}
};

__device__ __forceinline__ unsigned cvt_pk_bf16(float lo, float hi) { unsigned r; asm volatile("v_cvt_pk_bf16_f32 %0, %1, %2" : "=v"(r) : "v"(lo), "v"(hi)); return r; }
typedef float f32x2 __attribute__((ext_vector_type(2)));
#ifndef KLOOP_REP
#define KLOOP_REP 1
#endif
#ifndef GEMM_PROF
#define GEMM_PROF 0
#endif
#if GEMM_PROF
#define GSTAMP(var) unsigned long long var; do { __builtin_amdgcn_sched_barrier(0); var = __builtin_amdgcn_s_memtime(); __builtin_amdgcn_s_waitcnt(0xC07F); __builtin_amdgcn_sched_barrier(0); } while (0)
#define GADD(k, a_, b_) do { if (threadIdx.x == 0 && g.erep == 3) atomicAdd((unsigned*)((PG8_LAS unsigned*)(lds + 147392) + (k)), (unsigned)((b_) - (a_))); } while (0)
#else
#define GSTAMP(var) do { } while (0)
#define GADD(k, a_, b_) do { } while (0)
#endif
#ifndef EPI_REP
#define EPI_REP 1
#endif
template <class Epi, class Sched, bool ALIGN_EPI = false, bool SP2 = false>
__device__ __forceinline__ void gemm_phase(PG8_LAS unsigned char* lds, const Gemm g, const Sched& S, const Epi& E) {
    int tid_ = threadIdx.x; asm volatile("" : "+v"(tid_));
    const int tid = tid_, wid = __builtin_amdgcn_readfirstlane(tid >> 6), lane = tid & 63, wr = wid >> 2, wc = wid & 3, fr = lane & 15, fq = lane >> 4;
    const int K = g.K, nt = K / BK;
    unsigned voffA[2], voffB[2];
#pragma unroll
    for (int i = 0; i < 2; ++i) { int R, C; stage_rc(tid * 16 + i * 8192, R, C); const int Rb = Epi::PERM ? ((R & ~31) + perm32(R & 31)) : R;
        const int Ra = Epi::APERM ? ((R & ~63) + 4 * (R & 15) + ((R >> 4) & 3)) : R;
        voffA[i] = (unsigned)(Ra * K + C) * 2u; voffB[i] = (unsigned)(Rb * K + C) * 2u; }
    const size_t kstep = (size_t)(BK * 2);
    const size_t hstep = (size_t)HALF * K * 2;
    const size_t tstep = 2 * hstep;
    const unsigned ldsw = (unsigned)wid * 1024u;
    const int aoff = lds_byte(wr * 64 + fr, fq * 8), boff = lds_byte(wc * 32 + fr, fq * 8);
#define PG8_SA(b, h) (((b) * 2 + (h)) * HTB)
#define PG8_SB(b, h) ((4 + (b) * 2 + (h)) * HTB)
#define PG8_STAGE(bufoff, gbase, voff) do { _Pragma("unroll") for (int _i = 0; _i < 2; ++_i) \
        __builtin_amdgcn_global_load_lds((const unsigned*)((const char*)(gbase) + (voff)[_i]), (PG8_LAS unsigned*)(lds + (bufoff) + ldsw + _i * 8192), 16, 0, 0); } while (0)
#define PG8_LDA(dst, b, h) do { _Pragma("unroll") for (int m = 0; m < 4; ++m) _Pragma("unroll") for (int k = 0; k < 2; ++k) dst[m][k] = *(const PG8_LAS bf16x8*)(lds + PG8_SA(b, h) + aoff + m * 2048 + k * 1024); } while (0)
#define PG8_LDB(dst, b, h) do { _Pragma("unroll") for (int n = 0; n < 2; ++n) _Pragma("unroll") for (int k = 0; k < 2; ++k) dst[n][k] = *(const PG8_LAS bf16x8*)(lds + PG8_SB(b, h) + boff + n * 2048 + k * 1024); } while (0)
#define PG8_MMA(ai, bj, At, Bt) do { __builtin_amdgcn_s_setprio(1); _Pragma("unroll") for (int m = 0; m < 4; ++m) _Pragma("unroll") for (int n = 0; n < 2; ++n) _Pragma("unroll") for (int k = 0; k < 2; ++k) \
        acc[ai][bj][m][n] = __builtin_amdgcn_mfma_f32_16x16x32_bf16(Bt[n][k], At[m][k], acc[ai][bj][m][n], 0, 0, 0); __builtin_amdgcn_s_setprio(0); } while (0)
#define PG8_WAIT_V(n) asm volatile("s_waitcnt vmcnt(" #n ")" ::: "memory")
#define PG8_WAIT_L(n) asm volatile("s_waitcnt lgkmcnt(" #n ")" ::: "memory")
#define PG8_BAR __builtin_amdgcn_s_barrier()
#define PG8_SCHED __builtin_amdgcn_sched_barrier(0)
    GSTAMP(G0_);
    Unit cur, nxt; int ui = 0;
    if (!S.next(0, cur)) return;
    f32x4 acc[2][2][4][2];
#pragma unroll
    for (int a = 0; a < 2; ++a)
#pragma unroll
        for (int b = 0; b < 2; ++b)
#pragma unroll
            for (int m = 0; m < 4; ++m)
#pragma unroll
                for (int n = 0; n < 2; ++n) acc[a][b][m][n] = (f32x4){0.f, 0.f, 0.f, 0.f};
    bf16x8 At[4][2], B0[2][2], B1[2][2];
    const char* cA = (const char*)g.A + (size_t)cur.pm * tstep; const char* cB = (const char*)g.Bt + (size_t)cur.pn * tstep;
    S.a_ready(cur);
    if constexpr (SP2) {
        PG8_STAGE(PG8_SB(0, 0), cB, voffB); PG8_STAGE(PG8_SB(0, 1), cB + hstep, voffB); PG8_STAGE(PG8_SA(0, 0), cA, voffA); PG8_STAGE(PG8_SA(0, 1), cA + hstep, voffA);
        if (wr == 1) PG8_BAR;
        PG8_WAIT_V(2); PG8_BAR;
        PG8_STAGE(PG8_SB(1, 0), cB + kstep, voffB); PG8_STAGE(PG8_SA(1, 0), cA + kstep, voffA); PG8_STAGE(PG8_SB(1, 1), cB + hstep + kstep, voffB);
        PG8_WAIT_V(6); PG8_BAR;
    } else {
        PG8_STAGE(PG8_SB(0, 0), cB, voffB); PG8_STAGE(PG8_SA(0, 0), cA, voffA); PG8_STAGE(PG8_SB(0, 1), cB + hstep, voffB); PG8_STAGE(PG8_SA(0, 1), cA + hstep, voffA);
        if (wr == 1) PG8_BAR;
        PG8_WAIT_V(4); PG8_BAR;
        PG8_STAGE(PG8_SB(1, 0), cB + kstep, voffB); PG8_STAGE(PG8_SA(1, 0), cA + kstep, voffA); PG8_STAGE(PG8_SB(1, 1), cB + hstep + kstep, voffB);
        PG8_WAIT_V(6); PG8_BAR;
    }
    for (;;) {
        const bool has_next = S.next(ui + 1, nxt);
        const char* nA = has_next ? (const char*)g.A + (size_t)nxt.pm * tstep : cA; const char* nB = has_next ? (const char*)g.Bt + (size_t)nxt.pn * tstep : cB;
#if KLOOP_REP == 1
        for (int t = 0; t < nt; t += 2) {
            const bool last = (t == nt - 2);
            const char* a1 = cA + (size_t)(t + 1) * kstep;
            const char* a2 = last ? nA : cA + (size_t)(t + 2) * kstep; const char* b2 = last ? nB : cB + (size_t)(t + 2) * kstep;
#else
        for (int t2_ = 0, t = 0; t2_ < nt * g.erep; t2_ += 2, t = (t + 2 == nt) ? 0 : t + 2) {
            const bool last = (t2_ == nt * g.erep - 2); const int tn_ = (t + 2 == nt) ? 0 : t + 2;
            const char* a1 = cA + (size_t)(t + 1) * kstep;
            const char* a2 = last ? nA : cA + (size_t)tn_ * kstep; const char* b2 = last ? nB : cB + (size_t)tn_ * kstep;
#endif
            const char* a3 = a2 + kstep; const char* b3 = b2 + kstep;
            if (last && has_next) S.a_ready(nxt);
            if constexpr (SP2) {
            PG8_LDB(B0, 0, 0); PG8_LDB(B1, 0, 1); PG8_SCHED; PG8_LDA(At, 0, 0); PG8_STAGE(PG8_SA(1, 1), a1 + hstep, voffA);
            PG8_WAIT_V(8); PG8_WAIT_L(0); PG8_BAR; PG8_MMA(0, 0, At, B0); PG8_MMA(0, 1, At, B1); PG8_BAR; PG8_SCHED;
            PG8_LDA(At, 0, 1); PG8_STAGE(PG8_SB(0, 0), b2, voffB); PG8_STAGE(PG8_SB(0, 1), b2 + hstep, voffB); PG8_STAGE(PG8_SA(0, 0), a2, voffA);
            PG8_WAIT_V(8); PG8_WAIT_L(0); PG8_BAR; PG8_MMA(1, 0, At, B0); PG8_MMA(1, 1, At, B1); PG8_BAR; PG8_SCHED;
            PG8_LDB(B0, 1, 0); PG8_LDB(B1, 1, 1); PG8_SCHED; PG8_LDA(At, 1, 0); PG8_STAGE(PG8_SA(0, 1), a2 + hstep, voffA);
            PG8_WAIT_V(8); PG8_WAIT_L(0); PG8_BAR; PG8_MMA(0, 0, At, B0); PG8_MMA(0, 1, At, B1); PG8_BAR; PG8_SCHED;
            PG8_LDA(At, 1, 1); PG8_STAGE(PG8_SB(1, 0), b3, voffB); PG8_STAGE(PG8_SB(1, 1), b3 + hstep, voffB); PG8_STAGE(PG8_SA(1, 0), a3, voffA);
            PG8_WAIT_V(8); PG8_WAIT_L(0); PG8_BAR; PG8_MMA(1, 0, At, B0); PG8_MMA(1, 1, At, B1); PG8_BAR; PG8_SCHED;
            } else {
            PG8_LDB(B0, 0, 0); PG8_SCHED; PG8_LDA(At, 0, 0); PG8_STAGE(PG8_SA(1, 1), a1 + hstep, voffA);
            PG8_WAIT_L(8); PG8_BAR; PG8_WAIT_L(0); PG8_MMA(0, 0, At, B0); PG8_BAR; PG8_SCHED;
            PG8_LDB(B1, 0, 1); PG8_STAGE(PG8_SB(0, 0), b2, voffB);
            PG8_BAR; PG8_WAIT_L(0); PG8_MMA(0, 1, At, B1); PG8_BAR;
            PG8_LDA(At, 0, 1); PG8_STAGE(PG8_SA(0, 0), a2, voffA);
            PG8_BAR; PG8_WAIT_L(0); PG8_MMA(1, 0, At, B0); PG8_BAR; PG8_SCHED;
            PG8_STAGE(PG8_SB(0, 1), b2 + hstep, voffB);
            PG8_WAIT_V(6); PG8_BAR; PG8_MMA(1, 1, At, B1); PG8_BAR;
            PG8_LDB(B0, 1, 0); PG8_SCHED; PG8_LDA(At, 1, 0); PG8_STAGE(PG8_SA(0, 1), a2 + hstep, voffA);
            PG8_WAIT_L(8); PG8_BAR; PG8_WAIT_L(0); PG8_MMA(0, 0, At, B0); PG8_BAR; PG8_SCHED;
            PG8_LDB(B1, 1, 1); PG8_STAGE(PG8_SB(1, 0), b3, voffB);
            PG8_BAR; PG8_WAIT_L(0); PG8_MMA(0, 1, At, B1); PG8_BAR;
            PG8_LDA(At, 1, 1); PG8_STAGE(PG8_SA(1, 0), a3, voffA);
            PG8_BAR; PG8_WAIT_L(0); PG8_MMA(1, 0, At, B0); PG8_BAR; PG8_SCHED;
            PG8_STAGE(PG8_SB(1, 1), b3 + hstep, voffB);
            PG8_WAIT_V(6); PG8_BAR; PG8_MMA(1, 1, At, B1); PG8_BAR;
            }
            if constexpr (Epi::MIDHOOK) { if (t == Epi::HOOK_T) E.mid(acc, cur, wr, wc, fr, fq); }
        }
#if KLOOP_REP != 1
        _Pragma("unroll") for (int a_ = 0; a_ < 2; ++a_) _Pragma("unroll") for (int b_ = 0; b_ < 2; ++b_) _Pragma("unroll") for (int m_ = 0; m_ < 4; ++m_) _Pragma("unroll") for (int n_ = 0; n_ < 2; ++n_) acc[a_][b_][m_][n_] *= (g.erep == 2 ? 0.5f : 1.0f);
#endif
        GSTAMP(E0_);
        if constexpr (ALIGN_EPI) { if (wr == 0) PG8_BAR; }
        if constexpr (!Epi::AFTER_DRAIN) { if (EPI_REP > 1) { _Pragma("nounroll") for (int rep_ = 0; rep_ < g.erep; ++rep_) { asm volatile("" ::: "memory"); E(acc, cur, wr, wc, fr, fq); } } else E(acc, cur, wr, wc, fr, fq); S.done(cur); }
        GSTAMP(E1_); GADD(13 - 8, E0_, E1_);
        if (!has_next) break;
#pragma unroll
        for (int a = 0; a < 2; ++a)
#pragma unroll
            for (int b = 0; b < 2; ++b)
#pragma unroll
                for (int m = 0; m < 4; ++m)
#pragma unroll
                    for (int n = 0; n < 2; ++n) acc[a][b][m][n] = (f32x4){0.f, 0.f, 0.f, 0.f};
        cur = nxt; cA = nA; cB = nB; ++ui;
        if constexpr (ALIGN_EPI) { if (wr == 1) PG8_BAR; }                        GSTAMP(E2_); GADD(14 - 8, E1_, E2_);
    }
    PG8_WAIT_V(0);
    if constexpr (!ALIGN_EPI) { if (wr == 0) PG8_BAR; }
    PG8_BAR;
    if constexpr (Epi::AFTER_DRAIN) { E.fused(acc, cur, wr, wc, fr, fq, lds, wid, lane); S.done(cur); }
    GSTAMP(G1_); GADD(12 - 8, G0_, G1_);
#undef PG8_SA
#undef PG8_SB
#undef PG8_STAGE
#undef PG8_LDA
#undef PG8_LDB
#undef PG8_MMA
#undef PG8_WAIT_V
#undef PG8_WAIT_L
#undef PG8_BAR
#undef PG8_SCHED
}
}
constexpr int BATCH = 32, SEQ = 2048, DM = 1024, MTOK = BATCH * SEQ;
constexpr int KCAT = 1536, IN_W = 4400, N_IN = 4608, DFF = 2752, N_UP = 5632, K_DN = 2816, UPW = 5504;
constexpr float EPS = 1e-6f, QSCALE = 0.125f * 1.4426950408889634f, NEGBIG = -1e30f;
constexpr size_t MiB = 1u << 20;
constexpr size_t WS_CTL = 0, CTL_ZERO_BYTES = 1 * MiB;
constexpr size_t WS_WIN = 2 * MiB, WS_WCAT = 11 * MiB  , WS_WO = 14 * MiB, WS_WUP = 16 * MiB, WS_WDN = 27 * MiB, WS_W1T = 33 * MiB;
constexpr size_t WS_W2T = 34 * MiB, WS_B1 = 34 * MiB + 65536, WS_ROPE = 35 * MiB, WS_R1 = 36 * MiB, WS_SSQ = 37 * MiB, WS_CMP = 41 * MiB, WS_NG = 44 * MiB, WS_RAW = 56 * MiB;
constexpr size_t WS_XB = 144 * MiB, WS_UPOOL = 272 * MiB, WS_Q = 336 * MiB, WS_KV = 464 * MiB, WS_MG = 560 * MiB, WS_PA = 816 * MiB, WS_END = 1008 * MiB;
constexpr size_t WS_PY = 272 * MiB, WS_MERGED = 400 * MiB, WS_X1B = 560 * MiB, WS_A = 144 * MiB;
constexpr int LDS_BYTES = 147456, NWAVES = 8;

#define GAS __attribute__((address_space(1)))
#define LAS __attribute__((address_space(3)))
typedef unsigned short bf16;
typedef unsigned v4u __attribute__((ext_vector_type(4)));
typedef unsigned v2u __attribute__((ext_vector_type(2)));
typedef float f32x4 __attribute__((ext_vector_type(4)));
typedef float f32x16 __attribute__((ext_vector_type(16)));
typedef short bf16x8 __attribute__((ext_vector_type(8)));
typedef short s16x4 __attribute__((ext_vector_type(4)));
#define LDS_WAIT() asm volatile("s_waitcnt lgkmcnt(0)" ::: "memory")
#define VM_WAIT() asm volatile("s_waitcnt vmcnt(0)" ::: "memory")
__device__ __forceinline__ unsigned pk2(float lo, float hi) { return pg8::cvt_pk_bf16(lo, hi); }
__device__ __forceinline__ float bflo(unsigned w) { return __uint_as_float(w << 16); }
__device__ __forceinline__ float bfhi(unsigned w) { return __uint_as_float(w & 0xffff0000u); }
__device__ __forceinline__ float sigmoidf_(float z) { return __builtin_amdgcn_rcpf(1.0f + __builtin_amdgcn_exp2f(-1.4426950408889634f * z)); }
__device__ __forceinline__ float wave_sum(float v) {
#pragma unroll
    for (int o = 1; o < 64; o <<= 1) v += __shfl_xor(v, o);
    return v;
}

struct Args {
    const float* in[19];
    float* out; unsigned char* ws;
    int ph_lo, ph_hi; int erep[6];
};
enum { I_X = 0, I_ANW, I_WIN, I_POOLW, I_POOLS, I_QNW, I_KNW, I_CPOS, I_CW1, I_CB1, I_CW2, I_WPB, I_WAB, I_WO, I_FNW, I_WUP, I_CONVW, I_CONVB, I_WDN };

struct MapId { __device__ __forceinline__ int operator()(int s) const { return s; } };
struct MapIn { __device__ __forceinline__ int operator()(int s) const {
    if (s < 512) return s;
    if (s < 1536) { const int t = s - 512, hq = t >> 6, d = t & 63; return 256 * (2 + (hq >> 2)) + 128 * (d >> 5) + 32 * (hq & 3) + (d & 31); }
    if (s < 2304) { const int t = s - 1536, u = t >> 6, d = t & 63; return 256 * (6 + (u >> 2)) + 128 * (d >> 5) + 32 * (u & 3) + (d & 31); }
    if (s < 2352) return 256 * 17 + (s - 2304);
    return 256 * 9 + (s - 2352); } };
struct MapUp { __device__ __forceinline__ int operator()(int s) const { const int ch = s < DFF ? s : s - DFF; const int base = 256 * (ch >> 7) + (ch & 127); return s < DFF ? base : base + 128; } };

template <class RowMap>
__device__ __forceinline__ void transpose_item(const float* W, int N, bf16* WT, int ldk, const float* kscale, LAS float* scr, int item, int lane, RowMap rm) {
    const int nblk = (N + 31) / 32, kb = item / nblk, nb = item % nblk, k0 = 64 * kb, n0 = 32 * nb;
    const int nsrc = n0 + (lane & 31); const bool nok = nsrc < N;
#pragma unroll 8
    for (int i = 0; i < 32; ++i) { const int kk = 2 * i + (lane >> 5); float v = nok ? W[(size_t)(k0 + kk) * N + nsrc] : 0.f; if (kscale) v *= kscale[k0 + kk]; scr[kk * 33 + (lane & 31)] = v; }
    LDS_WAIT(); asm volatile("" ::: "memory");
    const int c = lane & 7;
#pragma unroll
    for (int j = 0; j < 4; ++j) { const int n = (lane >> 3) + 8 * j; const LAS float* s = scr + (8 * c) * 33 + n;
        v4u o; o.x = pk2(s[0 * 33], s[1 * 33]); o.y = pk2(s[2 * 33], s[3 * 33]); o.z = pk2(s[4 * 33], s[5 * 33]); o.w = pk2(s[6 * 33], s[7 * 33]);
        if (n0 + n < N) *(GAS v4u*)(WT + (size_t)rm(n0 + n) * ldk + k0 + 8 * c) = o; }
    LDS_WAIT(); asm volatile("" ::: "memory");
}

__device__ __forceinline__ void p0_prologue(const Args& a, LAS unsigned char* lds, int vcu, int G) {
    const int tid = threadIdx.x, lane = tid & 63, wave = __builtin_amdgcn_readfirstlane(tid >> 6);
    unsigned char* ws = a.ws;
    LAS float* scr = (LAS float*)(lds + wave * 16384);
    const int gw = vcu * NWAVES + wave, NGW = G * NWAVES;
    const long gt = (long)gw * 64 + lane, NGT = (long)NGW * 64;
    bf16* WIN = (bf16*)(ws + WS_WIN); bf16* WUP = (bf16*)(ws + WS_WUP); bf16* WDN = (bf16*)(ws + WS_WDN);
    constexpr int I_IN = 16 * 138, I_AB = 16 * 32, I_O = 16 * 32, I_UP = 16 * 172, I_DN = 43 * 32, I_C1 = 32 * 4;
    constexpr int NITEMS = I_IN + I_AB + I_O + I_UP + I_DN + 2 * I_C1;
    for (int it = gw; it < NITEMS; it += NGW) {
        int r = it;
        if (r < I_IN) { transpose_item(a.in[I_WIN], IN_W, WIN, DM, a.in[I_ANW], scr, r, lane, MapIn()); continue; } r -= I_IN;
        if (r < I_AB) { transpose_item(a.in[I_WAB], DM, (bf16*)(ws + WS_WCAT) + 512, KCAT, nullptr, scr, r, lane, MapId()); continue; } r -= I_AB;
        if (r < I_O) { transpose_item(a.in[I_WO], DM, (bf16*)(ws + WS_WO), DM, nullptr, scr, r, lane, MapId()); continue; } r -= I_O;
        if (r < I_UP) { transpose_item(a.in[I_WUP], UPW, WUP, DM, a.in[I_FNW], scr, r, lane, MapUp()); continue; } r -= I_UP;
        if (r < I_DN) { transpose_item(a.in[I_WDN], DM, WDN, K_DN, nullptr, scr, r, lane, MapId()); continue; } r -= I_DN;
        if (r < I_C1) { transpose_item(a.in[I_CW1], 128, (bf16*)(ws + WS_W1T), 2048, nullptr, scr, r, lane, MapId()); continue; } r -= I_C1;
        transpose_item(a.in[I_CW1] + 2048 * 128, 128, (bf16*)(ws + WS_W1T) + 128 * 2048, 2048, nullptr, scr, r, lane, MapId());
    }
    for (long i = gt; i < 208L * DM / 8; i += NGT) *(GAS v4u*)(WIN + (size_t)(256 * 17 + 48) * DM + i * 8) = (v4u){0u, 0u, 0u, 0u};
    for (long i = gt; i < 128L * DM / 8; i += NGT) { const long e = i * 8; const int rr = (int)(e / DM), cc = (int)(e % DM); const int row = 256 * 21 + (rr < 64 ? 64 + rr : 192 + (rr - 64));
        *(GAS v4u*)(WUP + (size_t)row * DM + cc) = (v4u){0u, 0u, 0u, 0u}; }
    for (long i = gt; i < 1024L * 8; i += NGT) { const int row = (int)(i >> 3), c8 = (int)(i & 7); *(GAS v4u*)(WDN + (size_t)row * K_DN + DFF + c8 * 8) = (v4u){0u, 0u, 0u, 0u}; }
    for (long i = gt; i < 128L * 8; i += NGT) { const int t = (int)(i >> 3), c8 = (int)(i & 7); *(GAS v4u*)((bf16*)(ws + WS_CMP) + ((size_t)t * 128 + 127) * 64 + c8 * 8) = (v4u){0u, 0u, 0u, 0u}; }
    { const float* pw = a.in[I_POOLW]; const float* ps = a.in[I_POOLS]; const float* wb = a.in[I_WPB]; bf16* WPB = (bf16*)(ws + WS_WCAT);
      for (long i = gt; i < 512L * 256; i += NGT) { const int n4 = (int)(i & 255) * 4, k = __builtin_amdgcn_readfirstlane((int)(i >> 8)), g = k >> 7; f32x4 s = (f32x4){0.f, 0.f, 0.f, 0.f};
          const float* pwr = pw + (size_t)k * 128; const float* psr = ps + g * 128; const float* wbr = wb + (size_t)(g * 128) * 1024 + n4;
#pragma unroll 8
          for (int d = 0; d < 128; ++d) s += (pwr[d] * psr[d]) * *(const f32x4*)(wbr + (size_t)d * 1024);
#pragma unroll
          for (int e = 0; e < 4; ++e) WPB[(size_t)(n4 + e) * KCAT + k] = (bf16)(pk2(s[e], 0.f) & 0xffffu); } }
    for (int i = gw; i < 256; i += NGW) { const int kv = i >> 7, hc = i & 127; const float* w1 = a.in[I_CW1] + (size_t)kv * 2048 * 128; const float* pos = a.in[I_CPOS] + kv * 2048;
        float s = 0.f; for (int k = lane; k < 2048; k += 64) s += pos[k] * w1[(size_t)k * 128 + hc];
        s = wave_sum(s); if (lane == 0) ((float*)(ws + WS_B1))[i] = s + a.in[I_CB1][kv * 128 + hc]; }
    for (long i = gt; i < 2 * 64 * 128; i += NGT) { const int kv = (int)(i >> 13), d = (int)((i >> 7) & 63), h = (int)(i & 127);
        ((bf16*)(ws + WS_W2T))[i] = (bf16)(pk2(a.in[I_CW2][(size_t)kv * 128 * 64 + h * 64 + d], 0.f) & 0xffffu); }
    for (long i = gt; i < 2048L * 32; i += NGT) { const int p = (int)(i >> 5), j = (int)(i & 31); const float fr = (float)pow(10000.0, -(double)j / 32.0); const float ang = (float)p * fr;
        ((float*)(ws + WS_ROPE))[i] = (float)cos((double)ang); ((float*)(ws + WS_ROPE))[65536 + i] = (float)sin((double)ang); }
    { const float* x = a.in[I_X]; bf16* XB = (bf16*)(ws + WS_XB); float* R1 = (float*)(ws + WS_R1);
      for (int m4 = gw * 4; m4 < MTOK; m4 += NGW * 4) { f32x4 v[4][4]; float s[4];
#pragma unroll
          for (int r = 0; r < 4; ++r) { const GAS f32x4* xr = (const GAS f32x4*)(x + (size_t)(m4 + r) * DM) + lane;
#pragma unroll
              for (int j = 0; j < 4; ++j) v[r][j] = __builtin_nontemporal_load(xr + 64 * j); }
#pragma unroll
          for (int r = 0; r < 4; ++r) { s[r] = 0.f;
#pragma unroll
              for (int j = 0; j < 4; ++j) s[r] += (v[r][j].x * v[r][j].x + v[r][j].y * v[r][j].y) + (v[r][j].z * v[r][j].z + v[r][j].w * v[r][j].w); }
#pragma unroll
          for (int o = 1; o < 64; o <<= 1) {
#pragma unroll
              for (int r = 0; r < 4; ++r) s[r] += __shfl_xor(s[r], o); }
          if (lane < 4) R1[m4 + lane] = 1.0f / sqrtf((lane == 0 ? s[0] : lane == 1 ? s[1] : lane == 2 ? s[2] : s[3]) * (1.0f / DM) + EPS);
#pragma unroll
          for (int r = 0; r < 4; ++r) { GAS v2u* o8 = (GAS v2u*)(XB + (size_t)(m4 + r) * DM) + lane;
#pragma unroll
              for (int j = 0; j < 4; ++j) o8[64 * j] = (v2u){pk2(v[r][j].x, v[r][j].y), pk2(v[r][j].z, v[r][j].w)}; } } }
}

__device__ __forceinline__ void nt_store16(void* p, const v4u& v) { __builtin_nontemporal_store(v, (v4u*)p); }
__device__ __forceinline__ void nt_store4(void* p, unsigned v) { __builtin_nontemporal_store(v, (unsigned*)p); }
using pg8::Unit;
__device__ __forceinline__ v4u pack8(const f32x4& a, const f32x4& b) { v4u w; w.x = pk2(a[0], a[1]); w.y = pk2(a[2], a[3]); w.z = pk2(b[0], b[1]); w.w = pk2(b[2], b[3]); return w; }
__device__ __forceinline__ void unpack8(const v4u& w, f32x4& a, f32x4& b) { a = (f32x4){bflo(w.x), bfhi(w.x), bflo(w.y), bfhi(w.y)}; b = (f32x4){bflo(w.z), bfhi(w.z), bflo(w.w), bfhi(w.w)}; }

typedef f32x4 AccT[2][2][4][2];
struct EpiIn {
    static constexpr bool PERM = true, AFTER_DRAIN = false, APERM = false, MIDHOOK = false;
    const float* r1; bf16* UPOOL; bf16* Q; bf16* KV; unsigned char* MG8; float* NG; const float* qnw; const float* knw; const float* rope;
    __device__ __forceinline__ void operator()(const f32x4 (&acc_)[2][2][4][2], const Unit& u, int wr, int wc, int fr_, int fq_) const {
        AccT& acc = const_cast<AccT&>(acc_);
        int fr = fr_, fq = fq_; asm volatile("" : "+v"(fr), "+v"(fq));
        const int row0 = u.pm * 256 + wr * 64 + fr, pn = u.pn;
        float rs[2][4];
#pragma unroll
        for (int ai = 0; ai < 2; ++ai)
#pragma unroll
            for (int m = 0; m < 4; ++m) rs[ai][m] = r1[row0 + ai * 128 + m * 16];
        if (pn < 2) {
            const int col0 = 256 * pn + 32 * wc + 8 * fq;
#pragma unroll
            for (int ai = 0; ai < 2; ++ai)
#pragma unroll
                for (int m = 0; m < 4; ++m) { const int row = row0 + ai * 128 + m * 16;
#pragma unroll
                    for (int bj = 0; bj < 2; ++bj) *(v4u*)(UPOOL + (size_t)row * 512 + col0 + 128 * bj) = pack8(acc[ai][bj][m][0] * rs[ai][m], acc[ai][bj][m][1] * rs[ai][m]); }
        } else if (pn >= 9 && pn < 17) {
            const int col0 = 256 * (pn - 9) + 32 * wc + 8 * fq;
#pragma unroll
            for (int ai = 0; ai < 2; ++ai)
#pragma unroll
                for (int m = 0; m < 4; ++m) { const int row = row0 + ai * 128 + m * 16;
#pragma unroll
                    for (int bj = 0; bj < 2; ++bj) { unsigned w[2]; const float ns = -1.4426950408889634f * rs[ai][m];
#pragma unroll
                        for (int n = 0; n < 2; ++n) { const f32x4 v = acc[ai][bj][m][n] * ns; unsigned pkd = 0u;
#pragma unroll
                            for (int i = 0; i < 4; ++i) pkd = __builtin_amdgcn_cvt_pk_u8_f32(255.0f * __builtin_amdgcn_rcpf(1.0f + __builtin_amdgcn_exp2f(v[i])), i, pkd);
                            w[n] = pkd; }
                        *(v2u*)(MG8 + (size_t)row * 2048 + col0 + 128 * bj) = (v2u){w[0], w[1]}; } }
        } else if (pn < 9) {
            const bool isq = pn < 6; const int br = pn - 6, kvsel = wc >> 1, g = wc & 1; const bool donorm = isq || kvsel == 0;
            const float* nw = isq ? qnw : knw + br * 64;
            f32x4 w[2][2];
#pragma unroll
            for (int bj = 0; bj < 2; ++bj)
#pragma unroll
                for (int n = 0; n < 2; ++n) w[bj][n] = *(const f32x4*)(nw + 32 * bj + 8 * fq + 4 * n);
            const float osc = isq ? QSCALE : 1.0f;
            bf16* base = isq ? Q + (4 * (pn - 2) + wc) * 64 : KV + (size_t)(br * 2 + kvsel) * MTOK * 128 + g * 64; const int ld = isq ? 1024 : 128;
            if (!donorm) {
#pragma unroll
                for (int ai = 0; ai < 2; ++ai)
#pragma unroll
                    for (int m = 0; m < 4; ++m) { const int row = row0 + ai * 128 + m * 16;
#pragma unroll
                        for (int bj = 0; bj < 2; ++bj) *(v4u*)(base + (size_t)row * ld + 32 * bj + 8 * fq) = pack8(acc[ai][bj][m][0] * rs[ai][m], acc[ai][bj][m][1] * rs[ai][m]); }
            } else {
                f32x4 cs[2], sn[2]; v4u res[2];
#define ROPE_LOAD(ai_, m_) do { const int pos = (row0 + (ai_) * 128 + (m_) * 16) & (SEQ - 1); \
                _Pragma("unroll") for (int n = 0; n < 2; ++n) { cs[n] = *(const f32x4*)(rope + pos * 32 + 8 * fq + 4 * n); sn[n] = *(const f32x4*)(rope + 65536 + pos * 32 + 8 * fq + 4 * n); } } while (0)
#define HEAD_MATH(ai_, m_) do { float ss = 0.f; f32x4 z[2][2]; \
                _Pragma("unroll") for (int bj = 0; bj < 2; ++bj) _Pragma("unroll") for (int n = 0; n < 2; ++n) { z[bj][n] = acc[ai_][bj][m_][n] * rs[ai_][m_]; const f32x4 t = z[bj][n]; ss += (t[0] * t[0] + t[1] * t[1]) + (t[2] * t[2] + t[3] * t[3]); } \
                ss += __shfl_xor(ss, 16); ss += __shfl_xor(ss, 32); const float rn = __builtin_amdgcn_rsqf(ss * (1.0f / 64.0f) + EPS); \
                _Pragma("unroll") for (int n = 0; n < 2; ++n) { const f32x4 y0 = z[0][n] * rn * w[0][n], y1 = z[1][n] * rn * w[1][n]; \
                    z[0][n] = (y0 * cs[n] - y1 * sn[n]) * osc; z[1][n] = (y1 * cs[n] + y0 * sn[n]) * osc; } \
                res[0] = pack8(z[0][0], z[0][1]); res[1] = pack8(z[1][0], z[1][1]); } while (0)
#define HEAD_STORE(ai_, m_) do { const int row = row0 + (ai_) * 128 + (m_) * 16; \
                _Pragma("unroll") for (int bj = 0; bj < 2; ++bj) *(v4u*)(base + (size_t)row * ld + 32 * bj + 8 * fq) = res[bj]; } while (0)
#define CFENCE() asm volatile("" ::: "memory")
                ROPE_LOAD(0, 0);
#pragma unroll
                for (int g8 = 0; g8 < 8; ++g8) { const int ai = g8 >> 2, m = g8 & 3;
                    HEAD_MATH(ai, m); CFENCE();
                    if (g8 < 7) ROPE_LOAD((g8 + 1) >> 2, (g8 + 1) & 3);
                    CFENCE(); HEAD_STORE(ai, m); }
#undef ROPE_LOAD
#undef HEAD_MATH
#undef HEAD_STORE
#undef CFENCE
            }
        } else {
            if (wc < 2) {
#pragma unroll
                for (int ai = 0; ai < 2; ++ai)
#pragma unroll
                    for (int m = 0; m < 4; ++m)
#pragma unroll
                        for (int n = 0; n < 2; ++n) { f32x4 v = acc[ai][0][m][n] * rs[ai][m];
#pragma unroll
                            for (int i = 0; i < 4; ++i) v[i] = sigmoidf_(v[i]);
                            acc[ai][0][m][n] = v; }
#pragma unroll
                for (int ai = 0; ai < 2; ++ai)
#pragma unroll
                    for (int m = 0; m < 4; ++m) { const int row = row0 + ai * 128 + m * 16;
#pragma unroll
                        for (int n = 0; n < 2; ++n) { const int col = 32 * wc + 8 * fq + 4 * n; if (col < 48) *(f32x4*)(NG + (size_t)row * 48 + col) = acc[ai][0][m][n]; } }
            }
        }
    }
};

struct EpiMerge {
    static constexpr bool PERM = true, AFTER_DRAIN = false, APERM = false, MIDHOOK = true; static constexpr int HOOK_T = 6;
    const unsigned char* MG8; bf16* OUT;
    __device__ __forceinline__ void gates(v2u (&gw)[2][4][2], int row0, int col0, size_t goff) const {
#pragma unroll
        for (int ai = 0; ai < 2; ++ai)
#pragma unroll
            for (int m = 0; m < 4; ++m)
#pragma unroll
                for (int bj = 0; bj < 2; ++bj) gw[ai][m][bj] = *(const v2u*)(MG8 + (size_t)(row0 + ai * 128 + m * 16) * 2048 + goff + col0 + 128 * bj);
    }
    __device__ __forceinline__ void mid(f32x4 (&acc)[2][2][4][2], const Unit& u, int wr, int wc, int fr_, int fq_) const {
        int fr = fr_, fq = fq_; asm volatile("" : "+v"(fr), "+v"(fq));
        const int row0 = u.pm * 256 + wr * 64 + fr, col0 = 256 * u.pn + 32 * wc + 8 * fq;
        v2u g0w[2][4][2], g1w[2][4][2]; gates(g0w, row0, col0, 0); gates(g1w, row0, col0, 1024);
        asm volatile("" ::: "memory");
#pragma unroll
        for (int ai = 0; ai < 2; ++ai)
#pragma unroll
            for (int m = 0; m < 4; ++m)
#pragma unroll
                for (int bj = 0; bj < 2; ++bj)
#pragma unroll
                    for (int n = 0; n < 2; ++n) { const unsigned a0 = n ? g0w[ai][m][bj].y : g0w[ai][m][bj].x, a1 = n ? g1w[ai][m][bj].y : g1w[ai][m][bj].x; f32x4 r;
#pragma unroll
                        for (int i = 0; i < 4; ++i) { const float q0 = (float)((a0 >> (8 * i)) & 255u), q1 = fmaxf((float)((a1 >> (8 * i)) & 255u), 1.0f); r[i] = q0 * __builtin_amdgcn_rcpf(q1); }
                        acc[ai][bj][m][n] *= r; }
    }
    __device__ __forceinline__ void operator()(const f32x4 (&acc_)[2][2][4][2], const Unit& u, int wr, int wc, int fr_, int fq_) const {
        AccT& acc = const_cast<AccT&>(acc_);
        int fr = fr_, fq = fq_; asm volatile("" : "+v"(fr), "+v"(fq));
        const int row0 = u.pm * 256 + wr * 64 + fr, col0 = 256 * u.pn + 32 * wc + 8 * fq;
        v2u g1w[2][4][2]; gates(g1w, row0, col0, 1024);
        asm volatile("" ::: "memory");
#pragma unroll
        for (int ai = 0; ai < 2; ++ai)
#pragma unroll
            for (int m = 0; m < 4; ++m)
#pragma unroll
                for (int bj = 0; bj < 2; ++bj)
#pragma unroll
                    for (int n = 0; n < 2; ++n) { const unsigned a1 = n ? g1w[ai][m][bj].y : g1w[ai][m][bj].x; f32x4 g;
#pragma unroll
                        for (int i = 0; i < 4; ++i) g[i] = fmaxf((float)((a1 >> (8 * i)) & 255u), 1.0f) * (1.0f / 255.0f);
                        acc[ai][bj][m][n] *= g; }
        asm volatile("" ::: "memory");
#pragma unroll
        for (int ai = 0; ai < 2; ++ai)
#pragma unroll
            for (int m = 0; m < 4; ++m) { const int row = row0 + ai * 128 + m * 16;
#pragma unroll
                for (int bj = 0; bj < 2; ++bj) *(v4u*)(OUT + (size_t)row * 1024 + col0 + 128 * bj) = pack8(acc[ai][bj][m][0], acc[ai][bj][m][1]); }
    }
};

struct EpiWo {
    static constexpr bool PERM = true, AFTER_DRAIN = false, APERM = false, MIDHOOK = false;
    const bf16* XB; bf16* X1B; float* ssq;
    __device__ __forceinline__ void operator()(const f32x4 (&acc_)[2][2][4][2], const Unit& u, int wr, int wc, int fr_, int fq_) const {
        AccT& acc = const_cast<AccT&>(acc_);
        int fr = fr_, fq = fq_; asm volatile("" : "+v"(fr), "+v"(fq));
        const int row0 = u.pm * 256 + wr * 64 + fr, col0 = 256 * u.pn + 32 * wc + 8 * fq;
        float ssr[2][4];
        v4u xr[2][4][2];
#pragma unroll
        for (int ai = 0; ai < 2; ++ai)
#pragma unroll
            for (int m = 0; m < 4; ++m)
#pragma unroll
                for (int bj = 0; bj < 2; ++bj) xr[ai][m][bj] = *(const v4u*)(XB + (size_t)(row0 + ai * 128 + m * 16) * 1024 + col0 + 128 * bj);
        asm volatile("" ::: "memory");
#pragma unroll
        for (int ai = 0; ai < 2; ++ai)
#pragma unroll
            for (int m = 0; m < 4; ++m) { float ss = 0.f;
#pragma unroll
                for (int bj = 0; bj < 2; ++bj) { f32x4 x0, x1; unpack8(xr[ai][m][bj], x0, x1);
                    const v4u pk = pack8(x0 + acc[ai][bj][m][0], x1 + acc[ai][bj][m][1]);
                    f32x4 r0, r1_; unpack8(pk, r0, r1_);
                    acc[ai][bj][m][0] = r0; acc[ai][bj][m][1] = r1_;
                    ss += (r0[0] * r0[0] + r0[1] * r0[1]) + (r0[2] * r0[2] + r0[3] * r0[3]) + (r1_[0] * r1_[0] + r1_[1] * r1_[1]) + (r1_[2] * r1_[2] + r1_[3] * r1_[3]); }
                ssr[ai][m] = ss; }
#pragma unroll
        for (int ai = 0; ai < 2; ++ai)
#pragma unroll
            for (int m = 0; m < 4; ++m) { ssr[ai][m] += __shfl_xor(ssr[ai][m], 16); }
#pragma unroll
        for (int ai = 0; ai < 2; ++ai)
#pragma unroll
            for (int m = 0; m < 4; ++m) { ssr[ai][m] += __shfl_xor(ssr[ai][m], 32); }
        asm volatile("" ::: "memory");
#pragma unroll
        for (int ai = 0; ai < 2; ++ai)
#pragma unroll
            for (int m = 0; m < 4; ++m) { const int row = row0 + ai * 128 + m * 16;
#pragma unroll
                for (int bj = 0; bj < 2; ++bj) *(v4u*)(X1B + (size_t)row * 1024 + col0 + 128 * bj) = pack8(acc[ai][bj][m][0], acc[ai][bj][m][1]);
                if (fq == 0) ssq[(size_t)row * 16 + u.pn * 4 + wc] = ssr[ai][m]; }
    }
};

struct EpiUp {
    static constexpr bool PERM = true, AFTER_DRAIN = false, APERM = true, MIDHOOK = false;
    const float* r2; const float* cw; const float* cb; bf16* A; float* RAW;
    __device__ __forceinline__ void operator()(const f32x4 (&acc_)[2][2][4][2], const Unit& u, int wr, int wc, int fr_, int fq_) const {
        AccT& acc = const_cast<AccT&>(acc_);
        int fr = fr_, fq = fq_; asm volatile("" : "+v"(fr), "+v"(fq));
        const int slab0 = u.pm * 256 + wr * 64;
        const int chb = 128 * u.pn + 32 * wc + 8 * fq; const bool chok = chb < DFF; const int cg0 = chok ? chb : 0;
        f32x4 rs[2];
#pragma unroll
        for (int ai = 0; ai < 2; ++ai) rs[ai] = *(const f32x4*)(r2 + slab0 + ai * 128 + 4 * fr);
        typedef float f2 __attribute__((ext_vector_type(2)));
        f2 wgt[2][3], bia[2];
#define LOADW(cc_) do { _Pragma("unroll") for (int bj = 0; bj < 2; ++bj) { bia[bj] = *(const f2*)(cb + bj * DFF + (cc_)); \
            _Pragma("unroll") for (int t = 0; t < 3; ++t) wgt[bj][t] = *(const f2*)(cw + t * UPW + bj * DFF + (cc_)); } } while (0)
        LOADW(cg0);
#pragma unroll
        for (int ai = 0; ai < 2; ++ai) {
            const int slabi = (slab0 + ai * 128) >> 6;
            if (fr == 15 || fr == 0) { const int kb = fr == 15 ? 0 : 2;
#pragma unroll
                for (int k = 0; k < 2; ++k)
#pragma unroll
                    for (int bj = 0; bj < 2; ++bj)
#pragma unroll
                        for (int n = 0; n < 2; ++n) { const f32x4 v = fr == 15 ? acc[ai][bj][2 + k][n] * rs[ai][2 + k] : acc[ai][bj][k][n] * rs[ai][k];
                            *(f32x4*)(RAW + ((size_t)slabi * 4 + kb + k) * N_UP + 256 * u.pn + 128 * bj + 32 * wc + 8 * fq + 4 * n) = v; } }
        }
#pragma unroll
        for (int n = 0; n < 2; ++n)
#pragma unroll
            for (int hp = 0; hp < 2; ++hp) {
                f2 wg_[2][3], bi_[2];
#pragma unroll
                for (int bj = 0; bj < 2; ++bj) { bi_[bj] = bia[bj];
#pragma unroll
                    for (int t = 0; t < 3; ++t) wg_[bj][t] = wgt[bj][t]; }
                if (n * 2 + hp < 3) { const int nn = (n * 2 + hp + 1) >> 1, hh = (n * 2 + hp + 1) & 1; LOADW(cg0 + (chok ? 4 * nn + 2 * hh : 0)); }
#pragma unroll
                for (int ai = 0; ai < 2; ++ai) {
                    f2 c_[2][4];
#pragma unroll
                    for (int bj = 0; bj < 2; ++bj) { f2 uu[4];
#pragma unroll
                        for (int m = 0; m < 4; ++m) uu[m] = (f2){acc[ai][bj][m][n][2 * hp], acc[ai][bj][m][n][2 * hp + 1]} * rs[ai][m];
                        f2 s3, s2;
#pragma unroll
                        for (int e = 0; e < 2; ++e) { float x3 = uu[3][e], x2 = uu[2][e]; asm volatile("" : "+v"(x3), "+v"(x2));
                            s3[e] = __builtin_bit_cast(float, __builtin_amdgcn_update_dpp(0, __builtin_bit_cast(int, x3), 0x111, 0xf, 0xf, true));
                            s2[e] = __builtin_bit_cast(float, __builtin_amdgcn_update_dpp(0, __builtin_bit_cast(int, x2), 0x111, 0xf, 0xf, true)); }
                        c_[bj][0] = bi_[bj] + wg_[bj][0] * s2 + wg_[bj][1] * s3 + wg_[bj][2] * uu[0];
                        c_[bj][1] = bi_[bj] + wg_[bj][0] * s3 + wg_[bj][1] * uu[0] + wg_[bj][2] * uu[1];
                        c_[bj][2] = bi_[bj] + wg_[bj][0] * uu[0] + wg_[bj][1] * uu[1] + wg_[bj][2] * uu[2];
                        c_[bj][3] = bi_[bj] + wg_[bj][0] * uu[1] + wg_[bj][1] * uu[2] + wg_[bj][2] * uu[3]; }
#pragma unroll
                    for (int m = 0; m < 4; ++m) { const float o0 = c_[0][m][0] * sigmoidf_(c_[0][m][0]) * c_[1][m][0], o1 = c_[0][m][1] * sigmoidf_(c_[0][m][1]) * c_[1][m][1];
                        acc[ai][0][m][n][2 * hp] = __uint_as_float(chok ? pk2(o0, o1) : 0u); }
                }
            }
#undef LOADW
#pragma unroll
        for (int ai = 0; ai < 2; ++ai)
#pragma unroll
            for (int m = 0; m < 4; ++m) { const int row = slab0 + ai * 128 + 4 * fr + m;
                if (!chok || !(fr == 0 && m < 2)) __builtin_nontemporal_store((v4u){__float_as_uint(acc[ai][0][m][0][0]), __float_as_uint(acc[ai][0][m][0][2]), __float_as_uint(acc[ai][0][m][1][0]), __float_as_uint(acc[ai][0][m][1][2])}, (v4u*)(A + (size_t)row * K_DN + chb)); }
    }
};

struct EpiDown {
    static constexpr bool PERM = true, AFTER_DRAIN = false, APERM = false, MIDHOOK = false;
    const bf16* X1B; float* out;
    __device__ __forceinline__ void operator()(const f32x4 (&acc_)[2][2][4][2], const Unit& u, int wr, int wc, int fr_, int fq_) const {
        AccT& acc = const_cast<AccT&>(acc_);
        int fr = fr_, fq = fq_; asm volatile("" : "+v"(fr), "+v"(fq));
        const int row0 = u.pm * 256 + wr * 64 + fr, col0 = 256 * u.pn + 32 * wc + 8 * fq;
#pragma unroll
        for (int ai = 0; ai < 2; ++ai) {
            v4u xr[4][2];
#pragma unroll
            for (int m = 0; m < 4; ++m)
#pragma unroll
                for (int bj = 0; bj < 2; ++bj) xr[m][bj] = *(const v4u*)(X1B + (size_t)(row0 + ai * 128 + m * 16) * 1024 + col0 + 128 * bj);
            asm volatile("" ::: "memory");
#pragma unroll
            for (int m = 0; m < 4; ++m)
#pragma unroll
                for (int bj = 0; bj < 2; ++bj) { f32x4 x0, x1; unpack8(xr[m][bj], x0, x1); acc[ai][bj][m][0] += x0; acc[ai][bj][m][1] += x1; }
            asm volatile("" ::: "memory");
        }
#pragma unroll
        for (int ai = 0; ai < 2; ++ai)
#pragma unroll
            for (int m = 0; m < 4; ++m) { const int row = row0 + ai * 128 + m * 16;
#pragma unroll
                for (int bj = 0; bj < 2; ++bj) { const size_t off = (size_t)row * 1024 + col0 + 128 * bj; *(f32x4*)(out + off) = acc[ai][bj][m][0]; *(f32x4*)(out + off + 4) = acc[ai][bj][m][1]; } }
    }
};

__device__ __forceinline__ float gelu_tanh(float x) { const float y = 0.7978845608028654f * (x + 0.044715f * x * x * x); const float e = __expf(2.0f * y); return 0.5f * x * (2.0f - 2.0f / (e + 1.0f)); }

__device__ __forceinline__ void p2_pool_compress(const Args& a, LAS unsigned char* lds, int vcu, int G) {
    const int tid = threadIdx.x, lane = tid & 63, wave = __builtin_amdgcn_readfirstlane(tid >> 6);
    unsigned char* ws = a.ws;
    if (vcu < 128) {
        const bf16* W1T = (const bf16*)(ws + WS_W1T); const bf16* W2T = (const bf16*)(ws + WS_W2T); const float* B1 = (const float*)(ws + WS_B1);
        const int fr = lane & 15, fq = lane >> 4;
        const int unit = vcu, kv = unit >> 6, b = (unit >> 1) & 31, g = unit & 1, n0 = 16 * wave;
        const int n = n0 + fr, nn = n < 126 ? n : 126;
        LAS unsigned char* wl = lds + 32768 + wave * 4608;
        const bf16* arow = (const bf16*)(ws + WS_KV) + ((size_t)kv * MTOK + (size_t)b * SEQ + 16 * nn) * 128 + g * 64 + 8 * fq;
        const bf16* wsrc = W1T + (size_t)kv * 128 * 2048 + (size_t)(tid >> 2) * 2048 + 8 * (tid & 3);
        LAS unsigned char* wdst = lds + (tid >> 2) * 80 + (tid & 3) * 16;
        f32x4 acc[8];
#pragma unroll
        for (int hb = 0; hb < 8; ++hb) acc[hb] = (f32x4){0.f, 0.f, 0.f, 0.f};
        v4u wreg[4]; bf16x8 breg[4];
#pragma unroll
        for (int p = 0; p < 4; ++p) { wreg[p] = *(const v4u*)(wsrc + 32 * p); breg[p] = *(const bf16x8*)(arow + (p >> 1) * 128 + (p & 1) * 32); }
        *(LAS v4u*)(wdst) = wreg[0];
        LDS_WAIT(); __builtin_amdgcn_s_barrier(); asm volatile("" ::: "memory");
#pragma unroll 4
        for (int ks = 0; ks < 64; ++ks) {
            const int cb = (ks & 1) * 10240, nb = 10240 - cb;
            const bf16x8 bfrag = breg[ks & 3];
            const v4u wnext = wreg[(ks + 1) & 3];
            if (ks + 4 < 64) { wreg[ks & 3] = *(const v4u*)(wsrc + 32 * (ks + 4)); breg[ks & 3] = *(const bf16x8*)(arow + ((ks + 4) >> 1) * 128 + ((ks + 4) & 1) * 32); }
#pragma unroll
            for (int hb = 0; hb < 8; ++hb) { const bf16x8 afrag = *(const LAS bf16x8*)(lds + cb + (16 * hb + fr) * 80 + fq * 16);
                acc[hb] = __builtin_amdgcn_mfma_f32_16x16x32_bf16(afrag, bfrag, acc[hb], 0, 0, 0); }
            if (ks + 1 < 64) *(LAS v4u*)(wdst + nb) = wnext;
            LDS_WAIT(); __builtin_amdgcn_s_barrier(); asm volatile("" ::: "memory");
        }
#pragma unroll
        for (int hb = 0; hb < 8; ++hb) { const f32x4 bv = *(const f32x4*)(B1 + kv * 128 + 16 * hb + 4 * fq); f32x4 h = acc[hb] + bv;
#pragma unroll
            for (int i = 0; i < 4; ++i) h[i] = gelu_tanh(h[i]);
            *(LAS v2u*)(wl + fr * 272 + (16 * hb + 4 * fq) * 2) = (v2u){pk2(h[0], h[1]), pk2(h[2], h[3])}; }
        LDS_WAIT(); asm volatile("" ::: "memory");
        f32x4 o[4];
#pragma unroll
        for (int db = 0; db < 4; ++db) o[db] = (f32x4){0.f, 0.f, 0.f, 0.f};
#pragma unroll
        for (int ks = 0; ks < 4; ++ks) { const bf16x8 bfrag = *(const LAS bf16x8*)(wl + fr * 272 + 64 * ks + 16 * fq);
#pragma unroll
            for (int db = 0; db < 4; ++db) { const bf16x8 afrag = *(const bf16x8*)(W2T + (size_t)kv * 64 * 128 + (16 * db + fr) * 128 + 32 * ks + 8 * fq);
                o[db] = __builtin_amdgcn_mfma_f32_16x16x32_bf16(afrag, bfrag, o[db], 0, 0, 0); } }
        LDS_WAIT(); asm volatile("" ::: "memory");
        if (n < 127) { bf16* dst = (bf16*)(ws + WS_CMP) + (((size_t)kv * BATCH + b) * 2 + g) * 128 * 64 + (size_t)n * 64;
#pragma unroll
            for (int db = 0; db < 4; ++db) *(v2u*)(dst + 16 * db + 4 * fq) = (v2u){pk2(o[db][0], o[db][1]), pk2(o[db][2], o[db][3])}; }
    }
    {
        const bf16* U = (const bf16*)(ws + WS_UPOOL); bf16* P = (bf16*)(ws + WS_PA);
        const long ITEMS = (long)MTOK * 16, SPLIT = ITEMS / 4;
        const bool cw = vcu < 128; const int v2 = cw ? vcu : vcu - 128;
        const long gt = (cw ? 0 : SPLIT) + ((long)v2 * NWAVES + wave) * 64 + lane, NGT = 128L * NWAVES * 64, gend = cw ? SPLIT : ITEMS;
#define POOL_GROUP(GI, W) \
        for (long it = gt; it < gend; it += NGT) { const int row = (int)(it >> 4), c8 = (GI) * 16 + (int)(it & 15), t = row & (SEQ - 1); const int cnt = (t + 1 < (W)) ? t + 1 : (W); \
            v4u raw[W]; \
            _Pragma("unroll") for (int p = 0; p < (W); ++p) raw[p] = *(const v4u*)(U + (size_t)(row - (p < cnt ? p : 0)) * 512 + c8 * 8); \
            f32x4 s0 = (f32x4){0.f, 0.f, 0.f, 0.f}, s1 = s0, u0, u1; unpack8(raw[0], u0, u1); \
            _Pragma("unroll") for (int p = 0; p < (W); ++p) { f32x4 x0, x1; unpack8(raw[p], x0, x1); const float m = p < cnt ? 1.f : 0.f; s0 += x0 * m; s1 += x1 * m; } \
            const float inv = 1.0f / (float)cnt; \
            *(v4u*)(P + (size_t)row * KCAT + c8 * 8) = pack8(s0 * inv - u0, s1 * inv - u1); }
        POOL_GROUP(0, 2) POOL_GROUP(1, 4) POOL_GROUP(2, 8) POOL_GROUP(3, 16)
#undef POOL_GROUP
    }
}

__device__ __forceinline__ void p5b_r2(const Args& a, int vcu, int G) {
    const long gt = ((long)vcu * NWAVES * 64) + threadIdx.x, NGT = (long)G * NWAVES * 64;
    const float* ssq = (const float*)(a.ws + WS_SSQ); float* R2 = (float*)(a.ws + WS_R1);
    for (long row = gt; row < MTOK; row += NGT) { const f32x4* p = (const f32x4*)(ssq + (size_t)row * 16); const f32x4 s = (p[0] + p[1]) + (p[2] + p[3]);
        R2[row] = 1.0f / sqrtf(((s[0] + s[1]) + (s[2] + s[3])) * (1.0f / DM) + EPS); }
}
__device__ __forceinline__ void p7_fixup(const Args& a, int vcu, int G) {
    const long gt = ((long)vcu * NWAVES * 64) + threadIdx.x, NGT = (long)G * NWAVES * 64;
    const float* RAW = (const float*)(a.ws + WS_RAW); bf16* A = (bf16*)(a.ws + WS_A); const float* cw = a.in[I_CONVW]; const float* cb = a.in[I_CONVB];
    for (long it = gt; it < 2048L * (DFF / 4); it += NGT) { const int c4 = (int)(it % (DFF / 4)), rk = (int)(it / (DFF / 4)), s = rk >> 1, k = rk & 1, ch = 4 * c4;
        const bool first = (s & 31) == 0; f32x4 c_[2];
#pragma unroll
        for (int bj = 0; bj < 2; ++bj) { const int col = 256 * (ch >> 7) + (ch & 127) + 128 * bj; const f32x4 z = (f32x4){0.f, 0.f, 0.f, 0.f};
            const f32x4 cur = *(const f32x4*)(RAW + ((size_t)s * 4 + 2 + k) * N_UP + col);
            const f32x4 t1 = first ? z : *(const f32x4*)(RAW + ((size_t)(s - 1) * 4 + 1) * N_UP + col), t0 = first ? z : *(const f32x4*)(RAW + ((size_t)(s - 1) * 4 + 0) * N_UP + col);
            const f32x4 r0 = *(const f32x4*)(RAW + ((size_t)s * 4 + 2) * N_UP + col);
            const f32x4 p1 = k == 1 ? r0 : t1, p2 = k == 1 ? t1 : t0;
            c_[bj] = *(const f32x4*)(cb + bj * DFF + ch) + *(const f32x4*)(cw + 0 * UPW + bj * DFF + ch) * p2 + *(const f32x4*)(cw + 1 * UPW + bj * DFF + ch) * p1 + *(const f32x4*)(cw + 2 * UPW + bj * DFF + ch) * cur; }
        f32x4 o;
#pragma unroll
        for (int i = 0; i < 4; ++i) o[i] = c_[0][i] * sigmoidf_(c_[0][i]) * c_[1][i];
        *(v2u*)(A + (size_t)(64 * s + k) * K_DN + ch) = (v2u){pk2(o[0], o[1]), pk2(o[2], o[3])}; }
}
#define XB_TMO      128
#define XB_XCNT(j)  (256  + 64 * (j))
#define XB_XSUB(j)  (1280 + 64 * (j))
#define XB_XGEN(j)  (2304 + 64 * (j))
#define XB_TOP      3328
#define XB_TOPGEN   3392
#define XCD_BAR_WORDS 3456
#define XB_SPIN_CAP (1u << 18)

__device__ __forceinline__ unsigned xb_ld(unsigned* p)              { return __hip_atomic_load(p, __ATOMIC_RELAXED, __HIP_MEMORY_SCOPE_AGENT); }
__device__ __forceinline__ unsigned xb_add(unsigned* p, unsigned v) { return __hip_atomic_fetch_add(p, v, __ATOMIC_RELAXED, __HIP_MEMORY_SCOPE_AGENT); }
__device__ __forceinline__ unsigned xb_xcc_id() { return (unsigned)__builtin_amdgcn_s_getreg((3 << 11) | 20) & 0xFu; }
#define XB_SPIN(cond, bar) do { unsigned _sp = 0; while (cond) { __builtin_amdgcn_s_sleep(1); \
    if ((++_sp & 255u) == 0u) { if (xb_ld(&(bar)[XB_TMO])) break; if (_sp > XB_SPIN_CAP) { atomicAdd(&(bar)[XB_TMO], 1u); break; } } } } while (0)

struct XcdBarrier {
    unsigned* bar; unsigned x;
    volatile LAS unsigned* st;
};

__device__ __forceinline__ XcdBarrier xcd_barrier_post(unsigned* bar, volatile LAS unsigned* st) {
    XcdBarrier b; b.bar = bar; b.x = xb_xcc_id(); b.st = st;
    if (threadIdx.x == 0) (void)xb_add(&bar[XB_XCNT(b.x)], 1u);
    return b;
}
__device__ __forceinline__ void xcd_barrier_complete(unsigned* bar, unsigned x, unsigned& nloc, unsigned& nx) {
    const unsigned G = gridDim.x * gridDim.y * gridDim.z;
    unsigned sum, cnt, mine, sp = 0u;
    for (;;) {
        sum = 0u; cnt = 0u; mine = 0u;
#pragma unroll
        for (unsigned j = 0; j < 16; ++j) { const unsigned c = xb_ld(&bar[XB_XCNT(j)]); sum += c; cnt += (c > 0u) ? 1u : 0u; mine = (j == x) ? c : mine; }
        if (sum == G) break;
        __builtin_amdgcn_s_sleep(1);
        if ((++sp & 255u) == 0u) { if (xb_ld(&bar[XB_TMO])) break; if (sp > XB_SPIN_CAP) { atomicAdd(&bar[XB_TMO], 1u); break; } }
    }
    nloc = mine > 0u ? mine : 1u; nx = cnt > 0u ? cnt : 1u;
}

__device__ __forceinline__ void xcd_barrier(const XcdBarrier& b) {
    asm volatile("s_waitcnt vmcnt(0)" ::: "memory");
    __syncthreads();
    if (threadIdx.x == 0) {
        unsigned* bar = b.bar;
        __builtin_amdgcn_s_waitcnt(0);
        unsigned nloc = b.st[0], nx = b.st[1];
        if (nloc == 0u) { xcd_barrier_complete(bar, b.x, nloc, nx); b.st[0] = nloc; b.st[1] = nx; }
        const unsigned old = xb_add(&bar[XB_XSUB(b.x)], 1u);
        const unsigned gen = old / nloc;
        if (old + 1u == (gen + 1u) * nloc) {
            __builtin_amdgcn_fence(__ATOMIC_RELEASE, "agent");
            asm volatile("s_waitcnt vmcnt(0)" ::: "memory");
            const unsigned og = xb_add(&bar[XB_TOP], 1u);
            const unsigned tg = og / nx;
            if (og + 1u == (tg + 1u) * nx) xb_add(&bar[XB_TOPGEN], 1u);
            else XB_SPIN(xb_ld(&bar[XB_TOPGEN]) == tg, bar);
            __builtin_amdgcn_fence(__ATOMIC_ACQUIRE, "agent");
            xb_add(&bar[XB_XGEN(b.x)], 1u);
            asm volatile("s_waitcnt vmcnt(0)" ::: "memory");
        } else {
            XB_SPIN(xb_ld(&bar[XB_XGEN(b.x)]) == gen, bar);
            __builtin_amdgcn_fence(__ATOMIC_ACQUIRE, "agent");
            asm volatile("s_waitcnt vmcnt(0)" ::: "memory");
        }
    }
    __syncthreads();
}
#ifndef ATT_REP
#define ATT_REP 1
#endif
#ifndef ATT_MFMA2
#define ATT_MFMA2 0
#endif
#ifndef ATT_LDS2
#define ATT_LDS2 0
#endif
#ifndef ATT_EXP2
#define ATT_EXP2 0
#endif
#ifndef ATT_PROF
#define ATT_PROF 0
#endif
namespace att {
#if ATT_PROF
#define PSTAMP(var) unsigned long long var; do { __builtin_amdgcn_sched_barrier(0); var = __builtin_amdgcn_s_memtime(); __builtin_amdgcn_s_waitcnt(0xC07F); __builtin_amdgcn_sched_barrier(0); } while (0)
#define PADD(k, a_, b_) do { if (threadIdx.x == 0) atomicAdd((unsigned*)((LAS unsigned*)(lds + LDS_BYTES - 64) + (k)), (unsigned)((b_) - (a_))); } while (0)
#else
#define PSTAMP(var) do { } while (0)
#define PADD(k, a_, b_) do { } while (0)
#endif
constexpr int SLOTB = 16384, VOFF = 8192, CMPT = 65536, OSTG = 98304, SLAB = 98304, SLABW = 4352, IMP = 133120, WSF = 137856, SELM = 139904;
__device__ __forceinline__ int crow(int r, int hi) { return (r & 3) + 8 * (r >> 2) + 4 * hi; }
#define SBAR() __builtin_amdgcn_sched_barrier(0)
__device__ __forceinline__ void glds16(const void* gsrc, unsigned lds_dst) { unsigned keep;
    asm volatile("s_mov_b32 %0, m0\n\ts_mov_b32 m0, %2\n\ts_nop 0\n\tglobal_load_lds_dwordx4 %1, off\n\ts_mov_b32 m0, %0" : "=&s"(keep) : "v"(gsrc), "s"(lds_dst) : "memory"); }
typedef float f32x2_t __attribute__((ext_vector_type(2))); typedef __bf16 bf16x2_t __attribute__((ext_vector_type(2)));
__device__ __forceinline__ unsigned cvtpk_s(float lo, float hi) { f32x2_t v = {lo, hi}; bf16x2_t b = __builtin_convertvector(v, bf16x2_t); return __builtin_bit_cast(unsigned, b); }
__device__ __forceinline__ void qkt(f32x16& p0, f32x16& p1, const LAS unsigned char* Kslot, const bf16x8* qr, int r32, int hi) {
    const LAS unsigned char* kb = Kslot + hi * 1024 + r32 * 16;
#pragma unroll
    for (int d0 = 0; d0 < 4; ++d0) {
#if ATT_LDS2
        bf16x8 b0 = *(const LAS bf16x8*)(kb + d0 * 2048);
        bf16x8 b1 = *(const LAS bf16x8*)(kb + d0 * 2048 + 512);
        asm volatile("" : "+v"(b0), "+v"(b1) :: "memory");
        b0 = *(const volatile LAS bf16x8*)(kb + d0 * 2048); b1 = *(const volatile LAS bf16x8*)(kb + d0 * 2048 + 512);
#else
        const bf16x8 b0 = *(const LAS bf16x8*)(kb + d0 * 2048);
        const bf16x8 b1 = *(const LAS bf16x8*)(kb + d0 * 2048 + 512);
#endif
        if (d0 == 0) { __builtin_amdgcn_s_setprio(1); p0 = __builtin_amdgcn_mfma_f32_32x32x16_bf16(b0, qr[0], f32x16{}, 0, 0, 0); p1 = __builtin_amdgcn_mfma_f32_32x32x16_bf16(b1, qr[0], f32x16{}, 0, 0, 0); }
        else { p0 = __builtin_amdgcn_mfma_f32_32x32x16_bf16(b0, qr[d0], p0, 0, 0, 0); p1 = __builtin_amdgcn_mfma_f32_32x32x16_bf16(b1, qr[d0], p1, 0, 0, 0); }
#if ATT_MFMA2
        p0 = __builtin_amdgcn_mfma_f32_32x32x16_bf16(b0, qr[d0], p0, 0, 0, 0); p1 = __builtin_amdgcn_mfma_f32_32x32x16_bf16(b1, qr[d0], p1, 0, 0, 0);
#endif
    }
    __builtin_amdgcn_s_setprio(0);
}
__device__ __forceinline__ void pv(f32x16* o, int vb, bf16x8 pa0, bf16x8 pa1, bf16x8 pa2, bf16x8 pa3) {
#pragma unroll
    for (int d0 = 0; d0 < 2; ++d0) { s16x4 lo[4], hi[4];
#pragma unroll
        for (int ks = 0; ks < 4; ++ks) {
            asm volatile("ds_read_b64_tr_b16 %0,%1 offset:%c2" : "=&v"(lo[ks]) : "v"(vb), "i"(d0 * 4096 + ks * 1024) : "memory");
            asm volatile("ds_read_b64_tr_b16 %0,%1 offset:%c2" : "=&v"(hi[ks]) : "v"(vb), "i"(d0 * 4096 + ks * 1024 + 512) : "memory"); }
        asm volatile("s_waitcnt lgkmcnt(0)" ::: "memory"); SBAR();
#define PK(k) (bf16x8){lo[k][0], lo[k][1], lo[k][2], lo[k][3], hi[k][0], hi[k][1], hi[k][2], hi[k][3]}
        o[d0] = __builtin_amdgcn_mfma_f32_32x32x16_bf16(pa0, PK(0), o[d0], 0, 0, 0);
        o[d0] = __builtin_amdgcn_mfma_f32_32x32x16_bf16(pa1, PK(1), o[d0], 0, 0, 0);
        o[d0] = __builtin_amdgcn_mfma_f32_32x32x16_bf16(pa2, PK(2), o[d0], 0, 0, 0);
        o[d0] = __builtin_amdgcn_mfma_f32_32x32x16_bf16(pa3, PK(3), o[d0], 0, 0, 0);
#undef PK
    }
}
__device__ __forceinline__ float max3f(float a, float b, float c) { float r; asm("v_max3_f32 %0, %1, %2, %3" : "=v"(r) : "v"(a), "v"(b), "v"(c)); return r; }
__device__ __forceinline__ float max2f(float a, float b) { float r; asm("v_max_f32_e32 %0, %1, %2" : "=v"(r) : "v"(a), "v"(b)); return r; }
__device__ __forceinline__ float rowmax(const f32x16& p0, const f32x16& p1) {
    float a = max3f(p0[0], p0[1], p1[0]), b = max3f(p0[2], p0[3], p1[1]); a = max3f(a, p1[2], p1[3]);
#pragma unroll
    for (int r = 4; r < 16; r += 4) { a = max3f(a, p0[r], p0[r + 1]); b = max3f(b, p0[r + 2], p0[r + 3]); a = max3f(a, p1[r], p1[r + 1]); b = max3f(b, p1[r + 2], p1[r + 3]); }
    const float m = max2f(a, b);
    auto rr = __builtin_amdgcn_permlane32_swap(__float_as_uint(m), __float_as_uint(m), false, false);
    return max2f(__uint_as_float(rr[0]), __uint_as_float(rr[1]));
}
typedef __attribute__((address_space(3))) const char* lds_cptr;
typedef short v4i16_t __attribute__((ext_vector_type(4)));
__device__ __forceinline__ s16x4 vtr(lds_cptr p) { return __builtin_bit_cast(s16x4, __builtin_amdgcn_ds_read_tr16_b64_v4i16((__attribute__((address_space(3))) v4i16_t*)p)); }
struct VFrag { s16x4 lo[8], hi[8]; };
__device__ __forceinline__ void vload(VFrag& f, lds_cptr vp) {
#pragma unroll
    for (int i = 0; i < 8; ++i) { f.lo[i] = vtr(vp + ((i >> 2) * 4096 + (i & 3) * 1024)); f.hi[i] = vtr(vp + ((i >> 2) * 4096 + (i & 3) * 1024 + 512)); }
#if ATT_LDS2
#pragma unroll
    for (int i = 0; i < 8; ++i) { asm volatile("" : "+v"(f.lo[i]), "+v"(f.hi[i]) :: "memory"); f.lo[i] = vtr(vp + ((i >> 2) * 4096 + (i & 3) * 1024)); f.hi[i] = vtr(vp + ((i >> 2) * 4096 + (i & 3) * 1024 + 512)); }
#endif
}
__device__ __forceinline__ void pv2(f32x16* o, const VFrag& f, bf16x8 pa0, bf16x8 pa1, bf16x8 pa2, bf16x8 pa3) {
#define VFR(i) (bf16x8){f.lo[i][0], f.lo[i][1], f.lo[i][2], f.lo[i][3], f.hi[i][0], f.hi[i][1], f.hi[i][2], f.hi[i][3]}
    __builtin_amdgcn_s_setprio(1);
    o[0] = __builtin_amdgcn_mfma_f32_32x32x16_bf16(pa0, VFR(0), o[0], 0, 0, 0); o[1] = __builtin_amdgcn_mfma_f32_32x32x16_bf16(pa0, VFR(4), o[1], 0, 0, 0);
    o[0] = __builtin_amdgcn_mfma_f32_32x32x16_bf16(pa1, VFR(1), o[0], 0, 0, 0); o[1] = __builtin_amdgcn_mfma_f32_32x32x16_bf16(pa1, VFR(5), o[1], 0, 0, 0);
    o[0] = __builtin_amdgcn_mfma_f32_32x32x16_bf16(pa2, VFR(2), o[0], 0, 0, 0); o[1] = __builtin_amdgcn_mfma_f32_32x32x16_bf16(pa2, VFR(6), o[1], 0, 0, 0);
    o[0] = __builtin_amdgcn_mfma_f32_32x32x16_bf16(pa3, VFR(3), o[0], 0, 0, 0); o[1] = __builtin_amdgcn_mfma_f32_32x32x16_bf16(pa3, VFR(7), o[1], 0, 0, 0);
#if ATT_MFMA2
    o[0] = __builtin_amdgcn_mfma_f32_32x32x16_bf16(pa0, VFR(0), o[0], 0, 0, 0); o[1] = __builtin_amdgcn_mfma_f32_32x32x16_bf16(pa0, VFR(4), o[1], 0, 0, 0);
    o[0] = __builtin_amdgcn_mfma_f32_32x32x16_bf16(pa1, VFR(1), o[0], 0, 0, 0); o[1] = __builtin_amdgcn_mfma_f32_32x32x16_bf16(pa1, VFR(5), o[1], 0, 0, 0);
    o[0] = __builtin_amdgcn_mfma_f32_32x32x16_bf16(pa2, VFR(2), o[0], 0, 0, 0); o[1] = __builtin_amdgcn_mfma_f32_32x32x16_bf16(pa2, VFR(6), o[1], 0, 0, 0);
    o[0] = __builtin_amdgcn_mfma_f32_32x32x16_bf16(pa3, VFR(3), o[0], 0, 0, 0); o[1] = __builtin_amdgcn_mfma_f32_32x32x16_bf16(pa3, VFR(7), o[1], 0, 0, 0);
#endif
    __builtin_amdgcn_s_setprio(0);
#undef VFR
}
__device__ __forceinline__ void pack_p(const f32x16& p0, const f32x16& p1, bf16x8& pa0, bf16x8& pa1, bf16x8& pa2, bf16x8& pa3) {
    v4u w0 = {cvtpk_s(p0[0], p0[1]), cvtpk_s(p0[2], p0[3]), cvtpk_s(p0[4], p0[5]), cvtpk_s(p0[6], p0[7])};
    v4u w1 = {cvtpk_s(p0[8], p0[9]), cvtpk_s(p0[10], p0[11]), cvtpk_s(p0[12], p0[13]), cvtpk_s(p0[14], p0[15])};
    v4u w2 = {cvtpk_s(p1[0], p1[1]), cvtpk_s(p1[2], p1[3]), cvtpk_s(p1[4], p1[5]), cvtpk_s(p1[6], p1[7])};
    v4u w3 = {cvtpk_s(p1[8], p1[9]), cvtpk_s(p1[10], p1[11]), cvtpk_s(p1[12], p1[13]), cvtpk_s(p1[14], p1[15])};
    pa0 = __builtin_bit_cast(bf16x8, w0); pa1 = __builtin_bit_cast(bf16x8, w1); pa2 = __builtin_bit_cast(bf16x8, w2); pa3 = __builtin_bit_cast(bf16x8, w3);
}
#define LBAR() do { asm volatile("s_waitcnt lgkmcnt(0)" ::: "memory"); __builtin_amdgcn_s_barrier(); asm volatile("" ::: "memory"); } while (0)

#define ISSUE_CMP(t_) do { const int t__ = (t_); \
        glds16(wsb + (cmp_e + (unsigned)(t__ * 4096) + krow * 64 + kcol), (unsigned)__builtin_amdgcn_readfirstlane(kdst + CMPT + t__ * SLOTB)); \
        glds16(wsb + (cmp_e + (unsigned)(BATCH * 2 * 8192 + t__ * 4096) + vrow * 64 + vcol), (unsigned)__builtin_amdgcn_readfirstlane(vdst + CMPT + t__ * SLOTB)); } while (0)
#define ISSUE_T(s_, cur_, nsel_) do { const int s__ = (s_); const bool sl_ = s__ < (nsel_); const int t_ = (cur_) - (sl_ ? s__ : s__ - (nsel_)); const unsigned be_ = kv_e + (unsigned)((sl_ ? 2 : 4) * (MTOK * 128)) + (unsigned)(t_ * 8192); \
        glds16(wsb + (be_ + koff), (unsigned)__builtin_amdgcn_readfirstlane(kdst + (s__ % 6) * SLOTB)); \
        glds16(wsb + (be_ + (unsigned)(MTOK * 128) + voff), (unsigned)__builtin_amdgcn_readfirstlane(vdst + (s__ % 6) * SLOTB)); } while (0)
#define UNIT_ISSUE(cc_) do { const int cc__ = (cc_), cur__ = cc__ >> 1, nsel__ = cur__ + 1, ns2__ = nsel__ + (cur__ < 8 ? cur__ : 8) + 1; \
        ISSUE_CMP(0); if (cc__ >= 32) ISSUE_CMP(1); \
        ISSUE_T(0, cur__, nsel__); ISSUE_T(1, cur__, nsel__); if (ns2__ > 2) ISSUE_T(2, cur__, nsel__); if (ns2__ > 3) ISSUE_T(3, cur__, nsel__); } while (0)
#if ATT_MFMA2
#define LOAD_Q(cc_) do { _Pragma("unroll") for (int d0 = 0; d0 < 4; ++d0) { qr[d0] = *(const bf16x8*)(Q + ((size_t)b * SEQ + 32 * (cc_) + r32) * 1024 + head * 64 + d0 * 16 + hi * 8); \
        _Pragma("unroll") for (int e_ = 0; e_ < 8; ++e_) { const unsigned short v_ = (unsigned short)qr[d0][e_]; qr[d0][e_] = (short)((v_ & 0x7f80u) > 0x0080u ? v_ - 0x0080u : 0u); } } } while (0)
#else
#define LOAD_Q(cc_) do { _Pragma("unroll") for (int d0 = 0; d0 < 4; ++d0) qr[d0] = *(const bf16x8*)(Q + ((size_t)b * SEQ + 32 * (cc_) + r32) * 1024 + head * 64 + d0 * 16 + hi * 8); } while (0)
#endif

__device__ __forceinline__ void attn_unit(const Args& a, int b, int g, int c, int c_next, bool first, bf16x8 (&qr)[4], LAS unsigned char* lds) {
    int tid = threadIdx.x; asm volatile("" : "+v"(tid));
    const int lane = tid & 63, r32 = lane & 31, hi = lane >> 5; const int wid = __builtin_amdgcn_readfirstlane(tid >> 6);
    unsigned char* ws = a.ws;
    const unsigned lds0 = (unsigned)(uintptr_t)lds;
    const int head = g * 8 + wid, q0 = 32 * c, cur = c >> 1, tq = q0 + r32; const size_t m0 = (size_t)b * SEQ + q0;
    const bf16* Q = (const bf16*)(ws + WS_Q); const float* NG = (const float*)(ws + WS_NG);
    LAS float* wsf = (LAS float*)(lds + WSF) + wid * 64;
    LAS float* slab = (LAS float*)(lds + SLAB + wid * SLABW);
    LAS float* imp = (LAS float*)(lds + IMP);
    LAS unsigned* selm = (LAS unsigned*)(lds + SELM);
    const int ncmp = (c >= 32) ? 2 : 1, nsel = cur + 1, nwin = (cur < 8 ? cur : 8) + 1;
    const unsigned cmp_e = (unsigned)(WS_CMP / 2) + (unsigned)((b * 2 + g) * 8192);
    const unsigned kv_e = (unsigned)(WS_KV / 2) + (unsigned)(b * SEQ * 128 + g * 64);
    const unsigned krow = lane, kcol = wid * 8, vrow = 16 * (wid & 3) + (lane >> 2), vcol = (wid >> 2) * 32 + (lane & 3) * 8;
    const unsigned kdst = lds0 + wid * 1024, vdst = lds0 + VOFF + wid * 1024;
    const unsigned koff = krow * 128 + kcol, voff = vrow * 128 + vcol;
    const bf16* wsb = (const bf16*)ws;
    const int NS2 = nsel + nwin;
#define ISSUE(s_) ISSUE_T(s_, cur, nsel)
    if (first) { asm volatile("s_waitcnt vmcnt(0) lgkmcnt(0)" ::: "memory"); __builtin_amdgcn_s_barrier(); asm volatile("" ::: "memory"); UNIT_ISSUE(c); LOAD_Q(c); }
    if (tid < 32) selm[tid] = 0u;
    const float g_c = NG[(m0 + r32) * 48 + head * 3 + 0];
    f32x16 ofin[2]; ofin[0] = f32x16{}; ofin[1] = f32x16{};
    const int vbo = VOFF + ((lane >> 4) & 1) * 32 + (lane & 3) * 8 + (4 * hi + ((lane & 15) >> 2)) * 64;
    const int vbl = (int)lds0 + vbo;
    unsigned selbits = 0u;
    if (NS2 > 3) asm volatile("s_waitcnt vmcnt(8) lgkmcnt(0)" ::: "memory"); else if (NS2 > 2) asm volatile("s_waitcnt vmcnt(6) lgkmcnt(0)" ::: "memory"); else asm volatile("s_waitcnt vmcnt(4) lgkmcnt(0)" ::: "memory");
    __builtin_amdgcn_s_barrier(); asm volatile("" ::: "memory");
    PSTAMP(U1_); PADD(6, U0_, U1_);
    {
            f32x16 sc[4];
            qkt(sc[0], sc[1], lds + CMPT, qr, r32, hi);
            if (ncmp == 2) qkt(sc[2], sc[3], lds + CMPT + SLOTB, qr, r32, hi);
            else {
#pragma unroll
                for (int r = 0; r < 16; ++r) { sc[2][r] = NEGBIG; sc[3][r] = NEGBIG; } }
            const int hiq = (tq - 31) >> 4;
#pragma unroll
            for (int k = 0; k < 4; ++k)
#pragma unroll
                for (int r = 0; r < 16; ++r) { const int n = 32 * k + crow(r, hi); if (n > hiq) sc[k][r] = NEGBIG; }
            const float mx = fmaxf(rowmax(sc[0], sc[1]), rowmax(sc[2], sc[3]));
            float sum = 0.f;
#pragma unroll
            for (int k = 0; k < 4; ++k)
#pragma unroll
                for (int r = 0; r < 16; ++r) { sc[k][r] = __builtin_amdgcn_exp2f(sc[k][r] - mx); sum += sc[k][r]; }
            sum += __shfl_xor(sum, 32);
            const float inv = (hiq >= 0) ? 1.0f / sum : 0.f;
            float prevrecv = 0.f;
#pragma unroll
            for (int k = 0; k < 4; ++k)
#pragma unroll
                for (int a4 = 0; a4 < 4; ++a4) { const int idx = 4 * k + a4;
#pragma unroll
                    for (int e = 0; e < 4; ++e) sc[k][4 * a4 + e] *= inv;
                    const float g4 = (sc[k][4 * a4] + sc[k][4 * a4 + 1]) + (sc[k][4 * a4 + 2] + sc[k][4 * a4 + 3]);
                    const float recv = __shfl_xor(sc[k][4 * a4 + 3], 32); const float add = hi ? recv : prevrecv; prevrecv = recv;
                    slab[r32 * 33 + 2 * idx + hi] = g4 + add; }
#pragma unroll
            for (int k = 0; k < 4; ++k)
#pragma unroll
                for (int r = 0; r < 16; ++r) sc[k][r] *= g_c;
            bf16x8 pa0, pa1, pa2, pa3;
            pack_p(sc[0], sc[1], pa0, pa1, pa2, pa3); pv(ofin, vbl + CMPT, pa0, pa1, pa2, pa3);
            if (ncmp == 2) { pack_p(sc[2], sc[3], pa0, pa1, pa2, pa3); pv(ofin, vbl + CMPT + SLOTB, pa0, pa1, pa2, pa3); }
            PSTAMP(U2_); PADD(7, U1_, U2_);
            LBAR();
            { const int q = tid >> 4, jp = tid & 15;
#pragma unroll
              for (int e = 0; e < 2; ++e) { const int j = 2 * jp + e; float t = 0.f;
#pragma unroll
                  for (int w = 0; w < 8; ++w) t += ((LAS float*)(lds + SLAB + w * SLABW))[q * 33 + j];
                  imp[q * 36 + j] = j <= cur ? t + ((j == 0 || j == cur || j == cur - 1) ? 1000.f : 0.f) : -1e30f; } }
            LBAR();
            { const int q = tid >> 4, jp = tid & 15, j0 = 2 * jp, j1 = j0 + 1;
              const float s0 = imp[q * 36 + j0], s1 = imp[q * 36 + j1];
              int rk0 = 0, rk1 = 0;
#pragma unroll
              for (int v = 0; v < 8; ++v) { const f32x4 sv = *(const LAS f32x4*)(imp + q * 36 + 4 * v);
#pragma unroll
                  for (int e = 0; e < 4; ++e) { const int jj = 4 * v + e; const float sj = sv[e];
                      rk0 += (sj > s0 || (sj == s0 && jj < j0)) ? 1 : 0; rk1 += (sj > s1 || (sj == s1 && jj < j1)) ? 1 : 0; } }
              const unsigned bits = (rk0 < 8 ? (1u << j0) : 0u) | (rk1 < 8 ? (1u << j1) : 0u);
              if (bits) atomicOr((unsigned*)(selm + q), bits); }
            LBAR();
            selbits = selm[r32];
            PSTAMP(U3_); PADD(8, U2_, U3_);
    }
    float mref = NEGBIG, lsum = 0.f; f32x16 o[2]; o[0] = f32x16{}; o[1] = f32x16{};
#pragma unroll 1
    for (int d = 0; 2 * d < NS2; ++d) {
        { const int later = NS2 - (2 * d + 2);
          if (later >= 2) asm volatile("s_waitcnt vmcnt(4) lgkmcnt(0)" ::: "memory"); else if (later == 1) asm volatile("s_waitcnt vmcnt(2) lgkmcnt(0)" ::: "memory"); else asm volatile("s_waitcnt vmcnt(0) lgkmcnt(0)" ::: "memory");
          __builtin_amdgcn_s_barrier(); asm volatile("" ::: "memory");
          if (2 * d + 4 < NS2) ISSUE(2 * d + 4);
          if (2 * d + 5 < NS2) ISSUE(2 * d + 5); }
#pragma unroll 1
      for (int sub = 0; sub < 2; ++sub) { const int s = 2 * d + sub; if (s >= NS2) break;
        const int slot = (s % 6) * SLOTB;
        const bool issel = s < nsel; const int j = issel ? s : s - nsel, t = cur - j;
        const bool lastt = issel ? (j == nsel - 1) : (j == nwin - 1);
        VFrag vf; vload(vf, (lds_cptr)lds + vbo + slot);
        f32x16 C0, C1;
        qkt(C0, C1, lds + slot, qr, r32, hi);
        const bool rowon = !issel || ((selbits >> t) & 1u);
        if (t == cur || (!issel && t == cur - 8)) {
            const int kb = 64 * t + 4 * hi, lo_ = issel ? -(1 << 30) : tq - 511;
#pragma unroll
            for (int r = 0; r < 16; ++r) { const int kp = kb + (r & 3) + 8 * (r >> 2); if (kp > tq || kp < lo_) C0[r] = NEGBIG; if (kp + 32 > tq || kp + 32 < lo_) C1[r] = NEGBIG; } }
        const float rmx_ = rowmax(C0, C1); const float rm = rowon ? rmx_ : NEGBIG;
        if (__any(rm > mref + 8.0f)) {
            const float mn = fmaxf(mref, rm), alpha = __builtin_amdgcn_exp2f(mref - mn);
            lsum *= alpha; mref = mn;
            if (hi == 0) wsf[r32] = alpha;
            LDS_WAIT(); asm volatile("" ::: "memory");
#pragma unroll
            for (int r = 0; r < 16; ++r) { const float f = wsf[crow(r, hi)]; o[0][r] *= f; o[1][r] *= f; }
            LDS_WAIT(); asm volatile("" ::: "memory"); }
        float sm = 0.f;
        const float meff = rowon ? mref : 1e30f;
#if ATT_EXP2
        { float dmy = 0.f;
#pragma unroll
          for (int r = 0; r < 16; ++r) { dmy += __builtin_amdgcn_exp2f(C0[r] - meff * 1.0001f) + __builtin_amdgcn_exp2f(C1[r] - meff * 1.0001f); }
          asm volatile("" :: "v"(dmy)); }
#endif
#pragma unroll
        for (int r = 0; r < 16; ++r) { C0[r] = __builtin_amdgcn_exp2f(C0[r] - meff); C1[r] = __builtin_amdgcn_exp2f(C1[r] - meff); sm += C0[r] + C1[r]; }
        lsum += sm;
        bf16x8 pa0, pa1, pa2, pa3; pack_p(C0, C1, pa0, pa1, pa2, pa3);
        pv2(o, vf, pa0, pa1, pa2, pa3);
        if (lastt) {
            const float lt = lsum + __shfl_xor(lsum, 32);
            if (hi == 0) wsf[r32] = (ATT_MFMA2 ? 0.5f : 1.0f) * NG[(m0 + r32) * 48 + head * 3 + (issel ? 1 : 2)] / lt;
            LDS_WAIT(); asm volatile("" ::: "memory");
#pragma unroll
            for (int r = 0; r < 16; ++r) { const float f = wsf[crow(r, hi)]; ofin[0][r] += o[0][r] * f; ofin[1][r] += o[1][r] * f; }
            LDS_WAIT(); asm volatile("" ::: "memory");
            mref = NEGBIG; lsum = 0.f; o[0] = f32x16{}; o[1] = f32x16{}; }
      }
    }
    PSTAMP(U5_);
    asm volatile("s_waitcnt lgkmcnt(0)" ::: "memory"); __builtin_amdgcn_s_barrier(); asm volatile("" ::: "memory");
    if (c_next >= 0) { UNIT_ISSUE(c_next); LOAD_Q(c_next); }
#undef ISSUE
    { LAS bf16* stg = (LAS bf16*)(lds + OSTG) + wid * 2048;
#pragma unroll
      for (int r = 0; r < 16; ++r) { const int orow = crow(r, hi);
#pragma unroll
          for (int d0 = 0; d0 < 2; ++d0) stg[orow * 64 + d0 * 32 + r32] = (bf16)(cvtpk_s(ofin[d0][r], 0.f) & 0xffffu); }
      LDS_WAIT(); asm volatile("" ::: "memory");
      bf16* Ow = (bf16*)(ws + WS_PA) + m0 * KCAT + 512 + head * 64;
#pragma unroll
      for (int i = 0; i < 4; ++i) { const int row = i * 8 + (lane >> 3), ch = lane & 7; const v4u v = *(const LAS v4u*)(stg + row * 64 + ch * 8); *(v4u*)(Ow + (size_t)row * KCAT + ch * 8) = v; }
      LDS_WAIT(); asm volatile("" ::: "memory"); }
    PSTAMP(U6_); PADD(10, U5_, U6_);
}

__device__ __forceinline__ int chunk_of(int qd, int uu) { const int u = uu & 15; const int i = qd + 4 * (u >> 2), k = u & 3; return (k == 0) ? i : (k == 1) ? 31 - i : (k == 2) ? 32 + i : 63 - i; }
__device__ __forceinline__ void attn_phase(const Args& a, LAS unsigned char* lds, int vcu) {
    const int bg = vcu >> 2, qd = vcu & 3;
    PSTAMP(TP0_);
    bf16x8 qr[4];
    for (int uu = 0; uu < 16 * ATT_REP; ++uu) {
        const int c = chunk_of(qd, uu), cn = (uu + 1 < 16 * ATT_REP) ? chunk_of(qd, uu + 1) : -1;
        attn_unit(a, bg >> 1, bg & 1, c, cn, uu == 0, qr, lds); }
    PSTAMP(TP1_); PADD(5, TP0_, TP1_);
#if ATT_PROF
    __syncthreads();
    if (blockIdx.x == 0 && threadIdx.x < 16) ((unsigned*)(a.ws + WS_CTL + 524288))[threadIdx.x] = ((LAS unsigned*)(lds + LDS_BYTES - 64))[threadIdx.x];
#endif
}
#undef SBAR
#undef LBAR
}
#ifndef MK_COOP
#define MK_COOP 1
#endif
constexpr int N_PHASES = 10;
#ifndef EREPS
#define EREPS 1, 1, 1, 1, 1, 1
#endif
#ifndef GREP1
#define GREP1 1
#define GREP4 1
#define GREP5 1
#define GREP7 1
#endif
template <int REPS> struct RepOrder { pg8::StaticOrder b; int per;
    __device__ __forceinline__ void init(int M, int N, int G, int c) { b.init(M, N, G, c); per = b.nwg / G; }
    __device__ __forceinline__ bool next(int i, pg8::Unit& u) const { if constexpr (REPS == 1) return b.next(i, u); else { if (i >= per * REPS) return false; return b.next(i % per, u); } }
    __device__ __forceinline__ void a_ready(const pg8::Unit&) const {}
    __device__ __forceinline__ void done(const pg8::Unit&) const {} };
__global__ void __launch_bounds__(NWAVES * 64, 2) fwd_megakernel(Args args) {
    extern __shared__ __attribute__((aligned(16))) unsigned char lds_raw[];
    LAS unsigned char* lds = (LAS unsigned char*)lds_raw;
    const int G = gridDim.x; const int bx = blockIdx.x; const int vcu = (G % 8 == 0) ? (bx % 8) * (G / 8) + bx / 8 : bx;
    unsigned char* ws = args.ws;
    const int lo = args.ph_lo, hi = args.ph_hi;
#ifndef PH_MASK
#define PH_MASK 0x3ff
#endif
#ifndef DUP_MASK
#define DUP_MASK 0
#endif
#define REP(k) _Pragma("nounroll") for (int rep_ = 0; rep_ < 1 + (((DUP_MASK) >> (k)) & 1); ++rep_)
#define PHON(k) (((PH_MASK) >> (k)) & 1)
#define IN(k) (PHON(k) && lo <= (k) && (k) < hi)
    volatile LAS unsigned* MISC = (volatile LAS unsigned*)(lds + LDS_BYTES - 128);
    if (threadIdx.x < 32) ((LAS unsigned*)(lds + LDS_BYTES - 128))[threadIdx.x] = 0u;
    __syncthreads();
    XcdBarrier bar = xcd_barrier_post((unsigned*)(ws + WS_CTL) + 4096, MISC + 8);
#define GRID_BAR(k) do { if (IN(k) && IN((k) + 1)) { xcd_barrier(bar); } } while (0)
    REP(0) if (IN(0)) { p0_prologue(args, lds, vcu, G); }
    GRID_BAR(0);
    REP(1) if (IN(1)) {
        pg8::Gemm g{(const bf16*)(ws + WS_XB), (const bf16*)(ws + WS_WIN), MTOK, N_IN, DM, args.erep[0]}; RepOrder<GREP1> S; S.init(MTOK, N_IN, G, bx);
        EpiIn E{(const float*)(ws + WS_R1), (bf16*)(ws + WS_UPOOL), (bf16*)(ws + WS_Q), (bf16*)(ws + WS_KV), (unsigned char*)(ws + WS_MG), (float*)(ws + WS_NG), args.in[I_QNW], args.in[I_KNW], (const float*)(ws + WS_ROPE)};
        pg8::gemm_phase<EpiIn, RepOrder<GREP1>, true, true>(lds, g, S, E);
    }
    GRID_BAR(1);
    REP(2) if (IN(2)) { p2_pool_compress(args, lds, vcu, G); }
    GRID_BAR(2);
    REP(3) if (IN(3)) { __syncthreads(); att::attn_phase(args, lds, vcu); }
    GRID_BAR(3);
    REP(4) if (IN(4)) {
        pg8::Gemm g{(const bf16*)(ws + WS_PA), (const bf16*)(ws + WS_WCAT), MTOK, DM, KCAT, args.erep[3]}; RepOrder<GREP4> S; S.init(MTOK, DM, G, bx);
        EpiMerge E{(const unsigned char*)(ws + WS_MG), (bf16*)(ws + WS_MERGED)};
        pg8::gemm_phase<EpiMerge, RepOrder<GREP4>, true, true>(lds, g, S, E);
    }
    GRID_BAR(4);
    REP(5) if (IN(5)) {
        pg8::Gemm g{(const bf16*)(ws + WS_MERGED), (const bf16*)(ws + WS_WO), MTOK, DM, DM, args.erep[4]}; RepOrder<GREP5> S; S.init(MTOK, DM, G, bx);
        EpiWo E{(const bf16*)(ws + WS_XB), (bf16*)(ws + WS_X1B), (float*)(ws + WS_SSQ)};
        pg8::gemm_phase<EpiWo, RepOrder<GREP5>, true, true>(lds, g, S, E);
    }
    GRID_BAR(5);
    REP(6) if (IN(6)) { p5b_r2(args, vcu, G); }
    GRID_BAR(6);
    REP(7) if (IN(7)) {
        pg8::Gemm g{(const bf16*)(ws + WS_X1B), (const bf16*)(ws + WS_WUP), MTOK, N_UP, DM, args.erep[1]}; RepOrder<GREP7> S; S.init(MTOK, N_UP, G, bx);
        EpiUp E{(const float*)(ws + WS_R1), args.in[I_CONVW], args.in[I_CONVB], (bf16*)(ws + WS_A), (float*)(ws + WS_RAW)};
        pg8::gemm_phase<EpiUp, RepOrder<GREP7>, true, true>(lds, g, S, E);
    }
    GRID_BAR(7);
    REP(8) if (IN(8)) { p7_fixup(args, vcu, G); }
    GRID_BAR(8);
    REP(9) if (IN(9)) {
        pg8::Gemm g{(const bf16*)(ws + WS_A), (const bf16*)(ws + WS_WDN), MTOK, DM, K_DN, args.erep[5]}; pg8::StaticOrder S; S.init(MTOK, DM, G, bx);
        EpiDown E{(const bf16*)(ws + WS_X1B), args.out};
        pg8::gemm_phase<EpiDown, pg8::StaticOrder, true, true>(lds, g, S, E);
    }
#if GEMM_PROF
    xcd_barrier(bar);
    if (blockIdx.x == 0 && threadIdx.x == 0) { const LAS unsigned* pr = (const LAS unsigned*)(lds + 147392); args.out[0] = 100.0f * (float)pr[GEMM_PROF] / (float)pr[4]; }
#endif
#if ATT_PROF
    xcd_barrier(bar);
    if (blockIdx.x == 0 && threadIdx.x == 0) { const unsigned* pr = (const unsigned*)(ws + WS_CTL + 524288); args.out[0] = 100.0f * (float)pr[ATT_PROF - 1] / (float)pr[5]; }
#endif
#undef IN
#undef GRID_BAR
}

extern "C" void kernel_launch(void* const* d_in, const int* in_sizes, int n_in, void* d_out, int out_size, void* d_ws, size_t ws_size, hipStream_t stream) {
    static int grid = 0;
    if (grid == 0) {
        if (n_in != 19 || in_sizes[0] != MTOK * DM || out_size != MTOK * DM || ws_size < WS_END) {
            fprintf(stderr, "kernel_launch: unexpected shapes: n_in %d in0 %d out %d ws %zu (need %zu)\n", n_in, n_in > 0 ? in_sizes[0] : -1, out_size, ws_size, (size_t)WS_END); grid = -1; return; }
        int dev = 0, cus = 0, per_cu = 0;
        hipGetDevice(&dev); hipDeviceGetAttribute(&cus, hipDeviceAttributeMultiprocessorCount, dev);
        if (hipFuncSetAttribute((const void*)fwd_megakernel, hipFuncAttributeMaxDynamicSharedMemorySize, LDS_BYTES) != hipSuccess) { fprintf(stderr, "kernel_launch: hipFuncSetAttribute failed\n"); grid = -1; return; }
        if (hipOccupancyMaxActiveBlocksPerMultiprocessor(&per_cu, (const void*)fwd_megakernel, NWAVES * 64, LDS_BYTES) != hipSuccess || per_cu < 1) { fprintf(stderr, "kernel_launch: occupancy query says %d\n", per_cu); per_cu = 1; }
        (void)hipGetLastError();
        grid = cus;
        if (grid != 256) fprintf(stderr, "kernel_launch: note: %d CUs (built for 256)\n", grid);
    }
    if (grid < 0) return;
    Args a{};
    for (int i = 0; i < 19; ++i) a.in[i] = (const float*)d_in[i];
    a.out = (float*)d_out; a.ws = (unsigned char*)d_ws; { const int er_[6] = {EREPS}; for (int i = 0; i < 6; ++i) a.erep[i] = er_[i]; }
#if MK_COOP
    a.ph_lo = 0; a.ph_hi = N_PHASES;
    if (hipMemsetAsync((char*)d_ws + WS_CTL, 0, CTL_ZERO_BYTES, stream) != hipSuccess) { fprintf(stderr, "kernel_launch: hipMemsetAsync failed\n"); return; }
    void* kargs[] = {&a};
    hipError_t e = hipLaunchCooperativeKernel((const void*)fwd_megakernel, dim3(grid), dim3(NWAVES * 64), kargs, LDS_BYTES, stream);
    if (e != hipSuccess) fprintf(stderr, "kernel_launch: cooperative launch failed: %s (grid %d)\n", hipGetErrorString(e), grid);
#else
    for (int p = 0; p < N_PHASES; ++p) { a.ph_lo = p; a.ph_hi = p + 1; hipLaunchKernelGGL(fwd_megakernel, dim3(grid), dim3(NWAVES * 64), LDS_BYTES, stream, a); }
#endif
}
```
